# Optimizing an MI355X kernel written in HIP

```python
import math
import jax, jax.numpy as jnp
from jax import lax
import numpy as np

D_MODEL = 1024
BATCH = 32
SEQ = 2048
DEPTH = 1

CTX_LEN = 256
GRID_W = 64
D_INNER = 2 * D_MODEL
D_SSM = D_INNER // 2
D_CONV = D_INNER - D_SSM
SSM_HEAD_DIM = 64
SSM_HEADS = D_SSM // SSM_HEAD_DIM
SSM_GROUPS = 2
SSM_STATE = 128
SSM_CONV_W = 5
SSM_CHUNK = 128
CONF_KERNEL = 31
CONF_CH_GROUP = 64
D_FF = ((int(8 * D_MODEL / 3) + 255) // 256) * 256
GN = SSM_GROUPS * SSM_STATE
OFF_Z = 0
OFF_X = OFF_Z + D_SSM
OFF_B = OFF_X + D_SSM
OFF_C = OFF_B + GN
OFF_DT = OFF_C + GN
OFF_GLU = OFF_DT + 2 * SSM_HEADS
D_IN_PROJ = OFF_GLU + 2 * D_CONV
N_MOD = 9
EPS = 1e-6

kernel_name = "hybrid_ssd_conformer_macaron_dit_block"


def rmsnorm(x, w):
    xf = x.astype(jnp.float32)
    y = xf * lax.rsqrt(jnp.mean(xf * xf, axis=-1, keepdims=True) + EPS)
    return (y * w.astype(jnp.float32)).astype(x.dtype)


def group_rmsnorm(x, w, groups):
    xf = x.astype(jnp.float32).reshape(*x.shape[:-1], groups, x.shape[-1] // groups)
    y = xf * lax.rsqrt(jnp.mean(xf * xf, axis=-1, keepdims=True) + EPS)
    return (y.reshape(x.shape) * w.astype(jnp.float32)).astype(x.dtype)


def layernorm(x, w, b):
    xf = x.astype(jnp.float32)
    mu = jnp.mean(xf, axis=-1, keepdims=True)
    var = jnp.mean(jnp.square(xf - mu), axis=-1, keepdims=True)
    y = (xf - mu) * lax.rsqrt(var + EPS)
    return (y * w.astype(jnp.float32) + b.astype(jnp.float32)).astype(x.dtype)


def modulate(h, shift, scale):
    return h * (1.0 + scale) + shift


def swiglu(h, w_gate, w_up, w_down):
    return (jax.nn.silu(h @ w_gate) * (h @ w_up)) @ w_down


def _flip(t):
    return jnp.flip(t, axis=1)


def dwconv1d(x, w, b):
    k = w.shape[0]
    pad = k // 2
    y = lax.conv_general_dilated(x, w[:, None, :], (1,), [(pad, pad)],
                                 dimension_numbers=("NWC", "WIO", "NWC"),
                                 feature_group_count=x.shape[-1])
    return y + b


def axial_dwconv(u, w, b, rows):
    bsz, seqlen, ch = u.shape
    k = w.shape[0]
    pad = k // 2
    half = ch // 2
    g = u.reshape(bsz, rows, GRID_W, ch)
    kh = w[:, :half][None, :, None, :]
    kv = w[:, half:][:, None, None, :]
    yh = lax.conv_general_dilated(g[..., :half], kh, (1, 1), [(0, 0), (pad, pad)],
                                  dimension_numbers=("NHWC", "HWIO", "NHWC"),
                                  feature_group_count=half)
    yv = lax.conv_general_dilated(g[..., half:], kv, (1, 1), [(pad, pad), (0, 0)],
                                  dimension_numbers=("NHWC", "HWIO", "NHWC"),
                                  feature_group_count=ch - half)
    return jnp.concatenate([yh, yv], axis=-1).reshape(bsz, seqlen, ch) + b


def ssd_chunked(xh, dt, a, bm, cm, h0):
    bsz, seqlen, nh, hd = xh.shape
    ng, ns = bm.shape[2], bm.shape[3]
    ne = nh // ng
    nc = seqlen // SSM_CHUNK
    dtype = xh.dtype
    xs = (xh * dt[..., None]).reshape(bsz, nc, SSM_CHUNK, ng, ne, hd)
    da = (dt.astype(jnp.float32) * a.astype(jnp.float32)).reshape(bsz, nc, SSM_CHUNK, ng, ne)
    cs = jnp.cumsum(da, axis=2)
    bc = bm.reshape(bsz, nc, SSM_CHUNK, ng, ns)
    cc = cm.reshape(bsz, nc, SSM_CHUNK, ng, ns)
    seg = cs[:, :, :, None] - cs[:, :, None, :]
    scan_order = jnp.tril(jnp.ones((SSM_CHUNK, SSM_CHUNK), dtype=bool))[None, None, :, :, None, None]
    decay = jnp.exp(jnp.where(scan_order, seg, -jnp.inf)).astype(dtype)
    scores = jnp.einsum("bclgn,bcsgn->bclsg", cc, bc)
    y_diag = jnp.einsum("bclsge,bcsgep->bclgep", scores[..., None] * decay, xs)
    w_state = jnp.exp(cs[:, :, -1:] - cs).astype(dtype)
    chunk_states = jnp.einsum("bclgn,bclge,bclgep->bcgepn", bc, w_state, xs)
    chunk_decay = jnp.exp(cs[:, :, -1]).astype(dtype)

    def step(h, inp):
        s, d = inp
        return h * d[..., None, None] + s, h

    _, h_prev = lax.scan(step, h0.reshape(bsz, ng, ne, hd, ns).astype(dtype),
                         (jnp.moveaxis(chunk_states, 1, 0), jnp.moveaxis(chunk_decay, 1, 0)))
    y_off = jnp.einsum("bclgn,cbgepn,bclge->bclgep", cc, h_prev, jnp.exp(cs).astype(dtype))
    return (y_diag + y_off).reshape(bsz, seqlen, nh, hd)


def ssd_final_state(xh, dt, a, bm):
    bsz, seqlen, nh, hd = xh.shape
    ng, ns = bm.shape[2], bm.shape[3]
    ne = nh // ng
    cs = jnp.cumsum(dt.astype(jnp.float32) * a.astype(jnp.float32), axis=1)
    w = (jnp.exp(cs[:, -1:] - cs) * dt.astype(jnp.float32)).astype(xh.dtype).reshape(bsz, seqlen, ng, ne)
    st = jnp.einsum("blgn,blge,blgep->bgepn", bm, w, xh.reshape(bsz, seqlen, ng, ne, hd))
    return st.reshape(bsz, nh, hd, ns)


def ctx_ssd_states(hc, w_in, conv_w, conv_b, dtb_f, dtb_b, alog_f, alog_b):
    bsz, clen, _ = hc.shape
    xb = jax.nn.silu(dwconv1d(hc @ w_in[:, OFF_X:OFF_C], conv_w[:, :D_SSM + GN], conv_b[:D_SSM + GN]))
    dt_raw = hc @ w_in[:, OFF_DT:OFF_GLU]
    xh = xb[..., :D_SSM].reshape(bsz, clen, SSM_HEADS, SSM_HEAD_DIM)
    bm = xb[..., D_SSM:].reshape(bsz, clen, SSM_GROUPS, SSM_STATE)
    dt_f = jax.nn.softplus(dt_raw[..., :SSM_HEADS] + dtb_f)
    dt_b = jax.nn.softplus(dt_raw[..., SSM_HEADS:] + dtb_b)
    s_f = ssd_final_state(xh, dt_f, -jnp.exp(alog_f), bm)
    s_b = ssd_final_state(_flip(xh), _flip(dt_b), -jnp.exp(alog_b), _flip(bm))
    return s_f, s_b


def mixer(h, w_in, w_out, conv_w, conv_b, dtb_f, dtb_b, alog_f, alog_b, d_skip, norm_w,
          cw, cb, ln_w, ln_b, h0_f, h0_b, rows):
    bsz, seqlen, _ = h.shape
    proj = h @ w_in
    z = proj[..., OFF_Z:OFF_X]
    xbc = jax.nn.silu(dwconv1d(proj[..., OFF_X:OFF_DT], conv_w, conv_b))
    dt_raw = proj[..., OFF_DT:OFF_GLU]
    glu = proj[..., OFF_GLU:]
    xh = xbc[..., :D_SSM].reshape(bsz, seqlen, SSM_HEADS, SSM_HEAD_DIM)
    bm = xbc[..., D_SSM:D_SSM + GN].reshape(bsz, seqlen, SSM_GROUPS, SSM_STATE)
    cm = xbc[..., D_SSM + GN:].reshape(bsz, seqlen, SSM_GROUPS, SSM_STATE)
    dt_f = jax.nn.softplus(dt_raw[..., :SSM_HEADS] + dtb_f)
    dt_b = jax.nn.softplus(dt_raw[..., SSM_HEADS:] + dtb_b)
    y_f = ssd_chunked(xh, dt_f, -jnp.exp(alog_f), bm, cm, h0_f)
    y_b = _flip(ssd_chunked(_flip(xh), _flip(dt_b), -jnp.exp(alog_b), _flip(bm), _flip(cm), h0_b))
    y = (y_f + y_b + d_skip[:, None] * xh).reshape(bsz, seqlen, D_SSM)
    y = group_rmsnorm(y * jax.nn.silu(z), norm_w, SSM_GROUPS)
    u = glu[..., :D_CONV] * jax.nn.sigmoid(glu[..., D_CONV:])
    if rows is None:
        u = dwconv1d(u, cw, cb)
    else:
        u = axial_dwconv(u, cw, cb, rows)
    u = jax.nn.silu(layernorm(u, ln_w, ln_b))
    return jnp.concatenate([y, u], axis=-1) @ w_out


def setup_inputs(seed: int = 0) -> dict:
    key = jax.random.key(seed)
    ks = iter(jax.random.split(key, 40))

    def nrm(shape, scale):
        return jax.random.normal(next(ks), shape, jnp.float32) * scale

    L = DEPTH
    d_in_scale = D_MODEL ** -0.5
    u_dt = jax.random.uniform(next(ks), (2, L, SSM_HEADS), jnp.float32)
    dt0 = jnp.exp(u_dt * (math.log(0.1) - math.log(1e-3)) + math.log(1e-3))
    dt_bias = dt0 + jnp.log(-jnp.expm1(-dt0))
    a_log = jnp.log(jax.random.uniform(next(ks), (2, L, SSM_HEADS), jnp.float32, 1.0, 16.0))
    return {
        "x": nrm((BATCH, SEQ, D_MODEL), 1.0),
        "c": nrm((BATCH, D_MODEL), 1.0),
        "ctx": nrm((BATCH, CTX_LEN, D_MODEL), 1.0),
        "c_ctx": nrm((D_MODEL,), 1.0),
        "w_mod": nrm((L, D_MODEL, N_MOD * D_MODEL), 0.5 * d_in_scale),
        "b_mod": nrm((L, N_MOD * D_MODEL), 0.02),
        "norm_ffn1": 1.0 + nrm((L, D_MODEL), 0.02),
        "ffn1_gate": nrm((L, D_MODEL, D_FF), d_in_scale),
        "ffn1_up": nrm((L, D_MODEL, D_FF), d_in_scale),
        "ffn1_down": nrm((L, D_FF, D_MODEL), D_FF ** -0.5),
        "norm_mix": 1.0 + nrm((L, D_MODEL), 0.02),
        "w_in": nrm((L, D_MODEL, D_IN_PROJ), d_in_scale),
        "ssm_conv_w": nrm((L, SSM_CONV_W, D_SSM + 2 * GN), SSM_CONV_W ** -0.5),
        "ssm_conv_b": nrm((L, D_SSM + 2 * GN), 0.02),
        "dt_bias_fwd": dt_bias[0],
        "dt_bias_bwd": dt_bias[1],
        "a_log_fwd": a_log[0],
        "a_log_bwd": a_log[1],
        "ssm_d": 1.0 + nrm((L, SSM_HEADS), 0.02),
        "ssm_norm_w": 1.0 + nrm((L, D_SSM), 0.02),
        "cconv_w": nrm((L, CONF_KERNEL, D_CONV), CONF_KERNEL ** -0.5),
        "cconv_b": nrm((L, D_CONV), 0.02),
        "cconv_ln_w": 1.0 + nrm((L, D_CONV), 0.02),
        "cconv_ln_b": nrm((L, D_CONV), 0.02),
        "w_out": nrm((L, D_INNER, D_MODEL), D_INNER ** -0.5),
        "norm_ffn2": 1.0 + nrm((L, D_MODEL), 0.02),
        "ffn2_gate": nrm((L, D_MODEL, D_FF), d_in_scale),
        "ffn2_up": nrm((L, D_MODEL, D_FF), d_in_scale),
        "ffn2_down": nrm((L, D_FF, D_MODEL), D_FF ** -0.5),
        "final_norm": 1.0 + nrm((D_MODEL,), 0.02),
    }


def reference(x, c, ctx, c_ctx, w_mod, b_mod, norm_ffn1, ffn1_gate, ffn1_up, ffn1_down, norm_mix,
              w_in, ssm_conv_w, ssm_conv_b, dt_bias_fwd, dt_bias_bwd, a_log_fwd, a_log_bwd, ssm_d,
              ssm_norm_w, cconv_w, cconv_b, cconv_ln_w, cconv_ln_b, w_out, norm_ffn2, ffn2_gate,
              ffn2_up, ffn2_down, final_norm):
    bsz = x.shape[0]
    rows = x.shape[1] // GRID_W
    xc = ctx
    for i in range(DEPTH):
        last = i == DEPTH - 1
        mod = (jax.nn.silu(c) @ w_mod[i] + b_mod[i]).reshape(bsz, N_MOD, 1, D_MODEL)
        n_c = 5 if last else N_MOD
        mod_c = (jax.nn.silu(c_ctx) @ w_mod[i][:, :n_c * D_MODEL] + b_mod[i][:n_c * D_MODEL]).reshape(n_c, 1, D_MODEL)
        x = x + 0.5 * mod[:, 2] * swiglu(modulate(rmsnorm(x, norm_ffn1[i]), mod[:, 0], mod[:, 1]),
                                         ffn1_gate[i], ffn1_up[i], ffn1_down[i])
        xc = xc + 0.5 * mod_c[2] * swiglu(modulate(rmsnorm(xc, norm_ffn1[i]), mod_c[0], mod_c[1]),
                                          ffn1_gate[i], ffn1_up[i], ffn1_down[i])
        hx = modulate(rmsnorm(x, norm_mix[i]), mod[:, 3], mod[:, 4])
        hc = modulate(rmsnorm(xc, norm_mix[i]), mod_c[3], mod_c[4])
        s_f, s_b = ctx_ssd_states(hc, w_in[i], ssm_conv_w[i], ssm_conv_b[i], dt_bias_fwd[i],
                                  dt_bias_bwd[i], a_log_fwd[i], a_log_bwd[i])
        x = x + mod[:, 5] * mixer(hx, w_in[i], w_out[i], ssm_conv_w[i], ssm_conv_b[i], dt_bias_fwd[i],
                                  dt_bias_bwd[i], a_log_fwd[i], a_log_bwd[i], ssm_d[i], ssm_norm_w[i],
                                  cconv_w[i], cconv_b[i], cconv_ln_w[i], cconv_ln_b[i], s_f, s_b, rows)
        if not last:
            zero_state = jnp.zeros_like(s_f)
            xc = xc + mod_c[5] * mixer(hc, w_in[i], w_out[i], ssm_conv_w[i], ssm_conv_b[i], dt_bias_fwd[i],
                                       dt_bias_bwd[i], a_log_fwd[i], a_log_bwd[i], ssm_d[i], ssm_norm_w[i],
                                       cconv_w[i], cconv_b[i], cconv_ln_w[i], cconv_ln_b[i],
                                       zero_state, zero_state, None)
        x = x + 0.5 * mod[:, 8] * swiglu(modulate(rmsnorm(x, norm_ffn2[i]), mod[:, 6], mod[:, 7]),
                                         ffn2_gate[i], ffn2_up[i], ffn2_down[i])
        if not last:
            xc = xc + 0.5 * mod_c[8] * swiglu(modulate(rmsnorm(xc, norm_ffn2[i]), mod_c[6], mod_c[7]),
                                              ffn2_gate[i], ffn2_up[i], ffn2_down[i])
    return rmsnorm(x, final_norm)
```

```cpp
#include <hip/hip_runtime.h>
#include <hip/hip_cooperative_groups.h>
#include <cstdio>
namespace cg = cooperative_groups;
namespace pg8 {
#define PG8_LAS __attribute__((address_space(3)))
typedef unsigned short bf16_t;
typedef short bf16x8 __attribute__((ext_vector_type(8)));
typedef float f32x4 __attribute__((ext_vector_type(4)));
typedef unsigned u32x4 __attribute__((ext_vector_type(4)));
constexpr int BM = 256, BK = 64, HALF = 128, HTB = HALF * BK * 2  , STAGE_BYTES = 8 * HTB, NXCD = 8, WGM = 8;

__host__ __device__ __forceinline__ int lds_byte(int r, int c) { const int st = (r >> 4) * 2 + (c >> 5), rr = r & 15, cc = c & 31, ob = rr * 64 + cc * 2; return st * 1024 + (ob ^ (((ob >> 9) & 1) << 5)); }
__host__ __device__ __forceinline__ void stage_rc(int b, int& R, int& C) { const int st = b / 1024, sb = b % 1024, swz = sb ^ (((sb >> 9) & 1) << 5); R = (st >> 1) * 16 + swz / 64; C = (st & 1) * 32 + (swz % 64) / 2; }
__host__ __device__ __forceinline__ int perm32(int rho) { const int n = rho >> 4, i = rho & 15; return 8 * (i >> 2) + 4 * n + (i & 3); }

struct Unit { int pm, pn; };
struct Gemm { const bf16_t* A; const bf16_t* Bt; int M, N, K; };

struct StaticOrder {
    int nM, nN, nwg, G, c;
    __host__ __device__ void init(int M, int N, int G_, int c_) { nM = M / BM; nN = N / BM; nwg = nM * nN; G = G_; c = c_; }
    __host__ __device__ bool next(int i, Unit& u) const {
        const long L = (long)i * G + c; if (L >= nwg) return false;
        int wgid = (int)L; { const int q = nwg / NXCD, r = nwg % NXCD, xcd = wgid % NXCD, off = wgid / NXCD; wgid = (xcd < r ? xcd * (q + 1) : r * (q + 1) + (xcd - r) * q) + off; }
        const int nig = WGM * nN, gid = wgid / nig, fm = gid * WGM, gsz = (nM - fm) < WGM ? (nM - fm) : WGM;
        u.pm = fm + ((wgid % nig) % gsz); u.pn = (wgid % nig) / gsz; return true;
    }
    __device__ __forceinline__ void a_ready(const Unit&) const {}
    __device__ __forceinline__ void done(const Unit&) const {}
};
__device__ __forceinline__ unsigned cvt_pk_bf16(float lo, float hi) { unsigned r; asm volatile("v_cvt_pk_bf16_f32 %0, %1, %2" : "=v"(r) : "v"(lo), "v"(hi)); return r; }
typedef float f32x2 __attribute__((ext_vector_type(2)));
template <class Epi, class Sched, bool STAMP = false>
__device__ __forceinline__ void gemm_phase(PG8_LAS unsigned char* lds, const Gemm g, const Sched& S, const Epi& E, unsigned long long* stamps) {
    const int tid = threadIdx.x, wid = __builtin_amdgcn_readfirstlane(tid >> 6), lane = tid & 63, wr = wid >> 2, wc = wid & 3, fr = lane & 15, fq = lane >> 4;
    const int K = g.K, nt = K / BK;
    int ts_lo = 0, ts_hi = 0, nts = 0; const unsigned long long rt_entry = STAMP ? (unsigned long long)wall_clock64() : 0ull;
#define PG8_STAMP() do { if (STAMP && wid == 0 && nts < 64) { const unsigned long long _c = (unsigned long long)clock64(); \
        ts_lo = (lane == nts) ? (int)(unsigned)_c : ts_lo; ts_hi = (lane == nts) ? (int)(unsigned)(_c >> 32) : ts_hi; ++nts; } } while (0)
    PG8_STAMP();
    unsigned voffA[2], voffB[2];
#pragma unroll
    for (int i = 0; i < 2; ++i) { int R, C; stage_rc(tid * 16 + i * 8192, R, C); const int Rb = Epi::PERM ? ((R & ~31) + perm32(R & 31)) : R;
        voffA[i] = (unsigned)(R * K + C) * 2u; voffB[i] = (unsigned)(Rb * K + C) * 2u; }
    const size_t kstep = (size_t)(BK * 2);
    const size_t hstep = (size_t)HALF * K * 2;
    const size_t tstep = 2 * hstep;
    const unsigned ldsw = (unsigned)wid * 1024u;
    const int aoff = lds_byte(wr * 64 + fr, fq * 8), boff = lds_byte(wc * 32 + fr, fq * 8);
#define PG8_SA(b, h) (((b) * 2 + (h)) * HTB)
#define PG8_SB(b, h) ((4 + (b) * 2 + (h)) * HTB)
#define PG8_STAGE(bufoff, gbase, voff) do { _Pragma("unroll") for (int _i = 0; _i < 2; ++_i) \
        __builtin_amdgcn_global_load_lds((const unsigned*)((const char*)(gbase) + (voff)[_i]), (PG8_LAS unsigned*)(lds + (bufoff) + ldsw + _i * 8192), 16, 0, 0); } while (0)
#define PG8_LDA(dst, b, h) do { _Pragma("unroll") for (int m = 0; m < 4; ++m) _Pragma("unroll") for (int k = 0; k < 2; ++k) dst[m][k] = *(const PG8_LAS bf16x8*)(lds + PG8_SA(b, h) + aoff + m * 2048 + k * 1024); } while (0)
#define PG8_LDB(dst, b, h) do { _Pragma("unroll") for (int n = 0; n < 2; ++n) _Pragma("unroll") for (int k = 0; k < 2; ++k) dst[n][k] = *(const PG8_LAS bf16x8*)(lds + PG8_SB(b, h) + boff + n * 2048 + k * 1024); } while (0)
#define PG8_MMA(ai, bj, At, Bt) do { __builtin_amdgcn_s_setprio(1); _Pragma("unroll") for (int m = 0; m < 4; ++m) _Pragma("unroll") for (int n = 0; n < 2; ++n) _Pragma("unroll") for (int k = 0; k < 2; ++k) \
        acc[ai][bj][m][n] = __builtin_amdgcn_mfma_f32_16x16x32_bf16(Bt[n][k], At[m][k], acc[ai][bj][m][n], 0, 0, 0); __builtin_amdgcn_s_setprio(0); } while (0)
#define PG8_WAIT_V(n) asm volatile("s_waitcnt vmcnt(" #n ")" ::: "memory")
#define PG8_WAIT_L(n) asm volatile("s_waitcnt lgkmcnt(" #n ")" ::: "memory")
#define PG8_BAR __builtin_amdgcn_s_barrier()
#define PG8_SCHED __builtin_amdgcn_sched_barrier(0)
    Unit cur, nxt; int ui = 0;
    if (!S.next(0, cur)) return;
    f32x4 acc[2][2][4][2];
#pragma unroll
    for (int a = 0; a < 2; ++a)
#pragma unroll
        for (int b = 0; b < 2; ++b)
#pragma unroll
            for (int m = 0; m < 4; ++m)
#pragma unroll
                for (int n = 0; n < 2; ++n) acc[a][b][m][n] = (f32x4){0.f, 0.f, 0.f, 0.f};
    bf16x8 At[4][2], B0[2][2], B1[2][2];
    const char* cA = (const char*)g.A + (size_t)cur.pm * tstep; const char* cB = (const char*)g.Bt + (size_t)cur.pn * tstep;
    S.a_ready(cur);
    PG8_STAGE(PG8_SB(0, 0), cB, voffB); PG8_STAGE(PG8_SA(0, 0), cA, voffA); PG8_STAGE(PG8_SB(0, 1), cB + hstep, voffB); PG8_STAGE(PG8_SA(0, 1), cA + hstep, voffA);
    if (wr == 1) PG8_BAR;
    PG8_WAIT_V(4); PG8_BAR;
    PG8_STAGE(PG8_SB(1, 0), cB + kstep, voffB); PG8_STAGE(PG8_SA(1, 0), cA + kstep, voffA); PG8_STAGE(PG8_SB(1, 1), cB + hstep + kstep, voffB);
    PG8_WAIT_V(6); PG8_BAR;
    PG8_STAMP();
    for (;;) {
        const bool has_next = S.next(ui + 1, nxt);
        const char* nA = has_next ? (const char*)g.A + (size_t)nxt.pm * tstep : cA; const char* nB = has_next ? (const char*)g.Bt + (size_t)nxt.pn * tstep : cB;
        for (int t = 0; t < nt; t += 2) {
            const bool last = (t == nt - 2);
            const char* a1 = cA + (size_t)(t + 1) * kstep;
            const char* a2 = last ? nA : cA + (size_t)(t + 2) * kstep; const char* b2 = last ? nB : cB + (size_t)(t + 2) * kstep;
            const char* a3 = a2 + kstep; const char* b3 = b2 + kstep;
            if (last && has_next) S.a_ready(nxt);
            PG8_LDB(B0, 0, 0); PG8_SCHED; PG8_LDA(At, 0, 0); PG8_STAGE(PG8_SA(1, 1), a1 + hstep, voffA);
            PG8_WAIT_L(8); PG8_BAR; PG8_WAIT_L(0); PG8_MMA(0, 0, At, B0); PG8_BAR; PG8_SCHED;
            PG8_LDB(B1, 0, 1); PG8_STAGE(PG8_SB(0, 0), b2, voffB);
            PG8_BAR; PG8_WAIT_L(0); PG8_MMA(0, 1, At, B1); PG8_BAR;
            PG8_LDA(At, 0, 1); PG8_STAGE(PG8_SA(0, 0), a2, voffA);
            PG8_BAR; PG8_WAIT_L(0); PG8_MMA(1, 0, At, B0); PG8_BAR; PG8_SCHED;
            PG8_STAGE(PG8_SB(0, 1), b2 + hstep, voffB);
            PG8_WAIT_V(6); PG8_BAR; PG8_MMA(1, 1, At, B1); PG8_BAR;
            PG8_LDB(B0, 1, 0); PG8_SCHED; PG8_LDA(At, 1, 0); PG8_STAGE(PG8_SA(0, 1), a2 + hstep, voffA);
            PG8_WAIT_L(8); PG8_BAR; PG8_WAIT_L(0); PG8_MMA(0, 0, At, B0); PG8_BAR; PG8_SCHED;
            PG8_LDB(B1, 1, 1); PG8_STAGE(PG8_SB(1, 0), b3, voffB);
            PG8_BAR; PG8_WAIT_L(0); PG8_MMA(0, 1, At, B1); PG8_BAR;
            PG8_LDA(At, 1, 1); PG8_STAGE(PG8_SA(1, 0), a3, voffA);
            PG8_BAR; PG8_WAIT_L(0); PG8_MMA(1, 0, At, B0); PG8_BAR; PG8_SCHED;
            PG8_STAGE(PG8_SB(1, 1), b3 + hstep, voffB);
            PG8_WAIT_V(6); PG8_BAR; PG8_MMA(1, 1, At, B1); PG8_BAR;
        }
        PG8_STAMP();
        if constexpr (!Epi::AFTER_DRAIN) { E(acc, cur, wr, wc, fr, fq); S.done(cur); }
        PG8_STAMP();
        if (!has_next) break;
#pragma unroll
        for (int a = 0; a < 2; ++a)
#pragma unroll
            for (int b = 0; b < 2; ++b)
#pragma unroll
                for (int m = 0; m < 4; ++m)
#pragma unroll
                    for (int n = 0; n < 2; ++n) acc[a][b][m][n] = (f32x4){0.f, 0.f, 0.f, 0.f};
        cur = nxt; cA = nA; cB = nB; ++ui;
    }
    PG8_WAIT_V(0);
    if (wr == 0) PG8_BAR;
    PG8_BAR;
    if constexpr (Epi::AFTER_DRAIN) { E.fused(acc, cur, wr, wc, fr, fq, lds, wid, lane); S.done(cur); }
    PG8_STAMP();
    if (STAMP && wid == 0) { stamps[lane] = lane < nts ? (((unsigned long long)(unsigned)ts_hi << 32) | (unsigned)ts_lo) : 0ull;
        if (lane == 62) stamps[62] = rt_entry; if (lane == 63) stamps[63] = (unsigned long long)wall_clock64(); }
#undef PG8_STAMP
#undef PG8_SA
#undef PG8_SB
#undef PG8_STAGE
#undef PG8_LDA
#undef PG8_LDB
#undef PG8_MMA
#undef PG8_WAIT_V
#undef PG8_WAIT_L
#undef PG8_BAR
#undef PG8_SCHED
}
}
using namespace pg8;
#define LAS __attribute__((address_space(3)))
typedef unsigned short u16;
typedef unsigned int u32;
typedef float f32x16 __attribute__((ext_vector_type(16)));

constexpr int TX = 65536, TCX = 8192, TT = 73728;
constexpr int DFF = 2816, NGU = 5632, NIN = 4864;
constexpr float EPSF = 1e-6f;
constexpr int LDS_BYTES = 160768;
constexpr int NPHASE = 15;

constexpr size_t SZ_WGU = (size_t)NGU * 1024 * 2, SZ_WD = (size_t)1024 * DFF * 2, SZ_WIN = (size_t)NIN * 1024 * 2, SZ_WOUT = (size_t)1024 * 2048 * 2;
constexpr size_t OFF_WGU1 = 0, OFF_WD1 = OFF_WGU1 + SZ_WGU, OFF_WGU2 = OFF_WD1 + SZ_WD, OFF_WD2 = OFF_WGU2 + SZ_WGU, OFF_WIN = OFF_WD2 + SZ_WD, OFF_WOUT = OFF_WIN + SZ_WIN;
constexpr size_t OFF_MOD = OFF_WOUT + SZ_WOUT;
constexpr size_t OFF_XC1 = OFF_MOD + (size_t)33 * 9216 * 4;
constexpr size_t OFF_DT = OFF_XC1 + (size_t)TCX * 1024 * 4;
constexpr size_t SZ_A16 = (size_t)TT * 16 * 4;
constexpr size_t OFF_DTF = OFF_DT + (size_t)TT * 32 * 4, OFF_DTB = OFF_DTF + SZ_A16, OFF_CSF = OFF_DTB + SZ_A16, OFF_CSB = OFF_CSF + SZ_A16;
constexpr size_t OFF_CDEC = OFF_CSB + SZ_A16;
constexpr size_t OFF_BIG = OFF_CDEC + (size_t)32 * 2 * 18 * 16 * 4;
constexpr size_t SZ_H = (size_t)TT * 1024 * 2, SZ_ACT = (size_t)TT * DFF * 2, SZ_ST = (size_t)32 * 2 * 17 * 16 * 8192 * 2;
constexpr size_t OFF_H = OFF_BIG, OFF_ACT = OFF_BIG + SZ_H, OFF_ST = OFF_BIG;
constexpr size_t WS_TOTAL = (size_t)1 << 30;
constexpr size_t OFF_U = WS_TOTAL - (size_t)TX * 1024 * 2, OFF_XBC = OFF_U - (size_t)TT * 1536 * 2, OFF_Y = OFF_XBC - (size_t)TX * 2048 * 2;
static_assert(OFF_BIG % 256 == 0 && OFF_ACT + SZ_ACT <= WS_TOTAL && OFF_Y >= OFF_ST + SZ_ST && OFF_Y >= OFF_H + SZ_H, "workspace map");

struct Params {
    const float *x, *c, *ctx, *c_ctx, *w_mod, *b_mod, *norm_ffn1, *g1, *u1, *d1, *norm_mix, *w_in, *scw, *scb, *dtbf, *dtbb, *alf, *alb, *ssm_d, *ssm_nw, *ccw, *ccb, *lnw, *lnb,
        *w_out, *norm_ffn2, *g2, *u2, *d2, *fnorm;
    float* out; unsigned char* ws; int ph_lo, ph_hi;
};

__device__ __forceinline__ float bf2f(u16 v) { return __uint_as_float(((u32)v) << 16); }
__device__ __forceinline__ u16 f2bf(float f) { u32 u = __float_as_uint(f); u += 0x7FFFu + ((u >> 16) & 1u); return (u16)(u >> 16); }
__device__ __forceinline__ float lo_f(u32 v) { return __uint_as_float(v << 16); }
__device__ __forceinline__ float hi_f(u32 v) { return __uint_as_float(v & 0xffff0000u); }
__device__ __forceinline__ float silu_f(float x) { return x / (1.0f + __expf(-x)); }
__device__ __forceinline__ float sigm_f(float x) { return 1.0f / (1.0f + __expf(-x)); }
__device__ __forceinline__ float wave_sum(float v) {
#pragma unroll
    for (int o = 32; o >= 1; o >>= 1) v += __shfl_xor(v, o);
    return v;
}

struct InOrder : StaticOrder {
    __device__ bool next(int i, Unit& u) const {
        const long L = (long)i * G + c;
        if (L < nwg) return StaticOrder::next(i, u);
        const int e = (int)(L - nwg); if (e >= 192) return false;
        u.pm = 256 + (e & 31); u.pn = e >> 5; return true;
    }
};

struct EpiSwiGLU {
    static constexpr bool PERM = true, AFTER_DRAIN = false;
    bf16_t* O;
    __device__ __forceinline__ void operator()(const f32x4 (&acc)[2][2][4][2], const Unit& u, int wr, int wc, int fr, int fq) const {
        const int row0 = u.pm * BM + wr * 64 + fr, col0 = u.pn * 128 + wc * 32 + 8 * fq;
#pragma unroll
        for (int ai = 0; ai < 2; ++ai)
#pragma unroll
            for (int m = 0; m < 4; ++m) {
                bf16_t* rowp = O + (size_t)(row0 + ai * HALF + m * 16) * DFF + col0;
                const f32x4 g0 = acc[ai][0][m][0], g1 = acc[ai][0][m][1], u0 = acc[ai][1][m][0], u1 = acc[ai][1][m][1];
                u32x4 w;
                w.x = cvt_pk_bf16(silu_f(g0[0]) * u0[0], silu_f(g0[1]) * u0[1]); w.y = cvt_pk_bf16(silu_f(g0[2]) * u0[2], silu_f(g0[3]) * u0[3]);
                w.z = cvt_pk_bf16(silu_f(g1[0]) * u1[0], silu_f(g1[1]) * u1[1]); w.w = cvt_pk_bf16(silu_f(g1[2]) * u1[2], silu_f(g1[3]) * u1[3]);
                *(u32x4*)rowp = w;
            }
    }
};

struct EpiResid {
    static constexpr bool PERM = false, AFTER_DRAIN = false;
    const float* baseX; float* outX; const float* baseC; float* outC; const float* mod; float s;
    __device__ __forceinline__ void operator()(const f32x4 (&acc)[2][2][4][2], const Unit& u, int wr, int wc, int fr, int fq) const {
        const int row0 = u.pm * BM + wr * 64 + fr, col0 = u.pn * BM + wc * 32 + 4 * fq;
        const bool isx = u.pm < 256; const int b = isx ? (u.pm >> 3) : 32;
        const float* bp0 = isx ? baseX + (size_t)row0 * 1024 : baseC + (size_t)(row0 - TX) * 1024;
        float* op0 = isx ? outX + (size_t)row0 * 1024 : outC + (size_t)(row0 - TX) * 1024;
        f32x4 mv[2][2];
#pragma unroll
        for (int bj = 0; bj < 2; ++bj)
#pragma unroll
            for (int n = 0; n < 2; ++n) mv[bj][n] = *(const f32x4*)(mod + (size_t)b * 9216 + col0 + bj * HALF + n * 16) * s;
#pragma unroll
        for (int ai = 0; ai < 2; ++ai)
#pragma unroll
            for (int m = 0; m < 4; ++m) {
                const size_t ro = (size_t)(ai * HALF + m * 16) * 1024 + col0;
#pragma unroll
                for (int bj = 0; bj < 2; ++bj)
#pragma unroll
                    for (int n = 0; n < 2; ++n) {
                        const f32x4 bv = *(const f32x4*)(bp0 + ro + bj * HALF + n * 16);
                        *(f32x4*)(op0 + ro + bj * HALF + n * 16) = bv + mv[bj][n] * acc[ai][bj][m][n];
                    }
            }
    }
};

struct EpiInProj {
    static constexpr bool PERM = true, AFTER_DRAIN = false;
    bf16_t* XBC; float* DT; bf16_t* Y; bf16_t* U;
    __device__ __forceinline__ void operator()(const f32x4 (&acc)[2][2][4][2], const Unit& u, int wr, int wc, int fr, int fq) const {
        const int row0 = u.pm * BM + wr * 64 + fr, cin = wc * 32 + 8 * fq, pn = u.pn;
        if (pn == 5) {
            if (wc == 0) {
#pragma unroll
                for (int ai = 0; ai < 2; ++ai)
#pragma unroll
                    for (int m = 0; m < 4; ++m) {
                        float* rp = DT + (size_t)(row0 + ai * HALF + m * 16) * 32 + 8 * fq;
                        *(f32x4*)rp = acc[ai][0][m][0]; *(f32x4*)(rp + 4) = acc[ai][0][m][1];
                    }
            }
        } else if (pn <= 10) {
            bf16_t* base; int ld;
            if (pn <= 4) { base = XBC + pn * 256; ld = 1536; } else if (pn == 6) { base = XBC + 1280; ld = 1536; } else { base = Y + (pn - 7) * 256; ld = 2048; }
#pragma unroll
            for (int ai = 0; ai < 2; ++ai)
#pragma unroll
                for (int m = 0; m < 4; ++m) {
                    bf16_t* rowp = base + (size_t)(row0 + ai * HALF + m * 16) * ld + cin;
#pragma unroll
                    for (int bj = 0; bj < 2; ++bj) {
                        const f32x4 v0 = acc[ai][bj][m][0], v1 = acc[ai][bj][m][1];
                        u32x4 w; w.x = cvt_pk_bf16(v0[0], v0[1]); w.y = cvt_pk_bf16(v0[2], v0[3]); w.z = cvt_pk_bf16(v1[0], v1[1]); w.w = cvt_pk_bf16(v1[2], v1[3]);
                        *(u32x4*)(rowp + bj * HALF) = w;
                    }
                }
        } else {
            bf16_t* base = U + (pn - 11) * 128 + cin;
#pragma unroll
            for (int ai = 0; ai < 2; ++ai)
#pragma unroll
                for (int m = 0; m < 4; ++m) {
                    bf16_t* rowp = base + (size_t)(row0 + ai * HALF + m * 16) * 1024;
                    const f32x4 a0 = acc[ai][0][m][0], a1 = acc[ai][0][m][1], b0 = acc[ai][1][m][0], b1 = acc[ai][1][m][1];
                    u32x4 w;
                    w.x = cvt_pk_bf16(a0[0] * sigm_f(b0[0]), a0[1] * sigm_f(b0[1])); w.y = cvt_pk_bf16(a0[2] * sigm_f(b0[2]), a0[3] * sigm_f(b0[3]));
                    w.z = cvt_pk_bf16(a1[0] * sigm_f(b1[0]), a1[1] * sigm_f(b1[1])); w.w = cvt_pk_bf16(a1[2] * sigm_f(b1[2]), a1[3] * sigm_f(b1[3]));
                    *(u32x4*)rowp = w;
                }
        }
    }
};

__device__ __forceinline__ void prep_mod_item(const Params& P, LAS unsigned char* lds, int it) {
    const int tid = threadIdx.x;
    LAS float* cc = (LAS float*)lds;
    for (int i = tid; i < 33 * 1024; i += 512) { const int r = i >> 10, k = i & 1023; const float v = (r < 32) ? P.c[r * 1024 + k] : P.c_ctx[k]; cc[i] = silu_f(v); }
    __syncthreads();
    const int n0 = it * 64, col = tid & 63, kk = tid >> 6;
    float acc[33];
#pragma unroll
    for (int r = 0; r < 33; ++r) acc[r] = 0.f;
    const float* wp = P.w_mod + (size_t)(kk * 128) * 9216 + n0 + col;
    for (int k4 = 0; k4 < 32; ++k4) {
        const float w0 = wp[(size_t)(k4 * 4 + 0) * 9216], w1 = wp[(size_t)(k4 * 4 + 1) * 9216], w2 = wp[(size_t)(k4 * 4 + 2) * 9216], w3 = wp[(size_t)(k4 * 4 + 3) * 9216];
#pragma unroll
        for (int r = 0; r < 33; ++r) { const f32x4 c4 = *(const LAS f32x4*)(cc + r * 1024 + kk * 128 + k4 * 4); acc[r] += c4[0] * w0 + c4[1] * w1 + c4[2] * w2 + c4[3] * w3; }
    }
    __syncthreads();
    LAS float* red = (LAS float*)lds;
#pragma unroll
    for (int r = 0; r < 33; ++r) red[(kk * 33 + r) * 64 + col] = acc[r];
    __syncthreads();
    float* MOD = (float*)(P.ws + OFF_MOD);
    for (int o = tid; o < 33 * 64; o += 512) { const int r = o >> 6, cl = o & 63; float s = 0.f;
#pragma unroll
        for (int q = 0; q < 8; ++q) s += red[(q * 33 + r) * 64 + cl];
        MOD[(size_t)r * 9216 + n0 + cl] = s + P.b_mod[n0 + cl]; }
    __syncthreads();
}

__device__ __forceinline__ void prep_tile(const Params& P, LAS unsigned char* lds, int t) {
    const int tid = threadIdx.x;
    const float* src; int sld, scol0, nvalid = 64, kt, n0, dld; u16* dst;
    if (t < 2816) {
        const int f = t >= 1408; const int tt = t - f * 1408; const int nt = tt >> 4; kt = tt & 15; n0 = nt * 64;
        const int j = n0 >> 8, s0 = n0 & 255;
        src = (s0 < 128) ? (f ? P.g2 : P.g1) : (f ? P.u2 : P.u1); scol0 = 128 * j + (s0 & 127); sld = DFF;
        dst = (u16*)(P.ws + (f ? OFF_WGU2 : OFF_WGU1)); dld = 1024;
    } else if (t < 2816 + 1408) {
        const int t2 = t - 2816; const int f = t2 >= 704; const int tt = t2 - f * 704; const int nt = tt / 44; kt = tt % 44; n0 = nt * 64;
        src = f ? P.d2 : P.d1; scol0 = n0; sld = 1024; dst = (u16*)(P.ws + (f ? OFF_WD2 : OFF_WD1)); dld = DFF;
    } else if (t < 2816 + 1408 + 1216) {
        const int tt = t - 4224; const int nt = tt >> 4; kt = tt & 15; n0 = nt * 64;
        const int pn = n0 >> 8, s0 = n0 & 255;
        if (pn < 4) scol0 = 1024 + n0; else if (pn == 4) scol0 = 2048 + s0; else if (pn == 5) { scol0 = 2560 + (s0 ? 0 : 0); nvalid = s0 ? 0 : 32; }
        else if (pn == 6) scol0 = 2304 + s0; else if (pn <= 10) scol0 = n0 - 1792;
        else { const int j = pn - 11; scol0 = (s0 < 128) ? (2592 + 128 * j + s0) : (2592 + 1024 + 128 * j + (s0 - 128)); }
        src = P.w_in; sld = 4640; dst = (u16*)(P.ws + OFF_WIN); dld = 1024;
    } else {
        const int tt = t - 5440; const int nt = tt >> 5; kt = tt & 31; n0 = nt * 64;
        src = P.w_out; scol0 = n0; sld = 1024; dst = (u16*)(P.ws + OFF_WOUT); dld = 2048;
    }
    LAS float* tile = (LAS float*)lds;
#pragma unroll
    for (int e = 0; e < 8; ++e) { const int idx = tid + 512 * e, kk = idx >> 6, nn = idx & 63;
        tile[kk * 65 + nn] = (nn < nvalid) ? src[(size_t)(kt * 64 + kk) * sld + scol0 + nn] : 0.f; }
    __syncthreads();
    { const int nn = tid >> 3, ks = (tid & 7) * 8; u32x4 w;
      w.x = cvt_pk_bf16(tile[(ks + 0) * 65 + nn], tile[(ks + 1) * 65 + nn]); w.y = cvt_pk_bf16(tile[(ks + 2) * 65 + nn], tile[(ks + 3) * 65 + nn]);
      w.z = cvt_pk_bf16(tile[(ks + 4) * 65 + nn], tile[(ks + 5) * 65 + nn]); w.w = cvt_pk_bf16(tile[(ks + 6) * 65 + nn], tile[(ks + 7) * 65 + nn]);
      *(u32x4*)(dst + (size_t)(n0 + nn) * dld + kt * 64 + ks) = w; }
    __syncthreads();
}

__device__ __forceinline__ void phase_prep(const Params& P, LAS unsigned char* lds) {
    constexpr int NMOD = 144, NTILE = 2816 + 1408 + 1216 + 512;
    for (int it = blockIdx.x; it < NMOD + NTILE; it += gridDim.x) { if (it < NMOD) prep_mod_item(P, lds, it); else prep_tile(P, lds, it - NMOD); }
}

template <int MODE>
__device__ __forceinline__ void phase_norm(const Params& P, const float* srcX, const float* srcC, int nrows, const float* nw, int shIdx, int scIdx, u16* H, float* outF) {
    const int lane = threadIdx.x & 63, gw = blockIdx.x * 8 + (threadIdx.x >> 6), nwv = gridDim.x * 8;
    const float* MOD = (const float*)(P.ws + OFF_MOD);
    for (int row = gw; row < nrows; row += nwv) {
        const float* src = (row < TX) ? srcX + (size_t)row * 1024 : srcC + (size_t)(row - TX) * 1024;
        const int b = (row < TX) ? (row >> 11) : 32;
        f32x4 v[4]; float ss = 0.f;
#pragma unroll
        for (int i = 0; i < 4; ++i) { v[i] = *(const f32x4*)(src + i * 256 + lane * 4); ss += v[i][0] * v[i][0] + v[i][1] * v[i][1] + v[i][2] * v[i][2] + v[i][3] * v[i][3]; }
        ss = wave_sum(ss);
        const float rstd = rsqrtf(ss * (1.0f / 1024.0f) + EPSF);
#pragma unroll
        for (int i = 0; i < 4; ++i) { const int col = i * 256 + lane * 4; const f32x4 w = *(const f32x4*)(nw + col);
            if (MODE == 0) {
                const f32x4 sh = *(const f32x4*)(MOD + (size_t)b * 9216 + shIdx * 1024 + col), sc = *(const f32x4*)(MOD + (size_t)b * 9216 + scIdx * 1024 + col);
                const f32x4 o = (v[i] * rstd * w) * (sc + 1.0f) + sh;
                uint2 pk; pk.x = cvt_pk_bf16(o[0], o[1]); pk.y = cvt_pk_bf16(o[2], o[3]);
                *(uint2*)(H + (size_t)row * 1024 + col) = pk;
            } else { *(f32x4*)(outF + (size_t)row * 1024 + col) = v[i] * rstd * w; } }
    }
}

template <int NC>
__device__ __forceinline__ void stage_conv(LAS u16* dst, int ld, const u16* XBC, int row0, int seq0, int seq1, int col0, const float* cw, const float* cb) {
    constexpr int NP = NC / 2, NTG = 512 / NP, TPG = 128 / NTG;
    const int tid = threadIdx.x, cp = tid % NP, tg = tid / NP, ch = col0 + 2 * cp, l0 = tg * TPG;
    float w0[5], w1[5];
#pragma unroll
    for (int k = 0; k < 5; ++k) { w0[k] = cw[k * 1536 + ch]; w1[k] = cw[k * 1536 + ch + 1]; }
    const float b0 = cb[ch], b1 = cb[ch + 1];
    u32 win[5] = {0u, 0u, 0u, 0u, 0u};
#pragma unroll
    for (int i = 0; i < TPG + 4; ++i) {
        const int r = row0 + l0 - 2 + i;
        u32 v = 0u; if (r >= seq0 && r < seq1) v = *(const u32*)(XBC + (size_t)r * 1536 + ch);
        win[0] = win[1]; win[1] = win[2]; win[2] = win[3]; win[3] = win[4]; win[4] = v;
        if (i >= 4) {
            float a0 = b0, a1 = b1;
#pragma unroll
            for (int k = 0; k < 5; ++k) { a0 += w0[k] * lo_f(win[k]); a1 += w1[k] * hi_f(win[k]); }
            *(LAS u32*)(dst + (l0 + i - 4) * ld + 2 * cp) = cvt_pk_bf16(silu_f(a0), silu_f(a1));
        }
    }
}

__device__ __forceinline__ void dtprep_item(const Params& P, LAS unsigned char* lds, int tc) {
    const int tid = threadIdx.x, dh = tid & 31, seg = tid >> 5, dir = dh >> 4, h = dh & 15;
    const bool isx = tc < 512; const int b = isx ? (tc >> 4) : ((tc - 512) >> 1); const int cidx = isx ? (tc & 15) : ((tc - 512) & 1);
    const int row0 = tc * 128;
    const int jscan = isx ? (dir ? 17 - cidx : cidx + 2) : (dir ? 1 - cidx : cidx);
    const float bias = dir ? P.dtbb[h] : P.dtbf[h]; const float a = -__expf(dir ? P.alb[h] : P.alf[h]);
    const float* DT = (const float*)(P.ws + OFF_DT);
    float dt[8], cs[8];
#pragma unroll
    for (int i = 0; i < 8; ++i) { const float raw = DT[(size_t)(row0 + seg * 8 + i) * 32 + dh] + bias; dt[i] = (raw > 20.f) ? raw : log1pf(__expf(raw)); }
    float run = 0.f;
    if (dir == 0) {
#pragma unroll
        for (int i = 0; i < 8; ++i) { run += dt[i] * a; cs[i] = run; }
    } else {
#pragma unroll
        for (int i = 7; i >= 0; --i) { run += dt[i] * a; cs[i] = run; }
    }
    LAS float* segsum = (LAS float*)lds;
    segsum[seg * 32 + dh] = run;
    __syncthreads();
    float off = 0.f, tot = 0.f;
#pragma unroll
    for (int s2 = 0; s2 < 16; ++s2) { const float v = segsum[s2 * 32 + dh]; tot += v; if (dir == 0 ? (s2 < seg) : (s2 > seg)) off += v; }
    float* DTO = (float*)(P.ws + (dir ? OFF_DTB : OFF_DTF)); float* CSO = (float*)(P.ws + (dir ? OFF_CSB : OFF_CSF));
#pragma unroll
    for (int i = 0; i < 8; ++i) { const size_t o = (size_t)(row0 + seg * 8 + i) * 16 + h; DTO[o] = dt[i]; CSO[o] = cs[i] + off; }
    if (seg == 0) ((float*)(P.ws + OFF_CDEC))[((b * 2 + dir) * 18 + jscan) * 16 + h] = __expf(tot);
    __syncthreads();
}

__device__ __forceinline__ void uconv_item(const Params& P, LAS unsigned char* lds, int item) {
    const int tid = threadIdx.x; const bool isH = item < 1024; const int e = item & 1023, b = e >> 5, q = e & 31;
    LAS u32* in = (LAS u32*)lds;
    const u16* Ug = (const u16*)(P.ws + OFF_U); u16* Yg = (u16*)(P.ws + OFF_Y);
    const int choff = isH ? 0 : 512;
#pragma unroll
    for (int i = 0; i < 8; ++i) { const int idx = tid + 512 * i, tok = idx >> 6, c16 = idx & 63; int grow, lrow;
        if (isH) { grow = b * 2048 + q * 64 + tok; lrow = 15 + tok; } else { const int line = tok >> 5, rr = tok & 31; grow = b * 2048 + rr * 64 + 2 * q + line; lrow = line * 62 + 15 + rr; }
        *(LAS u32x4*)(in + lrow * 256 + c16 * 4) = *(const u32x4*)(Ug + (size_t)grow * 1024 + choff + c16 * 8); }
    { const int npad = isH ? 30 : 60;
      for (int idx = tid; idx < npad * 64; idx += 512) { const int pr = idx >> 6, c16 = idx & 63; int lrow;
          if (isH) lrow = (pr < 15) ? pr : 64 + pr; else { const int line = pr / 30, k = pr % 30; lrow = line * 62 + ((k < 15) ? k : 32 + k); }
          *(LAS u32x4*)(in + lrow * 256 + c16 * 4) = (u32x4){0u, 0u, 0u, 0u}; } }
    __syncthreads();
    const int cp = tid & 255, half = tid >> 8, ch = choff + 2 * cp;
    float w0[31], w1[31];
#pragma unroll
    for (int k = 0; k < 31; ++k) { w0[k] = P.ccw[k * 1024 + ch]; w1[k] = P.ccw[k * 1024 + ch + 1]; }
    const float b0 = P.ccb[ch], b1 = P.ccb[ch + 1];
    const int base_row = isH ? 32 * half : 62 * half;
    for (int oo = 0; oo < 32; ++oo) {
        float a0 = b0, a1 = b1;
        const LAS u32* pr = in + (base_row + oo) * 256 + cp;
#pragma unroll
        for (int k = 0; k < 31; ++k) { const u32 v = pr[k * 256]; a0 += w0[k] * lo_f(v); a1 += w1[k] * hi_f(v); }
        const int grow = isH ? (b * 2048 + q * 64 + 32 * half + oo) : (b * 2048 + oo * 64 + 2 * q + half);
        *(u32*)(Yg + (size_t)grow * 2048 + 1024 + ch) = cvt_pk_bf16(a0, a1);
    }
    __syncthreads();
}

__device__ __forceinline__ void phase_p6(const Params& P, LAS unsigned char* lds) {
    for (int it = blockIdx.x; it < 576 + 2048; it += gridDim.x) { if (it < 576) dtprep_item(P, lds, it); else uconv_item(P, lds, it - 576); }
}

__device__ __forceinline__ bf16x8 gather8(const LAS u16* p, int stride) {
    bf16x8 r;
#pragma unroll
    for (int j = 0; j < 8; ++j) r[j] = (short)p[j * stride];
    return r;
}
#define MFMA32(a, b, c) __builtin_amdgcn_mfma_f32_32x32x16_bf16((a), (b), (c), 0, 0, 0)

__device__ __forceinline__ void s1_item(const Params& P, LAS unsigned char* lds, int item) {
    const int tid = threadIdx.x, w = tid >> 6, lane = tid & 63, r = lane & 31, hf = lane >> 5;
    const int g = item & 1, tc = (item >> 1) % 18, b = item / 36;
    const bool isx = tc < 16;
    const int seq0 = isx ? b * 2048 : TX + b * 256, seq1 = seq0 + (isx ? 2048 : 256), row0 = seq0 + 128 * (isx ? tc : tc - 16);
    const int jf = isx ? tc + 2 : tc - 16, jb = isx ? 17 - tc : 17 - tc;
    LAS u16* Bs = (LAS u16*)lds;
    LAS u16* Xs = (LAS u16*)(lds + 34816);
    LAS float* wfb = (LAS float*)(lds + 34816 + 18432);
    const u16* XBC = (const u16*)(P.ws + OFF_XBC);
    const float *CSF = (const float*)(P.ws + OFF_CSF), *CSB = (const float*)(P.ws + OFF_CSB), *DTF = (const float*)(P.ws + OFF_DTF), *DTB = (const float*)(P.ws + OFF_DTB);
    u16* ST = (u16*)(P.ws + OFF_ST);
    stage_conv<128>(Bs, 136, XBC, row0, seq0, seq1, 1024 + 128 * g, P.scw, P.scb);
    __syncthreads();
    const int pb = w >> 2, nb = w & 3;
    bf16x8 Bf[8];
#pragma unroll
    for (int ks = 0; ks < 8; ++ks) Bf[ks] = gather8(Bs + (16 * ks + 8 * hf) * 136 + 32 * nb + r, 136);
    for (int hh = 0; hh < 8; ++hh) {
        const int h = 8 * g + hh;
        stage_conv<64>(Xs, 72, XBC, row0, seq0, seq1, 64 * h, P.scw, P.scb);
        if (tid < 256) { const int l = tid & 127;
            if (tid < 128) wfb[l] = __expf(CSF[(size_t)(row0 + 127) * 16 + h] - CSF[(size_t)(row0 + l) * 16 + h]) * DTF[(size_t)(row0 + l) * 16 + h];
            else wfb[128 + l] = __expf(CSB[(size_t)row0 * 16 + h] - CSB[(size_t)(row0 + l) * 16 + h]) * DTB[(size_t)(row0 + l) * 16 + h]; }
        __syncthreads();
        f32x16 accf, accb;
#pragma unroll
        for (int i = 0; i < 16; ++i) { accf[i] = 0.f; accb[i] = 0.f; }
#pragma unroll
        for (int ks = 0; ks < 8; ++ks) {
            const int lb = 16 * ks + 8 * hf;
            float xv[8];
#pragma unroll
            for (int j = 0; j < 8; ++j) xv[j] = bf2f(Xs[(lb + j) * 72 + 32 * pb + r]);
            bf16x8 af, ab;
            u32 t;
#pragma unroll
            for (int j = 0; j < 8; j += 2) {
                t = cvt_pk_bf16(xv[j] * wfb[lb + j], xv[j + 1] * wfb[lb + j + 1]); af[j] = (short)(t & 0xffffu); af[j + 1] = (short)(t >> 16);
                t = cvt_pk_bf16(xv[j] * wfb[128 + lb + j], xv[j + 1] * wfb[128 + lb + j + 1]); ab[j] = (short)(t & 0xffffu); ab[j + 1] = (short)(t >> 16);
            }
            accf = MFMA32(af, Bf[ks], accf); accb = MFMA32(ab, Bf[ks], accb);
        }
        const int n = 32 * nb + r;
        if (jf <= 16) { u16* sp = ST + ((size_t)((b * 2 + 0) * 17 + jf) * 16 + h) * 8192;
#pragma unroll
            for (int i = 0; i < 16; ++i) { const int p = 32 * pb + (i & 3) + 8 * (i >> 2) + 4 * hf; sp[p * 128 + n] = f2bf(accf[i]); } }
        if (jb <= 16) { u16* sp = ST + ((size_t)((b * 2 + 1) * 17 + jb) * 16 + h) * 8192;
#pragma unroll
            for (int i = 0; i < 16; ++i) { const int p = 32 * pb + (i & 3) + 8 * (i >> 2) + 4 * hf; sp[p * 128 + n] = f2bf(accb[i]); } }
        __syncthreads();
    }
}

__device__ __forceinline__ void phase_s2(const Params& P) {
    u16* ST = (u16*)(P.ws + OFF_ST); const float* CDEC = (const float*)(P.ws + OFF_CDEC);
    const int nth = gridDim.x * 512;
    for (int v = blockIdx.x * 512 + threadIdx.x; v < 32 * 2 * 16 * 1024; v += nth) {
        const int pn = (v & 1023) * 8, h = (v >> 10) & 15, bd = v >> 14;
        float hs[8];
#pragma unroll
        for (int j = 0; j < 8; ++j) hs[j] = 0.f;
        for (int s = 0; s < 17; ++s) {
            u16* ptr = ST + ((size_t)(bd * 17 + s) * 16 + h) * 8192 + pn; const float dec = CDEC[(bd * 18 + s) * 16 + h];
            const u32x4 q = *(const u32x4*)ptr;
            hs[0] = hs[0] * dec + lo_f(q.x); hs[1] = hs[1] * dec + hi_f(q.x); hs[2] = hs[2] * dec + lo_f(q.y); hs[3] = hs[3] * dec + hi_f(q.y);
            hs[4] = hs[4] * dec + lo_f(q.z); hs[5] = hs[5] * dec + hi_f(q.z); hs[6] = hs[6] * dec + lo_f(q.w); hs[7] = hs[7] * dec + hi_f(q.w);
            u32x4 o; o.x = cvt_pk_bf16(hs[0], hs[1]); o.y = cvt_pk_bf16(hs[2], hs[3]); o.z = cvt_pk_bf16(hs[4], hs[5]); o.w = cvt_pk_bf16(hs[6], hs[7]);
            *(u32x4*)ptr = o;
        }
    }
}

__device__ __forceinline__ void s3_item(const Params& P, LAS unsigned char* lds, int item) {
    const int tid = threadIdx.x, w = tid >> 6, lane = tid & 63, r = lane & 31, hf = lane >> 5;
    const int g = item & 1, c = (item >> 1) & 15, b = item >> 5;
    const int seq0 = b * 2048, seq1 = seq0 + 2048, row0 = seq0 + 128 * c;
    LAS u16* Cs = (LAS u16*)lds;
    LAS u16* Ms = (LAS u16*)(lds + 34816);
    LAS u16* Gs = (LAS u16*)(lds + 69632);
    LAS u16* Xs = (LAS u16*)(lds + 104448);
    LAS u16* Hf = (LAS u16*)(lds + 122880);
    LAS u16* Hb = (LAS u16*)(lds + 140288);
    LAS float* ar = (LAS float*)(lds + 157696);
    LAS float* ssq = (LAS float*)(lds + 159744);
    const u16* XBC = (const u16*)(P.ws + OFF_XBC); const u16* ST = (const u16*)(P.ws + OFF_ST); u16* Yg = (u16*)(P.ws + OFF_Y);
    const float *CSF = (const float*)(P.ws + OFF_CSF), *CSB = (const float*)(P.ws + OFF_CSB), *DTF = (const float*)(P.ws + OFF_DTF), *DTB = (const float*)(P.ws + OFF_DTB);
    stage_conv<128>(Cs, 136, XBC, row0, seq0, seq1, 1280 + 128 * g, P.scw, P.scb);
    stage_conv<128>(Ms, 136, XBC, row0, seq0, seq1, 1024 + 128 * g, P.scw, P.scb);
    if (tid < 128) ssq[tid] = 0.f;
    __syncthreads();
    {
        const int wr2 = w >> 1, wc2 = w & 1;
        f32x16 g0, g1;
#pragma unroll
        for (int i = 0; i < 16; ++i) { g0[i] = 0.f; g1[i] = 0.f; }
#pragma unroll
        for (int ks = 0; ks < 8; ++ks) {
            const bf16x8 a = *(const LAS bf16x8*)(Cs + (32 * wr2 + r) * 136 + 16 * ks + 8 * hf);
            const bf16x8 b0 = *(const LAS bf16x8*)(Ms + (64 * wc2 + r) * 136 + 16 * ks + 8 * hf);
            const bf16x8 b1 = *(const LAS bf16x8*)(Ms + (64 * wc2 + 32 + r) * 136 + 16 * ks + 8 * hf);
            g0 = MFMA32(a, b0, g0); g1 = MFMA32(a, b1, g1);
        }
#pragma unroll
        for (int i = 0; i < 16; ++i) { const int l = 32 * wr2 + (i & 3) + 8 * (i >> 2) + 4 * hf;
            Gs[l * 136 + 64 * wc2 + r] = f2bf(g0[i]); Gs[l * 136 + 64 * wc2 + 32 + r] = f2bf(g1[i]); }
    }
    float sq[16];
#pragma unroll
    for (int i = 0; i < 16; ++i) sq[i] = 0.f;
    const int rb = w >> 1, cb2 = w & 1;
    for (int hh = 0; hh < 8; ++hh) {
        const int h = 8 * g + hh;
        __syncthreads();
        stage_conv<64>(Xs, 72, XBC, row0, seq0, seq1, 64 * h, P.scw, P.scb);
        { const u16* stf = ST + ((size_t)((b * 2 + 0) * 17 + (c + 1)) * 16 + h) * 8192; const u16* stb = ST + ((size_t)((b * 2 + 1) * 17 + (16 - c)) * 16 + h) * 8192;
#pragma unroll
          for (int i = 0; i < 4; ++i) { const int idx = tid + 512 * i, mat = idx >> 10, chk = idx & 1023, p = chk >> 4, n8 = (chk & 15) * 8;
              *(LAS u32x4*)((mat ? Hb : Hf) + p * 136 + n8) = *(const u32x4*)((mat ? stb : stf) + p * 128 + n8); } }
        { const int which = tid >> 7, l = tid & 127; const float* srcp = (which == 0) ? CSF : (which == 1) ? CSB : (which == 2) ? DTF : DTB; ar[which * 128 + l] = srcp[(size_t)(row0 + l) * 16 + h]; }
        __syncthreads();
        {
            const int l = tid >> 2, s0 = (tid & 3) * 32; const float csf_l = ar[l], csb_l = ar[128 + l], dg = ar[256 + l] + ar[384 + l], dsk = P.ssm_d[h];
#pragma unroll
            for (int s8 = 0; s8 < 4; ++s8) { const int s = s0 + 8 * s8; const bf16x8 gv = *(const LAS bf16x8*)(Gs + l * 136 + s); float o[8];
#pragma unroll
                for (int j = 0; j < 8; ++j) { const int ss = s + j; float f;
                    if (ss < l) f = __expf(csf_l - ar[ss]) * ar[256 + ss]; else if (ss > l) f = __expf(csb_l - ar[128 + ss]) * ar[384 + ss]; else f = dg;
                    o[j] = bf2f((u16)gv[j]) * f + ((ss == l) ? dsk : 0.f); }
                u32x4 q; q.x = cvt_pk_bf16(o[0], o[1]); q.y = cvt_pk_bf16(o[2], o[3]); q.z = cvt_pk_bf16(o[4], o[5]); q.w = cvt_pk_bf16(o[6], o[7]);
                *(LAS u32x4*)(Ms + l * 136 + s) = q; }
        }
        __syncthreads();
        f32x16 ad, af, ab;
#pragma unroll
        for (int i = 0; i < 16; ++i) { ad[i] = 0.f; af[i] = 0.f; ab[i] = 0.f; }
#pragma unroll
        for (int ks = 0; ks < 8; ++ks) {
            const int ko = 16 * ks + 8 * hf;
            const bf16x8 am = *(const LAS bf16x8*)(Ms + (32 * rb + r) * 136 + ko);
            const bf16x8 bx = gather8(Xs + ko * 72 + 32 * cb2 + r, 72);
            ad = MFMA32(am, bx, ad);
            const bf16x8 ac = *(const LAS bf16x8*)(Cs + (32 * rb + r) * 136 + ko);
            const bf16x8 bhf = *(const LAS bf16x8*)(Hf + (32 * cb2 + r) * 136 + ko);
            const bf16x8 bhb = *(const LAS bf16x8*)(Hb + (32 * cb2 + r) * 136 + ko);
            af = MFMA32(ac, bhf, af); ab = MFMA32(ac, bhb, ab);
        }
#pragma unroll
        for (int i = 0; i < 16; ++i) { const int l = 32 * rb + (i & 3) + 8 * (i >> 2) + 4 * hf;
            const float y = ad[i] + __expf(ar[l]) * af[i] + __expf(ar[128 + l]) * ab[i];
            u16* zp = Yg + (size_t)(row0 + l) * 2048 + 64 * h + 32 * cb2 + r;
            const float v = y * silu_f(bf2f(*zp)); *zp = f2bf(v); sq[i] += v * v; }
    }
#pragma unroll
    for (int i = 0; i < 16; ++i) { float s = sq[i];
#pragma unroll
        for (int o = 16; o >= 1; o >>= 1) s += __shfl_xor(s, o);
        if (r == 0) atomicAdd((float*)(ssq + 32 * rb + (i & 3) + 8 * (i >> 2) + 4 * hf), s); }
    __syncthreads();
#pragma unroll 4
    for (int i = 0; i < 16; ++i) { const int idx = tid + 512 * i, l = idx >> 6, c8 = (idx & 63) * 8;
        u16* yp = Yg + (size_t)(row0 + l) * 2048 + 512 * g + c8; const float rstd = rsqrtf(ssq[l] * (1.0f / 512.0f) + EPSF);
        const u32x4 q = *(const u32x4*)yp; const f32x4 w0 = *(const f32x4*)(P.ssm_nw + 512 * g + c8), w1 = *(const f32x4*)(P.ssm_nw + 512 * g + c8 + 4);
        u32x4 o; o.x = cvt_pk_bf16(lo_f(q.x) * rstd * w0[0], hi_f(q.x) * rstd * w0[1]); o.y = cvt_pk_bf16(lo_f(q.y) * rstd * w0[2], hi_f(q.y) * rstd * w0[3]);
        o.z = cvt_pk_bf16(lo_f(q.z) * rstd * w1[0], hi_f(q.z) * rstd * w1[1]); o.w = cvt_pk_bf16(lo_f(q.w) * rstd * w1[2], hi_f(q.w) * rstd * w1[3]);
        *(u32x4*)yp = o; }
    __syncthreads();
}

__device__ __forceinline__ void phase_lnb(const Params& P) {
    const int lane = threadIdx.x & 63, gw = blockIdx.x * 8 + (threadIdx.x >> 6), nwv = gridDim.x * 8;
    u16* Yg = (u16*)(P.ws + OFF_Y);
    for (int row = gw; row < TX; row += nwv) {
        u16* p = Yg + (size_t)row * 2048 + 1024 + lane * 8;
        const u32x4 q0 = *(const u32x4*)p, q1 = *(const u32x4*)(p + 512);
        float v[16] = {lo_f(q0.x), hi_f(q0.x), lo_f(q0.y), hi_f(q0.y), lo_f(q0.z), hi_f(q0.z), lo_f(q0.w), hi_f(q0.w), lo_f(q1.x), hi_f(q1.x), lo_f(q1.y), hi_f(q1.y), lo_f(q1.z), hi_f(q1.z), lo_f(q1.w), hi_f(q1.w)};
        float s = 0.f;
#pragma unroll
        for (int j = 0; j < 16; ++j) s += v[j];
        const float mu = wave_sum(s) * (1.0f / 1024.0f);
        float q = 0.f;
#pragma unroll
        for (int j = 0; j < 16; ++j) { v[j] -= mu; q += v[j] * v[j]; }
        const float rstd = rsqrtf(wave_sum(q) * (1.0f / 1024.0f) + EPSF);
        float o[16];
#pragma unroll
        for (int j = 0; j < 16; ++j) { const int col = (j < 8) ? (lane * 8 + j) : (512 + lane * 8 + j - 8); o[j] = silu_f(v[j] * rstd * P.lnw[col] + P.lnb[col]); }
        u32x4 a, bq; a.x = cvt_pk_bf16(o[0], o[1]); a.y = cvt_pk_bf16(o[2], o[3]); a.z = cvt_pk_bf16(o[4], o[5]); a.w = cvt_pk_bf16(o[6], o[7]);
        bq.x = cvt_pk_bf16(o[8], o[9]); bq.y = cvt_pk_bf16(o[10], o[11]); bq.z = cvt_pk_bf16(o[12], o[13]); bq.w = cvt_pk_bf16(o[14], o[15]);
        *(u32x4*)p = a; *(u32x4*)(p + 512) = bq;
    }
}

template <int PH> __device__ __forceinline__ void run_phase(const Params& P, LAS unsigned char* lds) {
    unsigned char* ws = P.ws;
    const float* MOD = (const float*)(ws + OFF_MOD);
    if constexpr (PH == 0) phase_prep(P, lds);
    if constexpr (PH == 1) phase_norm<0>(P, P.x, P.ctx, TT, P.norm_ffn1, 0, 1, (u16*)(ws + OFF_H), nullptr);
    if constexpr (PH == 2) { Gemm gm{(const bf16_t*)(ws + OFF_H), (const bf16_t*)(ws + OFF_WGU1), TT, NGU, 1024}; StaticOrder S; S.init(TT, NGU, (int)gridDim.x, (int)blockIdx.x);
        EpiSwiGLU E{(bf16_t*)(ws + OFF_ACT)}; gemm_phase<EpiSwiGLU, StaticOrder, false>(lds, gm, S, E, nullptr); }
    if constexpr (PH == 3) { Gemm gm{(const bf16_t*)(ws + OFF_ACT), (const bf16_t*)(ws + OFF_WD1), TT, 1024, DFF}; StaticOrder S; S.init(TT, 1024, (int)gridDim.x, (int)blockIdx.x);
        EpiResid E{P.x, P.out, P.ctx, (float*)(ws + OFF_XC1), MOD + 2 * 1024, 0.5f}; gemm_phase<EpiResid, StaticOrder, false>(lds, gm, S, E, nullptr); }
    if constexpr (PH == 4) phase_norm<0>(P, P.out, (const float*)(ws + OFF_XC1), TT, P.norm_mix, 3, 4, (u16*)(ws + OFF_H), nullptr);
    if constexpr (PH == 5) { Gemm gm{(const bf16_t*)(ws + OFF_H), (const bf16_t*)(ws + OFF_WIN), TX, NIN, 1024}; InOrder S; S.init(TX, NIN, (int)gridDim.x, (int)blockIdx.x);
        EpiInProj E{(bf16_t*)(ws + OFF_XBC), (float*)(ws + OFF_DT), (bf16_t*)(ws + OFF_Y), (bf16_t*)(ws + OFF_U)}; gemm_phase<EpiInProj, InOrder, false>(lds, gm, S, E, nullptr); }
    if constexpr (PH == 6) phase_p6(P, lds);
    if constexpr (PH == 7) { for (int it = blockIdx.x; it < 1152; it += gridDim.x) s1_item(P, lds, it); }
    if constexpr (PH == 8) phase_s2(P);
    if constexpr (PH == 9) { for (int it = blockIdx.x; it < 1024; it += gridDim.x) s3_item(P, lds, it); phase_lnb(P); }
    if constexpr (PH == 10) { Gemm gm{(const bf16_t*)(ws + OFF_Y), (const bf16_t*)(ws + OFF_WOUT), TX, 1024, 2048}; StaticOrder S; S.init(TX, 1024, (int)gridDim.x, (int)blockIdx.x);
        EpiResid E{P.out, P.out, nullptr, nullptr, MOD + 5 * 1024, 1.0f}; gemm_phase<EpiResid, StaticOrder, false>(lds, gm, S, E, nullptr); }
    if constexpr (PH == 11) phase_norm<0>(P, P.out, nullptr, TX, P.norm_ffn2, 6, 7, (u16*)(ws + OFF_H), nullptr);
    if constexpr (PH == 12) { Gemm gm{(const bf16_t*)(ws + OFF_H), (const bf16_t*)(ws + OFF_WGU2), TX, NGU, 1024}; StaticOrder S; S.init(TX, NGU, (int)gridDim.x, (int)blockIdx.x);
        EpiSwiGLU E{(bf16_t*)(ws + OFF_ACT)}; gemm_phase<EpiSwiGLU, StaticOrder, false>(lds, gm, S, E, nullptr); }
    if constexpr (PH == 13) { Gemm gm{(const bf16_t*)(ws + OFF_ACT), (const bf16_t*)(ws + OFF_WD2), TX, 1024, DFF}; StaticOrder S; S.init(TX, 1024, (int)gridDim.x, (int)blockIdx.x);
        EpiResid E{P.out, P.out, nullptr, nullptr, MOD + 8 * 1024, 0.5f}; gemm_phase<EpiResid, StaticOrder, false>(lds, gm, S, E, nullptr); }
    if constexpr (PH == 14) phase_norm<1>(P, P.out, nullptr, TX, P.fnorm, 0, 0, nullptr, P.out);
}

template <int PH> __global__ void __launch_bounds__(512, 2) k_one(Params P) {
    extern __shared__ __attribute__((aligned(16))) unsigned char shm[];
    run_phase<PH>(P, (LAS unsigned char*)shm);
}

template <int PH> __device__ __forceinline__ void run_all(const Params& P, LAS unsigned char* lds, cg::grid_group& grid) {
    run_phase<PH>(P, lds);
    if constexpr (PH + 1 < NPHASE) { grid.sync(); run_all<PH + 1>(P, lds, grid); }
}
__global__ void __launch_bounds__(512, 2) mega(Params P) {
    extern __shared__ __attribute__((aligned(16))) unsigned char shm[];
    cg::grid_group grid = cg::this_grid();
    run_all<0>(P, (LAS unsigned char*)shm, grid);
}

template <int PH> static void launch_each(int grid, hipStream_t stream, const Params& p) {
    static bool attr = false; if (!attr) { (void)hipFuncSetAttribute((const void*)k_one<PH>, hipFuncAttributeMaxDynamicSharedMemorySize, LDS_BYTES); attr = true; }
    hipLaunchKernelGGL(k_one<PH>, dim3(grid), dim3(512), LDS_BYTES, stream, p);
    if constexpr (PH + 1 < NPHASE) launch_each<PH + 1>(grid, stream, p);
}

#ifndef MK_MULTI
#define MK_MULTI 1
#endif
extern "C" void kernel_launch(void* const* d_in, const int* in_sizes, int n_in, void* d_out, int out_size, void* d_ws, size_t ws_size, hipStream_t stream) {
    static int grid = 0;
    if (grid == 0) {
        if (n_in != 30 || ws_size < WS_TOTAL) { fprintf(stderr, "kernel_launch: expected 30 inputs and >= %zu bytes of workspace (got %d, %zu)\n", (size_t)WS_TOTAL, n_in, ws_size); grid = -1; return; }
        int dev = 0, cus = 0, per_cu = 0;
        (void)hipGetDevice(&dev); (void)hipDeviceGetAttribute(&cus, hipDeviceAttributeMultiprocessorCount, dev);
        if (hipFuncSetAttribute((const void*)mega, hipFuncAttributeMaxDynamicSharedMemorySize, LDS_BYTES) != hipSuccess) { fprintf(stderr, "kernel_launch: hipFuncSetAttribute failed\n"); }
        if (hipOccupancyMaxActiveBlocksPerMultiprocessor(&per_cu, (const void*)mega, 512, LDS_BYTES) != hipSuccess || per_cu < 1) { fprintf(stderr, "kernel_launch: occupancy query says %d\n", per_cu); per_cu = 1; }
        (void)hipGetLastError();
        grid = cus * per_cu;
    }
    if (grid < 0) return;
    Params p{};
    const float** pp = (const float**)&p;
    for (int i = 0; i < 30; ++i) pp[i] = (const float*)d_in[i];
    p.out = (float*)d_out; p.ws = (unsigned char*)d_ws;
#if MK_MULTI
    launch_each<0>(grid, stream, p);
#else
    void* args[] = {&p};
    hipError_t e = hipLaunchCooperativeKernel((const void*)mega, dim3(grid), dim3(512), args, LDS_BYTES, stream);
    if (e != hipSuccess) fprintf(stderr, "kernel_launch: cooperative launch failed: %s (grid %d)\n", hipGetErrorString(e), grid);
#endif
}
```

```cpp
#include <hip/hip_runtime.h>
#include <hip/hip_cooperative_groups.h>
#include <cstdio>
namespace cg = cooperative_groups;
namespace pg8 {
#define PG8_LAS __attribute__((address_space(3)))
typedef unsigned short bf16_t;
typedef short bf16x8 __attribute__((ext_vector_type(8)));
typedef float f32x4 __attribute__((ext_vector_type(4)));
typedef unsigned u32x4 __attribute__((ext_vector_type(4)));
constexpr int BM = 256, BK = 64, HALF = 128, HTB = HALF * BK * 2  , STAGE_BYTES = 8 * HTB, NXCD = 8, WGM = 8;

__host__ __device__ __forceinline__ int lds_byte(int r, int c) { const int st = (r >> 4) * 2 + (c >> 5), rr = r & 15, cc = c & 31, ob = rr * 64 + cc * 2; return st * 1024 + (ob ^ (((ob >> 9) & 1) << 5)); }
__host__ __device__ __forceinline__ void stage_rc(int b, int& R, int& C) { const int st = b / 1024, sb = b % 1024, swz = sb ^ (((sb >> 9) & 1) << 5); R = (st >> 1) * 16 + swz / 64; C = (st & 1) * 32 + (swz % 64) / 2; }
__host__ __device__ __forceinline__ int perm32(int rho) { const int n = rho >> 4, i = rho & 15; return 8 * (i >> 2) + 4 * n + (i & 3); }

struct Unit { int pm, pn; };
struct Gemm { const bf16_t* A; const bf16_t* Bt; int M, N, K; };

struct StaticOrder {
    int nM, nN, nwg, G, c;
    __host__ __device__ void init(int M, int N, int G_, int c_) { nM = M / BM; nN = N / BM; nwg = nM * nN; G = G_; c = c_; }
    __host__ __device__ bool next(int i, Unit& u) const {
        const long L = (long)i * G + c; if (L >= nwg) return false;
        int wgid = (int)L; { const int q = nwg / NXCD, r = nwg % NXCD, xcd = wgid % NXCD, off = wgid / NXCD; wgid = (xcd < r ? xcd * (q + 1) : r * (q + 1) + (xcd - r) * q) + off; }
        const int nig = WGM * nN, gid = wgid / nig, fm = gid * WGM, gsz = (nM - fm) < WGM ? (nM - fm) : WGM;
        u.pm = fm + ((wgid % nig) % gsz); u.pn = (wgid % nig) / gsz; return true;
    }
    __device__ __forceinline__ void a_ready(const Unit&) const {}
    __device__ __forceinline__ void done(const Unit&) const {}
};
__device__ __forceinline__ unsigned cvt_pk_bf16(float lo, float hi) { unsigned r; asm volatile("v_cvt_pk_bf16_f32 %0, %1, %2" : "=v"(r) : "v"(lo), "v"(hi)); return r; }
typedef float f32x2 __attribute__((ext_vector_type(2)));
template <class Epi, class Sched, bool STAMP = false>
__device__ __forceinline__ void gemm_phase(PG8_LAS unsigned char* lds, const Gemm g, const Sched& S, const Epi& E, unsigned long long* stamps) {
    const int tid = threadIdx.x, wid = __builtin_amdgcn_readfirstlane(tid >> 6), lane = tid & 63, wr = wid >> 2, wc = wid & 3, fr = lane & 15, fq = lane >> 4;
    const int K = g.K, nt = K / BK;
    int ts_lo = 0, ts_hi = 0, nts = 0; const unsigned long long rt_entry = STAMP ? (unsigned long long)wall_clock64() : 0ull;
#define PG8_STAMP() do { if (STAMP && wid == 0 && nts < 64) { const unsigned long long _c = (unsigned long long)clock64(); \
        ts_lo = (lane == nts) ? (int)(unsigned)_c : ts_lo; ts_hi = (lane == nts) ? (int)(unsigned)(_c >> 32) : ts_hi; ++nts; } } while (0)
    PG8_STAMP();
    unsigned voffA[2], voffB[2];
#pragma unroll
    for (int i = 0; i < 2; ++i) { int R, C; stage_rc(tid * 16 + i * 8192, R, C); const int Rb = Epi::PERM ? ((R & ~31) + perm32(R & 31)) : R;
        voffA[i] = (unsigned)(R * K + C) * 2u; voffB[i] = (unsigned)(Rb * K + C) * 2u; }
    const size_t kstep = (size_t)(BK * 2);
    const size_t hstep = (size_t)HALF * K * 2;
    const size_t tstep = 2 * hstep;
    const unsigned ldsw = (unsigned)wid * 1024u;
    const int aoff = lds_byte(wr * 64 + fr, fq * 8), boff = lds_byte(wc * 32 + fr, fq * 8);
#define PG8_SA(b, h) (((b) * 2 + (h)) * HTB)
#define PG8_SB(b, h) ((4 + (b) * 2 + (h)) * HTB)
#define PG8_STAGE(bufoff, gbase, voff) do { _Pragma("unroll") for (int _i = 0; _i < 2; ++_i) \
        __builtin_amdgcn_global_load_lds((const unsigned*)((const char*)(gbase) + (voff)[_i]), (PG8_LAS unsigned*)(lds + (bufoff) + ldsw + _i * 8192), 16, 0, 0); } while (0)
#define PG8_LDA(dst, b, h) do { _Pragma("unroll") for (int m = 0; m < 4; ++m) _Pragma("unroll") for (int k = 0; k < 2; ++k) dst[m][k] = *(const PG8_LAS bf16x8*)(lds + PG8_SA(b, h) + aoff + m * 2048 + k * 1024); } while (0)
#define PG8_LDB(dst, b, h) do { _Pragma("unroll") for (int n = 0; n < 2; ++n) _Pragma("unroll") for (int k = 0; k < 2; ++k) dst[n][k] = *(const PG8_LAS bf16x8*)(lds + PG8_SB(b, h) + boff + n * 2048 + k * 1024); } while (0)
#define PG8_MMA(ai, bj, At, Bt) do { __builtin_amdgcn_s_setprio(1); _Pragma("unroll") for (int m = 0; m < 4; ++m) _Pragma("unroll") for (int n = 0; n < 2; ++n) _Pragma("unroll") for (int k = 0; k < 2; ++k) \
        acc[ai][bj][m][n] = __builtin_amdgcn_mfma_f32_16x16x32_bf16(Bt[n][k], At[m][k], acc[ai][bj][m][n], 0, 0, 0); __builtin_amdgcn_s_setprio(0); } while (0)
#define PG8_WAIT_V(n) asm volatile("s_waitcnt vmcnt(" #n ")" ::: "memory")
#define PG8_WAIT_L(n) asm volatile("s_waitcnt lgkmcnt(" #n ")" ::: "memory")
#define PG8_BAR __builtin_amdgcn_s_barrier()
#define PG8_SCHED __builtin_amdgcn_sched_barrier(0)
    Unit cur, nxt; int ui = 0;
    if (!S.next(0, cur)) return;
    f32x4 acc[2][2][4][2];
#pragma unroll
    for (int a = 0; a < 2; ++a)
#pragma unroll
        for (int b = 0; b < 2; ++b)
#pragma unroll
            for (int m = 0; m < 4; ++m)
#pragma unroll
                for (int n = 0; n < 2; ++n) acc[a][b][m][n] = (f32x4){0.f, 0.f, 0.f, 0.f};
    bf16x8 At[4][2], B0[2][2], B1[2][2];
    const char* cA = (const char*)g.A + (size_t)cur.pm * tstep; const char* cB = (const char*)g.Bt + (size_t)cur.pn * tstep;
    S.a_ready(cur);
    PG8_STAGE(PG8_SB(0, 0), cB, voffB); PG8_STAGE(PG8_SA(0, 0), cA, voffA); PG8_STAGE(PG8_SB(0, 1), cB + hstep, voffB); PG8_STAGE(PG8_SA(0, 1), cA + hstep, voffA);
    if (wr == 1) PG8_BAR;
    PG8_WAIT_V(4); PG8_BAR;
    PG8_STAGE(PG8_SB(1, 0), cB + kstep, voffB); PG8_STAGE(PG8_SA(1, 0), cA + kstep, voffA); PG8_STAGE(PG8_SB(1, 1), cB + hstep + kstep, voffB);
    PG8_WAIT_V(6); PG8_BAR;
    PG8_STAMP();
    for (;;) {
        const bool has_next = S.next(ui + 1, nxt);
        const char* nA = has_next ? (const char*)g.A + (size_t)nxt.pm * tstep : cA; const char* nB = has_next ? (const char*)g.Bt + (size_t)nxt.pn * tstep : cB;
        for (int t = 0; t < nt; t += 2) {
            const bool last = (t == nt - 2);
            const char* a1 = cA + (size_t)(t + 1) * kstep;
            const char* a2 = last ? nA : cA + (size_t)(t + 2) * kstep; const char* b2 = last ? nB : cB + (size_t)(t + 2) * kstep;
            const char* a3 = a2 + kstep; const char* b3 = b2 + kstep;
            if (last && has_next) S.a_ready(nxt);
            PG8_LDB(B0, 0, 0); PG8_SCHED; PG8_LDA(At, 0, 0); PG8_STAGE(PG8_SA(1, 1), a1 + hstep, voffA);
            PG8_WAIT_L(8); PG8_BAR; PG8_WAIT_L(0); PG8_MMA(0, 0, At, B0); PG8_BAR; PG8_SCHED;
            PG8_LDB(B1, 0, 1); PG8_STAGE(PG8_SB(0, 0), b2, voffB);
            PG8_BAR; PG8_WAIT_L(0); PG8_MMA(0, 1, At, B1); PG8_BAR;
            PG8_LDA(At, 0, 1); PG8_STAGE(PG8_SA(0, 0), a2, voffA);
            PG8_BAR; PG8_WAIT_L(0); PG8_MMA(1, 0, At, B0); PG8_BAR; PG8_SCHED;
            PG8_STAGE(PG8_SB(0, 1), b2 + hstep, voffB);
            PG8_WAIT_V(6); PG8_BAR; PG8_MMA(1, 1, At, B1); PG8_BAR;
            PG8_LDB(B0, 1, 0); PG8_SCHED; PG8_LDA(At, 1, 0); PG8_STAGE(PG8_SA(0, 1), a2 + hstep, voffA);
            PG8_WAIT_L(8); PG8_BAR; PG8_WAIT_L(0); PG8_MMA(0, 0, At, B0); PG8_BAR; PG8_SCHED;
            PG8_LDB(B1, 1, 1); PG8_STAGE(PG8_SB(1, 0), b3, voffB);
            PG8_BAR; PG8_WAIT_L(0); PG8_MMA(0, 1, At, B1); PG8_BAR;
            PG8_LDA(At, 1, 1); PG8_STAGE(PG8_SA(1, 0), a3, voffA);
            PG8_BAR; PG8_WAIT_L(0); PG8_MMA(1, 0, At, B0); PG8_BAR; PG8_SCHED;
            PG8_STAGE(PG8_SB(1, 1), b3 + hstep, voffB);
            PG8_WAIT_V(6); PG8_BAR; PG8_MMA(1, 1, At, B1); PG8_BAR;
        }
        PG8_STAMP();
        if constexpr (!Epi::AFTER_DRAIN) { E(acc, cur, wr, wc, fr, fq); S.done(cur); }
        PG8_STAMP();
        if (!has_next) break;
#pragma unroll
        for (int a = 0; a < 2; ++a)
#pragma unroll
            for (int b = 0; b < 2; ++b)
#pragma unroll
                for (int m = 0; m < 4; ++m)
#pragma unroll
                    for (int n = 0; n < 2; ++n) acc[a][b][m][n] = (f32x4){0.f, 0.f, 0.f, 0.f};
        cur = nxt; cA = nA; cB = nB; ++ui;
    }
    PG8_WAIT_V(0);
    if (wr == 0) PG8_BAR;
    PG8_BAR;
    if constexpr (Epi::AFTER_DRAIN) { E.fused(acc, cur, wr, wc, fr, fq, lds, wid, lane); S.done(cur); }
    PG8_STAMP();
    if (STAMP && wid == 0) { stamps[lane] = lane < nts ? (((unsigned long long)(unsigned)ts_hi << 32) | (unsigned)ts_lo) : 0ull;
        if (lane == 62) stamps[62] = rt_entry; if (lane == 63) stamps[63] = (unsigned long long)wall_clock64(); }
#undef PG8_STAMP
#undef PG8_SA
#undef PG8_SB
#undef PG8_STAGE
#undef PG8_LDA
#undef PG8_LDB
#undef PG8_MMA
#undef PG8_WAIT_V
#undef PG8_WAIT_L
#undef PG8_BAR
#undef PG8_SCHED
}
}
using namespace pg8;
#define LAS __attribute__((address_space(3)))
typedef unsigned short u16;
typedef unsigned int u32;
typedef float f32x16 __attribute__((ext_vector_type(16)));

constexpr int TX = 65536, TCX = 8192, TT = 73728;
constexpr int DFF = 2816, NGU = 5632, NIN = 4864;
constexpr float EPSF = 1e-6f;
constexpr int LDS_BYTES = 160768;
constexpr int NPHASE = 15;

constexpr size_t SZ_WGU = (size_t)NGU * 1024 * 2, SZ_WD = (size_t)1024 * DFF * 2, SZ_WIN = (size_t)NIN * 1024 * 2, SZ_WOUT = (size_t)1024 * 2048 * 2;
constexpr size_t OFF_WGU1 = 0, OFF_WD1 = OFF_WGU1 + SZ_WGU, OFF_WGU2 = OFF_WD1 + SZ_WD, OFF_WD2 = OFF_WGU2 + SZ_WGU, OFF_WIN = OFF_WD2 + SZ_WD, OFF_WOUT = OFF_WIN + SZ_WIN;
constexpr size_t OFF_MOD = OFF_WOUT + SZ_WOUT;
constexpr size_t OFF_XC1 = OFF_MOD + (size_t)33 * 9216 * 4;
constexpr size_t OFF_DT = OFF_XC1 + (size_t)TCX * 1024 * 4;
constexpr size_t SZ_A16 = (size_t)TT * 16 * 4;
constexpr size_t OFF_DTF = OFF_DT + (size_t)TT * 32 * 4, OFF_DTB = OFF_DTF + SZ_A16, OFF_CSF = OFF_DTB + SZ_A16, OFF_CSB = OFF_CSF + SZ_A16;
constexpr size_t OFF_CDEC = OFF_CSB + SZ_A16;
constexpr size_t OFF_BIG = OFF_CDEC + (size_t)32 * 2 * 18 * 16 * 4;
constexpr size_t SZ_H = (size_t)TT * 1024 * 2, SZ_ACT = (size_t)TT * DFF * 2, SZ_ST = (size_t)32 * 2 * 17 * 16 * 8192 * 2;
constexpr size_t OFF_H = OFF_BIG, OFF_ACT = OFF_BIG + SZ_H, OFF_ST = OFF_BIG;
constexpr size_t WS_TOTAL = (size_t)1 << 30;
constexpr size_t OFF_U = WS_TOTAL - (size_t)TX * 1024 * 2, OFF_XBC = OFF_U - (size_t)TT * 1536 * 2, OFF_Y = OFF_XBC - (size_t)TX * 2048 * 2;
static_assert(OFF_BIG % 256 == 0 && OFF_ACT + SZ_ACT <= WS_TOTAL && OFF_Y >= OFF_ST + SZ_ST && OFF_Y >= OFF_H + SZ_H, "workspace map");

struct Params {
    const float *x, *c, *ctx, *c_ctx, *w_mod, *b_mod, *norm_ffn1, *g1, *u1, *d1, *norm_mix, *w_in, *scw, *scb, *dtbf, *dtbb, *alf, *alb, *ssm_d, *ssm_nw, *ccw, *ccb, *lnw, *lnb,
        *w_out, *norm_ffn2, *g2, *u2, *d2, *fnorm;
    float* out; unsigned char* ws; int ph_lo, ph_hi;
};

__device__ __forceinline__ float bf2f(u16 v) { return __uint_as_float(((u32)v) << 16); }
__device__ __forceinline__ u16 f2bf(float f) { u32 u = __float_as_uint(f); u += 0x7FFFu + ((u >> 16) & 1u); return (u16)(u >> 16); }
__device__ __forceinline__ float lo_f(u32 v) { return __uint_as_float(v << 16); }
__device__ __forceinline__ float hi_f(u32 v) { return __uint_as_float(v & 0xffff0000u); }
__device__ __forceinline__ float silu_f(float x) { return x / (1.0f + __expf(-x)); }
__device__ __forceinline__ float sigm_f(float x) { return 1.0f / (1.0f + __expf(-x)); }
__device__ __forceinline__ float wave_sum(float v) {
#pragma unroll
    for (int o = 32; o >= 1; o >>= 1) v += __shfl_xor(v, o);
    return v;
}

struct InOrder : StaticOrder {
    __device__ bool next(int i, Unit& u) const {
        const long L = (long)i * G + c;
        if (L < nwg) return StaticOrder::next(i, u);
        const int e = (int)(L - nwg); if (e >= 192) return false;
        u.pm = 256 + (e & 31); u.pn = e >> 5; return true;
    }
};

struct EpiSwiGLU {
    static constexpr bool PERM = true, AFTER_DRAIN = false;
    bf16_t* O;
    __device__ __forceinline__ void operator()(const f32x4 (&acc)[2][2][4][2], const Unit& u, int wr, int wc, int fr, int fq) const {
        const int row0 = u.pm * BM + wr * 64 + fr, col0 = u.pn * 128 + wc * 32 + 8 * fq;
#pragma unroll
        for (int ai = 0; ai < 2; ++ai)
#pragma unroll
            for (int m = 0; m < 4; ++m) {
                bf16_t* rowp = O + (size_t)(row0 + ai * HALF + m * 16) * DFF + col0;
                const f32x4 g0 = acc[ai][0][m][0], g1 = acc[ai][0][m][1], u0 = acc[ai][1][m][0], u1 = acc[ai][1][m][1];
                u32x4 w;
                w.x = cvt_pk_bf16(silu_f(g0[0]) * u0[0], silu_f(g0[1]) * u0[1]); w.y = cvt_pk_bf16(silu_f(g0[2]) * u0[2], silu_f(g0[3]) * u0[3]);
                w.z = cvt_pk_bf16(silu_f(g1[0]) * u1[0], silu_f(g1[1]) * u1[1]); w.w = cvt_pk_bf16(silu_f(g1[2]) * u1[2], silu_f(g1[3]) * u1[3]);
                *(u32x4*)rowp = w;
            }
    }
};

struct EpiResid {
    static constexpr bool PERM = false, AFTER_DRAIN = false;
    const float* baseX; float* outX; const float* baseC; float* outC; const float* mod; float s;
    __device__ __forceinline__ void operator()(const f32x4 (&acc)[2][2][4][2], const Unit& u, int wr, int wc, int fr, int fq) const {
        const int row0 = u.pm * BM + wr * 64 + fr, col0 = u.pn * BM + wc * 32 + 4 * fq;
        const bool isx = u.pm < 256; const int b = isx ? (u.pm >> 3) : 32;
        const float* bp0 = isx ? baseX + (size_t)row0 * 1024 : baseC + (size_t)(row0 - TX) * 1024;
        float* op0 = isx ? outX + (size_t)row0 * 1024 : outC + (size_t)(row0 - TX) * 1024;
        f32x4 mv[2][2];
#pragma unroll
        for (int bj = 0; bj < 2; ++bj)
#pragma unroll
            for (int n = 0; n < 2; ++n) mv[bj][n] = *(const f32x4*)(mod + (size_t)b * 9216 + col0 + bj * HALF + n * 16) * s;
#pragma unroll
        for (int ai = 0; ai < 2; ++ai)
#pragma unroll
            for (int m = 0; m < 4; ++m) {
                const size_t ro = (size_t)(ai * HALF + m * 16) * 1024 + col0;
#pragma unroll
                for (int bj = 0; bj < 2; ++bj)
#pragma unroll
                    for (int n = 0; n < 2; ++n) {
                        const f32x4 bv = *(const f32x4*)(bp0 + ro + bj * HALF + n * 16);
                        *(f32x4*)(op0 + ro + bj * HALF + n * 16) = bv + mv[bj][n] * acc[ai][bj][m][n];
                    }
            }
    }
};

struct EpiInProj {
    static constexpr bool PERM = true, AFTER_DRAIN = false;
    bf16_t* XBC; float* DT; bf16_t* Y; bf16_t* U;
    __device__ __forceinline__ void operator()(const f32x4 (&acc)[2][2][4][2], const Unit& u, int wr, int wc, int fr, int fq) const {
        const int row0 = u.pm * BM + wr * 64 + fr, cin = wc * 32 + 8 * fq, pn = u.pn;
        if (pn == 5) {
            if (wc == 0) {
#pragma unroll
                for (int ai = 0; ai < 2; ++ai)
#pragma unroll
                    for (int m = 0; m < 4; ++m) {
                        float* rp = DT + (size_t)(row0 + ai * HALF + m * 16) * 32 + 8 * fq;
                        *(f32x4*)rp = acc[ai][0][m][0]; *(f32x4*)(rp + 4) = acc[ai][0][m][1];
                    }
            }
        } else if (pn <= 10) {
            bf16_t* base; int ld;
            if (pn <= 4) { base = XBC + pn * 256; ld = 1536; } else if (pn == 6) { base = XBC + 1280; ld = 1536; } else { base = Y + (pn - 7) * 256; ld = 2048; }
#pragma unroll
            for (int ai = 0; ai < 2; ++ai)
#pragma unroll
                for (int m = 0; m < 4; ++m) {
                    bf16_t* rowp = base + (size_t)(row0 + ai * HALF + m * 16) * ld + cin;
#pragma unroll
                    for (int bj = 0; bj < 2; ++bj) {
                        const f32x4 v0 = acc[ai][bj][m][0], v1 = acc[ai][bj][m][1];
                        u32x4 w; w.x = cvt_pk_bf16(v0[0], v0[1]); w.y = cvt_pk_bf16(v0[2], v0[3]); w.z = cvt_pk_bf16(v1[0], v1[1]); w.w = cvt_pk_bf16(v1[2], v1[3]);
                        *(u32x4*)(rowp + bj * HALF) = w;
                    }
                }
        } else {
            bf16_t* base = U + (pn - 11) * 128 + cin;
#pragma unroll
            for (int ai = 0; ai < 2; ++ai)
#pragma unroll
                for (int m = 0; m < 4; ++m) {
                    bf16_t* rowp = base + (size_t)(row0 + ai * HALF + m * 16) * 1024;
                    const f32x4 a0 = acc[ai][0][m][0], a1 = acc[ai][0][m][1], b0 = acc[ai][1][m][0], b1 = acc[ai][1][m][1];
                    u32x4 w;
                    w.x = cvt_pk_bf16(a0[0] * sigm_f(b0[0]), a0[1] * sigm_f(b0[1])); w.y = cvt_pk_bf16(a0[2] * sigm_f(b0[2]), a0[3] * sigm_f(b0[3]));
                    w.z = cvt_pk_bf16(a1[0] * sigm_f(b1[0]), a1[1] * sigm_f(b1[1])); w.w = cvt_pk_bf16(a1[2] * sigm_f(b1[2]), a1[3] * sigm_f(b1[3]));
                    *(u32x4*)rowp = w;
                }
        }
    }
};

__device__ __forceinline__ void prep_mod_item(const Params& P, LAS unsigned char* lds, int it) {
    const int tid = threadIdx.x;
    LAS float* cc = (LAS float*)lds;
    for (int i = tid; i < 33 * 1024; i += 512) { const int r = i >> 10, k = i & 1023; const float v = (r < 32) ? P.c[r * 1024 + k] : P.c_ctx[k]; cc[i] = silu_f(v); }
    __syncthreads();
    const int n0 = it * 64, col = tid & 63, kk = tid >> 6;
    float acc[33];
#pragma unroll
    for (int r = 0; r < 33; ++r) acc[r] = 0.f;
    const float* wp = P.w_mod + (size_t)(kk * 128) * 9216 + n0 + col;
    for (int k4 = 0; k4 < 32; ++k4) {
        const float w0 = wp[(size_t)(k4 * 4 + 0) * 9216], w1 = wp[(size_t)(k4 * 4 + 1) * 9216], w2 = wp[(size_t)(k4 * 4 + 2) * 9216], w3 = wp[(size_t)(k4 * 4 + 3) * 9216];
#pragma unroll
        for (int r = 0; r < 33; ++r) { const f32x4 c4 = *(const LAS f32x4*)(cc + r * 1024 + kk * 128 + k4 * 4); acc[r] += c4[0] * w0 + c4[1] * w1 + c4[2] * w2 + c4[3] * w3; }
    }
    __syncthreads();
    LAS float* red = (LAS float*)lds;
#pragma unroll
    for (int r = 0; r < 33; ++r) red[(kk * 33 + r) * 64 + col] = acc[r];
    __syncthreads();
    float* MOD = (float*)(P.ws + OFF_MOD);
    for (int o = tid; o < 33 * 64; o += 512) { const int r = o >> 6, cl = o & 63; float s = 0.f;
#pragma unroll
        for (int q = 0; q < 8; ++q) s += red[(q * 33 + r) * 64 + cl];
        MOD[(size_t)r * 9216 + n0 + cl] = s + P.b_mod[n0 + cl]; }
    __syncthreads();
}

__device__ __forceinline__ void prep_tile(const Params& P, LAS unsigned char* lds, int t) {
    const int tid = threadIdx.x;
    const float* src; int sld, scol0, nvalid = 64, kt, n0, dld; u16* dst;
    if (t < 2816) {
        const int f = t >= 1408; const int tt = t - f * 1408; const int nt = tt >> 4; kt = tt & 15; n0 = nt * 64;
        const int j = n0 >> 8, s0 = n0 & 255;
        src = (s0 < 128) ? (f ? P.g2 : P.g1) : (f ? P.u2 : P.u1); scol0 = 128 * j + (s0 & 127); sld = DFF;
        dst = (u16*)(P.ws + (f ? OFF_WGU2 : OFF_WGU1)); dld = 1024;
    } else if (t < 2816 + 1408) {
        const int t2 = t - 2816; const int f = t2 >= 704; const int tt = t2 - f * 704; const int nt = tt / 44; kt = tt % 44; n0 = nt * 64;
        src = f ? P.d2 : P.d1; scol0 = n0; sld = 1024; dst = (u16*)(P.ws + (f ? OFF_WD2 : OFF_WD1)); dld = DFF;
    } else if (t < 2816 + 1408 + 1216) {
        const int tt = t - 4224; const int nt = tt >> 4; kt = tt & 15; n0 = nt * 64;
        const int pn = n0 >> 8, s0 = n0 & 255;
        if (pn < 4) scol0 = 1024 + n0; else if (pn == 4) scol0 = 2048 + s0; else if (pn == 5) { scol0 = 2560 + (s0 ? 0 : 0); nvalid = s0 ? 0 : 32; }
        else if (pn == 6) scol0 = 2304 + s0; else if (pn <= 10) scol0 = n0 - 1792;
        else { const int j = pn - 11; scol0 = (s0 < 128) ? (2592 + 128 * j + s0) : (2592 + 1024 + 128 * j + (s0 - 128)); }
        src = P.w_in; sld = 4640; dst = (u16*)(P.ws + OFF_WIN); dld = 1024;
    } else {
        const int tt = t - 5440; const int nt = tt >> 5; kt = tt & 31; n0 = nt * 64;
        src = P.w_out; scol0 = n0; sld = 1024; dst = (u16*)(P.ws + OFF_WOUT); dld = 2048;
    }
    LAS float* tile = (LAS float*)lds;
#pragma unroll
    for (int e = 0; e < 8; ++e) { const int idx = tid + 512 * e, kk = idx >> 6, nn = idx & 63;
        tile[kk * 65 + nn] = (nn < nvalid) ? src[(size_t)(kt * 64 + kk) * sld + scol0 + nn] : 0.f; }
    __syncthreads();
    { const int nn = tid >> 3, ks = (tid & 7) * 8; u32x4 w;
      w.x = cvt_pk_bf16(tile[(ks + 0) * 65 + nn], tile[(ks + 1) * 65 + nn]); w.y = cvt_pk_bf16(tile[(ks + 2) * 65 + nn], tile[(ks + 3) * 65 + nn]);
      w.z = cvt_pk_bf16(tile[(ks + 4) * 65 + nn], tile[(ks + 5) * 65 + nn]); w.w = cvt_pk_bf16(tile[(ks + 6) * 65 + nn], tile[(ks + 7) * 65 + nn]);
      *(u32x4*)(dst + (size_t)(n0 + nn) * dld + kt * 64 + ks) = w; }
    __syncthreads();
}

__device__ __forceinline__ void phase_prep(const Params& P, LAS unsigned char* lds) {
    constexpr int NMOD = 144, NTILE = 2816 + 1408 + 1216 + 512;
    for (int it = blockIdx.x; it < NMOD + NTILE; it += gridDim.x) { if (it < NMOD) prep_mod_item(P, lds, it); else prep_tile(P, lds, it - NMOD); }
}

template <int MODE>
__device__ __forceinline__ void phase_norm(const Params& P, const float* srcX, const float* srcC, int nrows, const float* nw, int shIdx, int scIdx, u16* H, float* outF) {
    const int lane = threadIdx.x & 63, gw = blockIdx.x * 8 + (threadIdx.x >> 6), nwv = gridDim.x * 8;
    const float* MOD = (const float*)(P.ws + OFF_MOD);
    for (int row = gw; row < nrows; row += nwv) {
        const float* src = (row < TX) ? srcX + (size_t)row * 1024 : srcC + (size_t)(row - TX) * 1024;
        const int b = (row < TX) ? (row >> 11) : 32;
        f32x4 v[4]; float ss = 0.f;
#pragma unroll
        for (int i = 0; i < 4; ++i) { v[i] = *(const f32x4*)(src + i * 256 + lane * 4); ss += v[i][0] * v[i][0] + v[i][1] * v[i][1] + v[i][2] * v[i][2] + v[i][3] * v[i][3]; }
        ss = wave_sum(ss);
        const float rstd = rsqrtf(ss * (1.0f / 1024.0f) + EPSF);
#pragma unroll
        for (int i = 0; i < 4; ++i) { const int col = i * 256 + lane * 4; const f32x4 w = *(const f32x4*)(nw + col);
            if (MODE == 0) {
                const f32x4 sh = *(const f32x4*)(MOD + (size_t)b * 9216 + shIdx * 1024 + col), sc = *(const f32x4*)(MOD + (size_t)b * 9216 + scIdx * 1024 + col);
                const f32x4 o = (v[i] * rstd * w) * (sc + 1.0f) + sh;
                uint2 pk; pk.x = cvt_pk_bf16(o[0], o[1]); pk.y = cvt_pk_bf16(o[2], o[3]);
                *(uint2*)(H + (size_t)row * 1024 + col) = pk;
            } else { *(f32x4*)(outF + (size_t)row * 1024 + col) = v[i] * rstd * w; } }
    }
}

template <int NC>
__device__ __forceinline__ void stage_conv(LAS u16* dst, int ld, const u16* XBC, int row0, int seq0, int seq1, int col0, const float* cw, const float* cb) {
    constexpr int NP = NC / 2, NTG = 512 / NP, TPG = 128 / NTG;
    const int tid = threadIdx.x, cp = tid % NP, tg = tid / NP, ch = col0 + 2 * cp, l0 = tg * TPG;
    float w0[5], w1[5];
#pragma unroll
    for (int k = 0; k < 5; ++k) { w0[k] = cw[k * 1536 + ch]; w1[k] = cw[k * 1536 + ch + 1]; }
    const float b0 = cb[ch], b1 = cb[ch + 1];
    u32 win[5] = {0u, 0u, 0u, 0u, 0u};
#pragma unroll
    for (int i = 0; i < TPG + 4; ++i) {
        const int r = row0 + l0 - 2 + i;
        u32 v = 0u; if (r >= seq0 && r < seq1) v = *(const u32*)(XBC + (size_t)r * 1536 + ch);
        win[0] = win[1]; win[1] = win[2]; win[2] = win[3]; win[3] = win[4]; win[4] = v;
        if (i >= 4) {
            float a0 = b0, a1 = b1;
#pragma unroll
            for (int k = 0; k < 5; ++k) { a0 += w0[k] * lo_f(win[k]); a1 += w1[k] * hi_f(win[k]); }
            *(LAS u32*)(dst + (l0 + i - 4) * ld + 2 * cp) = cvt_pk_bf16(silu_f(a0), silu_f(a1));
        }
    }
}

__device__ __forceinline__ void dtprep_item(const Params& P, LAS unsigned char* lds, int tc) {
    const int tid = threadIdx.x, dh = tid & 31, seg = tid >> 5, dir = dh >> 4, h = dh & 15;
    const bool isx = tc < 512; const int b = isx ? (tc >> 4) : ((tc - 512) >> 1); const int cidx = isx ? (tc & 15) : ((tc - 512) & 1);
    const int row0 = tc * 128;
    const int jscan = isx ? (dir ? 17 - cidx : cidx + 2) : (dir ? 1 - cidx : cidx);
    const float bias = dir ? P.dtbb[h] : P.dtbf[h]; const float a = -__expf(dir ? P.alb[h] : P.alf[h]);
    const float* DT = (const float*)(P.ws + OFF_DT);
    float dt[8], cs[8];
#pragma unroll
    for (int i = 0; i < 8; ++i) { const float raw = DT[(size_t)(row0 + seg * 8 + i) * 32 + dh] + bias; dt[i] = (raw > 20.f) ? raw : log1pf(__expf(raw)); }
    float run = 0.f;
    if (dir == 0) {
#pragma unroll
        for (int i = 0; i < 8; ++i) { run += dt[i] * a; cs[i] = run; }
    } else {
#pragma unroll
        for (int i = 7; i >= 0; --i) { run += dt[i] * a; cs[i] = run; }
    }
    LAS float* segsum = (LAS float*)lds;
    segsum[seg * 32 + dh] = run;
    __syncthreads();
    float off = 0.f, tot = 0.f;
#pragma unroll
    for (int s2 = 0; s2 < 16; ++s2) { const float v = segsum[s2 * 32 + dh]; tot += v; if (dir == 0 ? (s2 < seg) : (s2 > seg)) off += v; }
    float* DTO = (float*)(P.ws + (dir ? OFF_DTB : OFF_DTF)); float* CSO = (float*)(P.ws + (dir ? OFF_CSB : OFF_CSF));
#pragma unroll
    for (int i = 0; i < 8; ++i) { const size_t o = (size_t)(row0 + seg * 8 + i) * 16 + h; DTO[o] = dt[i]; CSO[o] = cs[i] + off; }
    if (seg == 0) ((float*)(P.ws + OFF_CDEC))[((b * 2 + dir) * 18 + jscan) * 16 + h] = __expf(tot);
    __syncthreads();
}

__device__ __forceinline__ void uconv_item(const Params& P, LAS unsigned char* lds, int item) {
    const int tid = threadIdx.x; const bool isH = item < 1024; const int e = item & 1023, b = e >> 5, q = e & 31;
    LAS u32* in = (LAS u32*)lds;
    const u16* Ug = (const u16*)(P.ws + OFF_U); u16* Yg = (u16*)(P.ws + OFF_Y);
    const int choff = isH ? 0 : 512;
#pragma unroll
    for (int i = 0; i < 8; ++i) { const int idx = tid + 512 * i, tok = idx >> 6, c16 = idx & 63; int grow, lrow;
        if (isH) { grow = b * 2048 + q * 64 + tok; lrow = 15 + tok; } else { const int line = tok >> 5, rr = tok & 31; grow = b * 2048 + rr * 64 + 2 * q + line; lrow = line * 62 + 15 + rr; }
        *(LAS u32x4*)(in + lrow * 256 + c16 * 4) = *(const u32x4*)(Ug + (size_t)grow * 1024 + choff + c16 * 8); }
    { const int npad = isH ? 30 : 60;
      for (int idx = tid; idx < npad * 64; idx += 512) { const int pr = idx >> 6, c16 = idx & 63; int lrow;
          if (isH) lrow = (pr < 15) ? pr : 64 + pr; else { const int line = pr / 30, k = pr % 30; lrow = line * 62 + ((k < 15) ? k : 32 + k); }
          *(LAS u32x4*)(in + lrow * 256 + c16 * 4) = (u32x4){0u, 0u, 0u, 0u}; } }
    __syncthreads();
    const int cp = tid & 255, half = tid >> 8, ch = choff + 2 * cp;
    float w0[31], w1[31];
#pragma unroll
    for (int k = 0; k < 31; ++k) { w0[k] = P.ccw[k * 1024 + ch]; w1[k] = P.ccw[k * 1024 + ch + 1]; }
    const float b0 = P.ccb[ch], b1 = P.ccb[ch + 1];
    const int base_row = isH ? 32 * half : 62 * half;
    for (int oo = 0; oo < 32; ++oo) {
        float a0 = b0, a1 = b1;
        const LAS u32* pr = in + (base_row + oo) * 256 + cp;
#pragma unroll
        for (int k = 0; k < 31; ++k) { const u32 v = pr[k * 256]; a0 += w0[k] * lo_f(v); a1 += w1[k] * hi_f(v); }
        const int grow = isH ? (b * 2048 + q * 64 + 32 * half + oo) : (b * 2048 + oo * 64 + 2 * q + half);
        *(u32*)(Yg + (size_t)grow * 2048 + 1024 + ch) = cvt_pk_bf16(a0, a1);
    }
    __syncthreads();
}

__device__ __forceinline__ void phase_p6(const Params& P, LAS unsigned char* lds) {
    for (int it = blockIdx.x; it < 576 + 2048; it += gridDim.x) { if (it < 576) dtprep_item(P, lds, it); else uconv_item(P, lds, it - 576); }
}

__device__ __forceinline__ bf16x8 gather8(const LAS u16* p, int stride) {
    bf16x8 r;
#pragma unroll
    for (int j = 0; j < 8; ++j) r[j] = (short)p[j * stride];
    return r;
}
#define MFMA32(a, b, c) __builtin_amdgcn_mfma_f32_32x32x16_bf16((a), (b), (c), 0, 0, 0)

__device__ __forceinline__ void s1_item(const Params& P, LAS unsigned char* lds, int item) {
    const int tid = threadIdx.x, w = tid >> 6, lane = tid & 63, r = lane & 31, hf = lane >> 5;
    const int g = item & 1, tc = (item >> 1) % 18, b = item / 36;
    const bool isx = tc < 16;
    const int seq0 = isx ? b * 2048 : TX + b * 256, seq1 = seq0 + (isx ? 2048 : 256), row0 = seq0 + 128 * (isx ? tc : tc - 16);
    const int jf = isx ? tc + 2 : tc - 16, jb = isx ? 17 - tc : 17 - tc;
    LAS u16* Bs = (LAS u16*)lds;
    LAS u16* Xs = (LAS u16*)(lds + 34816);
    LAS float* wfb = (LAS float*)(lds + 34816 + 18432);
    const u16* XBC = (const u16*)(P.ws + OFF_XBC);
    const float *CSF = (const float*)(P.ws + OFF_CSF), *CSB = (const float*)(P.ws + OFF_CSB), *DTF = (const float*)(P.ws + OFF_DTF), *DTB = (const float*)(P.ws + OFF_DTB);
    u16* ST = (u16*)(P.ws + OFF_ST);
    stage_conv<128>(Bs, 136, XBC, row0, seq0, seq1, 1024 + 128 * g, P.scw, P.scb);
    __syncthreads();
    const int pb = w >> 2, nb = w & 3;
    bf16x8 Bf[8];
#pragma unroll
    for (int ks = 0; ks < 8; ++ks) Bf[ks] = gather8(Bs + (16 * ks + 8 * hf) * 136 + 32 * nb + r, 136);
    for (int hh = 0; hh < 8; ++hh) {
        const int h = 8 * g + hh;
        stage_conv<64>(Xs, 72, XBC, row0, seq0, seq1, 64 * h, P.scw, P.scb);
        if (tid < 256) { const int l = tid & 127;
            if (tid < 128) wfb[l] = __expf(CSF[(size_t)(row0 + 127) * 16 + h] - CSF[(size_t)(row0 + l) * 16 + h]) * DTF[(size_t)(row0 + l) * 16 + h];
            else wfb[128 + l] = __expf(CSB[(size_t)row0 * 16 + h] - CSB[(size_t)(row0 + l) * 16 + h]) * DTB[(size_t)(row0 + l) * 16 + h]; }
        __syncthreads();
        f32x16 accf, accb;
#pragma unroll
        for (int i = 0; i < 16; ++i) { accf[i] = 0.f; accb[i] = 0.f; }
#pragma unroll
        for (int ks = 0; ks < 8; ++ks) {
            const int lb = 16 * ks + 8 * hf;
            float xv[8];
#pragma unroll
            for (int j = 0; j < 8; ++j) xv[j] = bf2f(Xs[(lb + j) * 72 + 32 * pb + r]);
            bf16x8 af, ab;
            u32 t;
#pragma unroll
            for (int j = 0; j < 8; j += 2) {
                t = cvt_pk_bf16(xv[j] * wfb[lb + j], xv[j + 1] * wfb[lb + j + 1]); af[j] = (short)(t & 0xffffu); af[j + 1] = (short)(t >> 16);
                t = cvt_pk_bf16(xv[j] * wfb[128 + lb + j], xv[j + 1] * wfb[128 + lb + j + 1]); ab[j] = (short)(t & 0xffffu); ab[j + 1] = (short)(t >> 16);
            }
            accf = MFMA32(af, Bf[ks], accf); accb = MFMA32(ab, Bf[ks], accb);
        }
        const int n = 32 * nb + r;
        if (jf <= 16) { u16* sp = ST + ((size_t)((b * 2 + 0) * 17 + jf) * 16 + h) * 8192;
#pragma unroll
            for (int i = 0; i < 16; ++i) { const int p = 32 * pb + (i & 3) + 8 * (i >> 2) + 4 * hf; sp[p * 128 + n] = f2bf(accf[i]); } }
        if (jb <= 16) { u16* sp = ST + ((size_t)((b * 2 + 1) * 17 + jb) * 16 + h) * 8192;
#pragma unroll
            for (int i = 0; i < 16; ++i) { const int p = 32 * pb + (i & 3) + 8 * (i >> 2) + 4 * hf; sp[p * 128 + n] = f2bf(accb[i]); } }
        __syncthreads();
    }
}

__device__ __forceinline__ void phase_s2(const Params& P) {
    u16* ST = (u16*)(P.ws + OFF_ST); const float* CDEC = (const float*)(P.ws + OFF_CDEC);
    const int nth = gridDim.x * 512;
    for (int v = blockIdx.x * 512 + threadIdx.x; v < 32 * 2 * 16 * 1024; v += nth) {
        const int pn = (v & 1023) * 8, h = (v >> 10) & 15, bd = v >> 14;
        float hs[8];
#pragma unroll
        for (int j = 0; j < 8; ++j) hs[j] = 0.f;
        for (int s = 0; s < 17; ++s) {
            u16* ptr = ST + ((size_t)(bd * 17 + s) * 16 + h) * 8192 + pn; const float dec = CDEC[(bd * 18 + s) * 16 + h];
            const u32x4 q = *(const u32x4*)ptr;
            hs[0] = hs[0] * dec + lo_f(q.x); hs[1] = hs[1] * dec + hi_f(q.x); hs[2] = hs[2] * dec + lo_f(q.y); hs[3] = hs[3] * dec + hi_f(q.y);
            hs[4] = hs[4] * dec + lo_f(q.z); hs[5] = hs[5] * dec + hi_f(q.z); hs[6] = hs[6] * dec + lo_f(q.w); hs[7] = hs[7] * dec + hi_f(q.w);
            u32x4 o; o.x = cvt_pk_bf16(hs[0], hs[1]); o.y = cvt_pk_bf16(hs[2], hs[3]); o.z = cvt_pk_bf16(hs[4], hs[5]); o.w = cvt_pk_bf16(hs[6], hs[7]);
            *(u32x4*)ptr = o;
        }
    }
}

__device__ __forceinline__ void s3_item(const Params& P, LAS unsigned char* lds, int item) {
    const int tid = threadIdx.x, w = tid >> 6, lane = tid & 63, r = lane & 31, hf = lane >> 5;
    const int g = item & 1, c = (item >> 1) & 15, b = item >> 5;
    const int seq0 = b * 2048, seq1 = seq0 + 2048, row0 = seq0 + 128 * c;
    LAS u16* Cs = (LAS u16*)lds;
    LAS u16* Ms = (LAS u16*)(lds + 34816);
    LAS u16* Gs = (LAS u16*)(lds + 69632);
    LAS u16* Xs = (LAS u16*)(lds + 104448);
    LAS u16* Hf = (LAS u16*)(lds + 122880);
    LAS u16* Hb = (LAS u16*)(lds + 140288);
    LAS float* ar = (LAS float*)(lds + 157696);
    LAS float* ssq = (LAS float*)(lds + 159744);
    const u16* XBC = (const u16*)(P.ws + OFF_XBC); const u16* ST = (const u16*)(P.ws + OFF_ST); u16* Yg = (u16*)(P.ws + OFF_Y);
    const float *CSF = (const float*)(P.ws + OFF_CSF), *CSB = (const float*)(P.ws + OFF_CSB), *DTF = (const float*)(P.ws + OFF_DTF), *DTB = (const float*)(P.ws + OFF_DTB);
    stage_conv<128>(Cs, 136, XBC, row0, seq0, seq1, 1280 + 128 * g, P.scw, P.scb);
    stage_conv<128>(Ms, 136, XBC, row0, seq0, seq1, 1024 + 128 * g, P.scw, P.scb);
    if (tid < 128) ssq[tid] = 0.f;
    __syncthreads();
    {
        const int wr2 = w >> 1, wc2 = w & 1;
        f32x16 g0, g1;
#pragma unroll
        for (int i = 0; i < 16; ++i) { g0[i] = 0.f; g1[i] = 0.f; }
#pragma unroll
        for (int ks = 0; ks < 8; ++ks) {
            const bf16x8 a = *(const LAS bf16x8*)(Cs + (32 * wr2 + r) * 136 + 16 * ks + 8 * hf);
            const bf16x8 b0 = *(const LAS bf16x8*)(Ms + (64 * wc2 + r) * 136 + 16 * ks + 8 * hf);
            const bf16x8 b1 = *(const LAS bf16x8*)(Ms + (64 * wc2 + 32 + r) * 136 + 16 * ks + 8 * hf);
            g0 = MFMA32(a, b0, g0); g1 = MFMA32(a, b1, g1);
        }
#pragma unroll
        for (int i = 0; i < 16; ++i) { const int l = 32 * wr2 + (i & 3) + 8 * (i >> 2) + 4 * hf;
            Gs[l * 136 + 64 * wc2 + r] = f2bf(g0[i]); Gs[l * 136 + 64 * wc2 + 32 + r] = f2bf(g1[i]); }
    }
    float sq[16];
#pragma unroll
    for (int i = 0; i < 16; ++i) sq[i] = 0.f;
    const int rb = w >> 1, cb2 = w & 1;
    for (int hh = 0; hh < 8; ++hh) {
        const int h = 8 * g + hh;
        __syncthreads();
        stage_conv<64>(Xs, 72, XBC, row0, seq0, seq1, 64 * h, P.scw, P.scb);
        { const u16* stf = ST + ((size_t)((b * 2 + 0) * 17 + (c + 1)) * 16 + h) * 8192; const u16* stb = ST + ((size_t)((b * 2 + 1) * 17 + (16 - c)) * 16 + h) * 8192;
#pragma unroll
          for (int i = 0; i < 4; ++i) { const int idx = tid + 512 * i, mat = idx >> 10, chk = idx & 1023, p = chk >> 4, n8 = (chk & 15) * 8;
              *(LAS u32x4*)((mat ? Hb : Hf) + p * 136 + n8) = *(const u32x4*)((mat ? stb : stf) + p * 128 + n8); } }
        { const int which = tid >> 7, l = tid & 127; const float* srcp = (which == 0) ? CSF : (which == 1) ? CSB : (which == 2) ? DTF : DTB; ar[which * 128 + l] = srcp[(size_t)(row0 + l) * 16 + h]; }
        __syncthreads();
        {
            const int l = tid >> 2, s0 = (tid & 3) * 32; const float csf_l = ar[l], csb_l = ar[128 + l], dg = ar[256 + l] + ar[384 + l], dsk = P.ssm_d[h];
#pragma unroll
            for (int s8 = 0; s8 < 4; ++s8) { const int s = s0 + 8 * s8; const bf16x8 gv = *(const LAS bf16x8*)(Gs + l * 136 + s); float o[8];
#pragma unroll
                for (int j = 0; j < 8; ++j) { const int ss = s + j; float f;
                    if (ss < l) f = __expf(csf_l - ar[ss]) * ar[256 + ss]; else if (ss > l) f = __expf(csb_l - ar[128 + ss]) * ar[384 + ss]; else f = dg;
                    o[j] = bf2f((u16)gv[j]) * f + ((ss == l) ? dsk : 0.f); }
                u32x4 q; q.x = cvt_pk_bf16(o[0], o[1]); q.y = cvt_pk_bf16(o[2], o[3]); q.z = cvt_pk_bf16(o[4], o[5]); q.w = cvt_pk_bf16(o[6], o[7]);
                *(LAS u32x4*)(Ms + l * 136 + s) = q; }
        }
        __syncthreads();
        f32x16 ad, af, ab;
#pragma unroll
        for (int i = 0; i < 16; ++i) { ad[i] = 0.f; af[i] = 0.f; ab[i] = 0.f; }
#pragma unroll
        for (int ks = 0; ks < 8; ++ks) {
            const int ko = 16 * ks + 8 * hf;
            const bf16x8 am = *(const LAS bf16x8*)(Ms + (32 * rb + r) * 136 + ko);
            const bf16x8 bx = gather8(Xs + ko * 72 + 32 * cb2 + r, 72);
            ad = MFMA32(am, bx, ad);
            const bf16x8 ac = *(const LAS bf16x8*)(Cs + (32 * rb + r) * 136 + ko);
            const bf16x8 bhf = *(const LAS bf16x8*)(Hf + (32 * cb2 + r) * 136 + ko);
            const bf16x8 bhb = *(const LAS bf16x8*)(Hb + (32 * cb2 + r) * 136 + ko);
            af = MFMA32(ac, bhf, af); ab = MFMA32(ac, bhb, ab);
        }
#pragma unroll
        for (int i = 0; i < 16; ++i) { const int l = 32 * rb + (i & 3) + 8 * (i >> 2) + 4 * hf;
            const float y = ad[i] + __expf(ar[l]) * af[i] + __expf(ar[128 + l]) * ab[i];
            u16* zp = Yg + (size_t)(row0 + l) * 2048 + 64 * h + 32 * cb2 + r;
            const float v = y * silu_f(bf2f(*zp)); *zp = f2bf(v); sq[i] += v * v; }
    }
#pragma unroll
    for (int i = 0; i < 16; ++i) { float s = sq[i];
#pragma unroll
        for (int o = 16; o >= 1; o >>= 1) s += __shfl_xor(s, o);
        if (r == 0) atomicAdd((float*)(ssq + 32 * rb + (i & 3) + 8 * (i >> 2) + 4 * hf), s); }
    __syncthreads();
#pragma unroll 4
    for (int i = 0; i < 16; ++i) { const int idx = tid + 512 * i, l = idx >> 6, c8 = (idx & 63) * 8;
        u16* yp = Yg + (size_t)(row0 + l) * 2048 + 512 * g + c8; const float rstd = rsqrtf(ssq[l] * (1.0f / 512.0f) + EPSF);
        const u32x4 q = *(const u32x4*)yp; const f32x4 w0 = *(const f32x4*)(P.ssm_nw + 512 * g + c8), w1 = *(const f32x4*)(P.ssm_nw + 512 * g + c8 + 4);
        u32x4 o; o.x = cvt_pk_bf16(lo_f(q.x) * rstd * w0[0], hi_f(q.x) * rstd * w0[1]); o.y = cvt_pk_bf16(lo_f(q.y) * rstd * w0[2], hi_f(q.y) * rstd * w0[3]);
        o.z = cvt_pk_bf16(lo_f(q.z) * rstd * w1[0], hi_f(q.z) * rstd * w1[1]); o.w = cvt_pk_bf16(lo_f(q.w) * rstd * w1[2], hi_f(q.w) * rstd * w1[3]);
        *(u32x4*)yp = o; }
    __syncthreads();
}

__device__ __forceinline__ void phase_lnb(const Params& P) {
    const int lane = threadIdx.x & 63, gw = blockIdx.x * 8 + (threadIdx.x >> 6), nwv = gridDim.x * 8;
    u16* Yg = (u16*)(P.ws + OFF_Y);
    for (int row = gw; row < TX; row += nwv) {
        u16* p = Yg + (size_t)row * 2048 + 1024 + lane * 8;
        const u32x4 q0 = *(const u32x4*)p, q1 = *(const u32x4*)(p + 512);
        float v[16] = {lo_f(q0.x), hi_f(q0.x), lo_f(q0.y), hi_f(q0.y), lo_f(q0.z), hi_f(q0.z), lo_f(q0.w), hi_f(q0.w), lo_f(q1.x), hi_f(q1.x), lo_f(q1.y), hi_f(q1.y), lo_f(q1.z), hi_f(q1.z), lo_f(q1.w), hi_f(q1.w)};
        float s = 0.f;
#pragma unroll
        for (int j = 0; j < 16; ++j) s += v[j];
        const float mu = wave_sum(s) * (1.0f / 1024.0f);
        float q = 0.f;
#pragma unroll
        for (int j = 0; j < 16; ++j) { v[j] -= mu; q += v[j] * v[j]; }
        const float rstd = rsqrtf(wave_sum(q) * (1.0f / 1024.0f) + EPSF);
        float o[16];
#pragma unroll
        for (int j = 0; j < 16; ++j) { const int col = (j < 8) ? (lane * 8 + j) : (512 + lane * 8 + j - 8); o[j] = silu_f(v[j] * rstd * P.lnw[col] + P.lnb[col]); }
        u32x4 a, bq; a.x = cvt_pk_bf16(o[0], o[1]); a.y = cvt_pk_bf16(o[2], o[3]); a.z = cvt_pk_bf16(o[4], o[5]); a.w = cvt_pk_bf16(o[6], o[7]);
        bq.x = cvt_pk_bf16(o[8], o[9]); bq.y = cvt_pk_bf16(o[10], o[11]); bq.z = cvt_pk_bf16(o[12], o[13]); bq.w = cvt_pk_bf16(o[14], o[15]);
        *(u32x4*)p = a; *(u32x4*)(p + 512) = bq;
    }
}

template <int PH> __device__ __forceinline__ void run_phase(const Params& P, LAS unsigned char* lds) {
    unsigned char* ws = P.ws;
    const float* MOD = (const float*)(ws + OFF_MOD);
    if constexpr (PH == 0) phase_prep(P, lds);
    if constexpr (PH == 1) phase_norm<0>(P, P.x, P.ctx, TT, P.norm_ffn1, 0, 1, (u16*)(ws + OFF_H), nullptr);
    if constexpr (PH == 2) { Gemm gm{(const bf16_t*)(ws + OFF_H), (const bf16_t*)(ws + OFF_WGU1), TT, NGU, 1024}; StaticOrder S; S.init(TT, NGU, (int)gridDim.x, (int)blockIdx.x);
        EpiSwiGLU E{(bf16_t*)(ws + OFF_ACT)}; gemm_phase<EpiSwiGLU, StaticOrder, false>(lds, gm, S, E, nullptr); }
    if constexpr (PH == 3) { Gemm gm{(const bf16_t*)(ws + OFF_ACT), (const bf16_t*)(ws + OFF_WD1), TT, 1024, DFF}; StaticOrder S; S.init(TT, 1024, (int)gridDim.x, (int)blockIdx.x);
        EpiResid E{P.x, P.out, P.ctx, (float*)(ws + OFF_XC1), MOD + 2 * 1024, 0.5f}; gemm_phase<EpiResid, StaticOrder, false>(lds, gm, S, E, nullptr); }
    if constexpr (PH == 4) phase_norm<0>(P, P.out, (const float*)(ws + OFF_XC1), TT, P.norm_mix, 3, 4, (u16*)(ws + OFF_H), nullptr);
    if constexpr (PH == 5) { Gemm gm{(const bf16_t*)(ws + OFF_H), (const bf16_t*)(ws + OFF_WIN), TX, NIN, 1024}; InOrder S; S.init(TX, NIN, (int)gridDim.x, (int)blockIdx.x);
        EpiInProj E{(bf16_t*)(ws + OFF_XBC), (float*)(ws + OFF_DT), (bf16_t*)(ws + OFF_Y), (bf16_t*)(ws + OFF_U)}; gemm_phase<EpiInProj, InOrder, false>(lds, gm, S, E, nullptr); }
    if constexpr (PH == 6) phase_p6(P, lds);
    if constexpr (PH == 7) { for (int it = blockIdx.x; it < 1152; it += gridDim.x) s1_item(P, lds, it); }
    if constexpr (PH == 8) phase_s2(P);
    if constexpr (PH == 9) { for (int it = blockIdx.x; it < 1024; it += gridDim.x) s3_item(P, lds, it); phase_lnb(P); }
    if constexpr (PH == 10) { Gemm gm{(const bf16_t*)(ws + OFF_Y), (const bf16_t*)(ws + OFF_WOUT), TX, 1024, 2048}; StaticOrder S; S.init(TX, 1024, (int)gridDim.x, (int)blockIdx.x);
        EpiResid E{P.out, P.out, nullptr, nullptr, MOD + 5 * 1024, 1.0f}; gemm_phase<EpiResid, StaticOrder, false>(lds, gm, S, E, nullptr); }
    if constexpr (PH == 11) phase_norm<0>(P, P.out, nullptr, TX, P.norm_ffn2, 6, 7, (u16*)(ws + OFF_H), nullptr);
    if constexpr (PH == 12) { Gemm gm{(const bf16_t*)(ws + OFF_H), (const bf16_t*)(ws + OFF_WGU2), TX, NGU, 1024}; StaticOrder S; S.init(TX, NGU, (int)gridDim.x, (int)blockIdx.x);
        EpiSwiGLU E{(bf16_t*)(ws + OFF_ACT)}; gemm_phase<EpiSwiGLU, StaticOrder, false>(lds, gm, S, E, nullptr); }
    if constexpr (PH == 13) { Gemm gm{(const bf16_t*)(ws + OFF_ACT), (const bf16_t*)(ws + OFF_WD2), TX, 1024, DFF}; StaticOrder S; S.init(TX, 1024, (int)gridDim.x, (int)blockIdx.x);
        EpiResid E{P.out, P.out, nullptr, nullptr, MOD + 8 * 1024, 0.5f}; gemm_phase<EpiResid, StaticOrder, false>(lds, gm, S, E, nullptr); }
    if constexpr (PH == 14) phase_norm<1>(P, P.out, nullptr, TX, P.fnorm, 0, 0, nullptr, P.out);
}

template <int PH> __global__ void __launch_bounds__(512, 2) k_one(Params P) {
    extern __shared__ __attribute__((aligned(16))) unsigned char shm[];
    run_phase<PH>(P, (LAS unsigned char*)shm);
}

template <int PH> __device__ __forceinline__ void run_all(const Params& P, LAS unsigned char* lds, cg::grid_group& grid) {
    run_phase<PH>(P, lds);
    if constexpr (PH + 1 < NPHASE) { grid.sync(); run_all<PH + 1>(P, lds, grid); }
}
__global__ void __launch_bounds__(512, 2) mega(Params P) {
    extern __shared__ __attribute__((aligned(16))) unsigned char shm[];
    cg::grid_group grid = cg::this_grid();
    run_all<0>(P, (LAS unsigned char*)shm, grid);
}

template <int PH> static void launch_each(int grid, hipStream_t stream, const Params& p) {
    static bool attr = false; if (!attr) { (void)hipFuncSetAttribute((const void*)k_one<PH>, hipFuncAttributeMaxDynamicSharedMemorySize, LDS_BYTES); attr = true; }
    hipLaunchKernelGGL(k_one<PH>, dim3(grid), dim3(512), LDS_BYTES, stream, p);
    if constexpr (PH + 1 < NPHASE) launch_each<PH + 1>(grid, stream, p);
}

#ifndef MK_MULTI
#define MK_MULTI 0
#endif
extern "C" void kernel_launch(void* const* d_in, const int* in_sizes, int n_in, void* d_out, int out_size, void* d_ws, size_t ws_size, hipStream_t stream) {
    static int grid = 0;
    if (grid == 0) {
        if (n_in != 30 || ws_size < WS_TOTAL) { fprintf(stderr, "kernel_launch: expected 30 inputs and >= %zu bytes of workspace (got %d, %zu)\n", (size_t)WS_TOTAL, n_in, ws_size); grid = -1; return; }
        int dev = 0, cus = 0, per_cu = 0;
        (void)hipGetDevice(&dev); (void)hipDeviceGetAttribute(&cus, hipDeviceAttributeMultiprocessorCount, dev);
        if (hipFuncSetAttribute((const void*)mega, hipFuncAttributeMaxDynamicSharedMemorySize, LDS_BYTES) != hipSuccess) { fprintf(stderr, "kernel_launch: hipFuncSetAttribute failed\n"); }
        if (hipOccupancyMaxActiveBlocksPerMultiprocessor(&per_cu, (const void*)mega, 512, LDS_BYTES) != hipSuccess || per_cu < 1) { fprintf(stderr, "kernel_launch: occupancy query says %d\n", per_cu); per_cu = 1; }
        (void)hipGetLastError();
        grid = cus * per_cu;
    }
    if (grid < 0) return;
    Params p{};
    const float** pp = (const float**)&p;
    for (int i = 0; i < 30; ++i) pp[i] = (const float*)d_in[i];
    p.out = (float*)d_out; p.ws = (unsigned char*)d_ws;
#if MK_MULTI
    launch_each<0>(grid, stream, p);
#else
    void* args[] = {&p};
    hipError_t e = hipLaunchCooperativeKernel((const void*)mega, dim3(grid), dim3(512), args, LDS_BYTES, stream);
    if (e != hipSuccess) fprintf(stderr, "kernel_launch: cooperative launch failed: %s (grid %d)\n", hipGetErrorString(e), grid);
#endif
}
```

```cpp
#include <hip/hip_runtime.h>
#include <hip/hip_cooperative_groups.h>
#include <cstdio>
namespace cg = cooperative_groups;
__device__ __forceinline__ int tid_fresh() { int t = (int)threadIdx.x; asm volatile("" : "+v"(t)); return t; }
namespace pg8 {
#define PG8_LAS __attribute__((address_space(3)))
typedef unsigned short bf16_t;
typedef short bf16x8 __attribute__((ext_vector_type(8)));
typedef float f32x4 __attribute__((ext_vector_type(4)));
typedef unsigned u32x4 __attribute__((ext_vector_type(4)));
constexpr int BM = 256, BK = 64, HALF = 128, HTB = HALF * BK * 2  , STAGE_BYTES = 8 * HTB, NXCD = 8, WGM = 8;

__host__ __device__ __forceinline__ int lds_byte(int r, int c) { const int st = (r >> 4) * 2 + (c >> 5), rr = r & 15, cc = c & 31, ob = rr * 64 + cc * 2; return st * 1024 + (ob ^ (((ob >> 9) & 1) << 5)); }
__host__ __device__ __forceinline__ void stage_rc(int b, int& R, int& C) { const int st = b / 1024, sb = b % 1024, swz = sb ^ (((sb >> 9) & 1) << 5); R = (st >> 1) * 16 + swz / 64; C = (st & 1) * 32 + (swz % 64) / 2; }
__host__ __device__ __forceinline__ int perm32(int rho) { const int n = rho >> 4, i = rho & 15; return 8 * (i >> 2) + 4 * n + (i & 3); }

struct Unit { int pm, pn; };
struct Gemm { const bf16_t* A; const bf16_t* Bt; int M, N, K; };

struct StaticOrder {
    int nM, nN, nwg, G, c;
    __host__ __device__ void init(int M, int N, int G_, int c_) { nM = M / BM; nN = N / BM; nwg = nM * nN; G = G_; c = c_; }
    __host__ __device__ bool next(int i, Unit& u) const {
        const long L = (long)i * G + c; if (L >= nwg) return false;
        int wgid = (int)L; { const int q = nwg / NXCD, r = nwg % NXCD, xcd = wgid % NXCD, off = wgid / NXCD; wgid = (xcd < r ? xcd * (q + 1) : r * (q + 1) + (xcd - r) * q) + off; }
        const int nig = WGM * nN, gid = wgid / nig, fm = gid * WGM, gsz = (nM - fm) < WGM ? (nM - fm) : WGM;
        u.pm = fm + ((wgid % nig) % gsz); u.pn = (wgid % nig) / gsz; return true;
    }
    __device__ __forceinline__ void a_ready(const Unit&) const {}
    __device__ __forceinline__ void done(const Unit&) const {}
};
__device__ __forceinline__ unsigned cvt_pk_bf16(float lo, float hi) { unsigned r; asm volatile("v_cvt_pk_bf16_f32 %0, %1, %2" : "=v"(r) : "v"(lo), "v"(hi)); return r; }
typedef float f32x2 __attribute__((ext_vector_type(2)));
template <class Epi, class Sched, bool STAMP = false>
__device__ __forceinline__ void gemm_phase(PG8_LAS unsigned char* lds, const Gemm g, const Sched& S, const Epi& E, unsigned long long* stamps) {
    const int tid = tid_fresh(), wid = __builtin_amdgcn_readfirstlane(tid >> 6), lane = tid & 63, wr = wid >> 2, wc = wid & 3, fr = lane & 15, fq = lane >> 4;
    const int K = g.K, nt = K / BK;
    int ts_lo = 0, ts_hi = 0, nts = 0; const unsigned long long rt_entry = STAMP ? (unsigned long long)wall_clock64() : 0ull;
#define PG8_STAMP() do { if (STAMP && wid == 0 && nts < 64) { const unsigned long long _c = (unsigned long long)clock64(); \
        ts_lo = (lane == nts) ? (int)(unsigned)_c : ts_lo; ts_hi = (lane == nts) ? (int)(unsigned)(_c >> 32) : ts_hi; ++nts; } } while (0)
    PG8_STAMP();
    unsigned voffA[2], voffB[2];
#pragma unroll
    for (int i = 0; i < 2; ++i) { int R, C; stage_rc(tid * 16 + i * 8192, R, C); const int Rb = Epi::PERM ? ((R & ~31) + perm32(R & 31)) : R;
        voffA[i] = (unsigned)(R * K + C) * 2u; voffB[i] = (unsigned)(Rb * K + C) * 2u; }
    const size_t kstep = (size_t)(BK * 2);
    const size_t hstep = (size_t)HALF * K * 2;
    const size_t tstep = 2 * hstep;
    const unsigned ldsw = (unsigned)wid * 1024u;
    const int aoff = lds_byte(wr * 64 + fr, fq * 8), boff = lds_byte(wc * 32 + fr, fq * 8);
#define PG8_SA(b, h) (((b) * 2 + (h)) * HTB)
#define PG8_SB(b, h) ((4 + (b) * 2 + (h)) * HTB)
#define PG8_STAGE(bufoff, gbase, voff) do { _Pragma("unroll") for (int _i = 0; _i < 2; ++_i) \
        __builtin_amdgcn_global_load_lds((const unsigned*)((const char*)(gbase) + (voff)[_i]), (PG8_LAS unsigned*)(lds + (bufoff) + ldsw + _i * 8192), 16, 0, 0); } while (0)
#define PG8_LDA(dst, b, h) do { _Pragma("unroll") for (int m = 0; m < 4; ++m) _Pragma("unroll") for (int k = 0; k < 2; ++k) dst[m][k] = *(const PG8_LAS bf16x8*)(lds + PG8_SA(b, h) + aoff + m * 2048 + k * 1024); } while (0)
#define PG8_LDB(dst, b, h) do { _Pragma("unroll") for (int n = 0; n < 2; ++n) _Pragma("unroll") for (int k = 0; k < 2; ++k) dst[n][k] = *(const PG8_LAS bf16x8*)(lds + PG8_SB(b, h) + boff + n * 2048 + k * 1024); } while (0)
#define PG8_MMA(ai, bj, At, Bt) do { __builtin_amdgcn_s_setprio(1); _Pragma("unroll") for (int m = 0; m < 4; ++m) _Pragma("unroll") for (int n = 0; n < 2; ++n) _Pragma("unroll") for (int k = 0; k < 2; ++k) \
        acc[ai][bj][m][n] = __builtin_amdgcn_mfma_f32_16x16x32_bf16(Bt[n][k], At[m][k], acc[ai][bj][m][n], 0, 0, 0); __builtin_amdgcn_s_setprio(0); } while (0)
#define PG8_WAIT_V(n) asm volatile("s_waitcnt vmcnt(" #n ")" ::: "memory")
#define PG8_WAIT_L(n) asm volatile("s_waitcnt lgkmcnt(" #n ")" ::: "memory")
#define PG8_BAR __builtin_amdgcn_s_barrier()
#define PG8_SCHED __builtin_amdgcn_sched_barrier(0)
    Unit cur, nxt; int ui = 0;
    if (!S.next(0, cur)) return;
    f32x4 acc[2][2][4][2];
#pragma unroll
    for (int a = 0; a < 2; ++a)
#pragma unroll
        for (int b = 0; b < 2; ++b)
#pragma unroll
            for (int m = 0; m < 4; ++m)
#pragma unroll
                for (int n = 0; n < 2; ++n) acc[a][b][m][n] = (f32x4){0.f, 0.f, 0.f, 0.f};
    bf16x8 At[4][2], B0[2][2], B1[2][2];
    const char* cA = (const char*)g.A + (size_t)cur.pm * tstep; const char* cB = (const char*)g.Bt + (size_t)cur.pn * tstep;
    S.a_ready(cur);
    PG8_STAGE(PG8_SB(0, 0), cB, voffB); PG8_STAGE(PG8_SA(0, 0), cA, voffA); PG8_STAGE(PG8_SB(0, 1), cB + hstep, voffB); PG8_STAGE(PG8_SA(0, 1), cA + hstep, voffA);
    if (wr == 1) PG8_BAR;
    PG8_WAIT_V(4); PG8_BAR;
    PG8_STAGE(PG8_SB(1, 0), cB + kstep, voffB); PG8_STAGE(PG8_SA(1, 0), cA + kstep, voffA); PG8_STAGE(PG8_SB(1, 1), cB + hstep + kstep, voffB);
    PG8_WAIT_V(6); PG8_BAR;
    PG8_STAMP();
    for (;;) {
        const bool has_next = S.next(ui + 1, nxt);
        const char* nA = has_next ? (const char*)g.A + (size_t)nxt.pm * tstep : cA; const char* nB = has_next ? (const char*)g.Bt + (size_t)nxt.pn * tstep : cB;
        for (int t = 0; t < nt; t += 2) {
            const bool last = (t == nt - 2);
            const char* a1 = cA + (size_t)(t + 1) * kstep;
            const char* a2 = last ? nA : cA + (size_t)(t + 2) * kstep; const char* b2 = last ? nB : cB + (size_t)(t + 2) * kstep;
            const char* a3 = a2 + kstep; const char* b3 = b2 + kstep;
            if (last && has_next) S.a_ready(nxt);
            PG8_LDB(B0, 0, 0); PG8_SCHED; PG8_LDA(At, 0, 0); PG8_STAGE(PG8_SA(1, 1), a1 + hstep, voffA);
            PG8_WAIT_L(8); PG8_BAR; PG8_WAIT_L(0); PG8_MMA(0, 0, At, B0); PG8_BAR; PG8_SCHED;
            PG8_LDB(B1, 0, 1); PG8_STAGE(PG8_SB(0, 0), b2, voffB);
            PG8_BAR; PG8_WAIT_L(0); PG8_MMA(0, 1, At, B1); PG8_BAR;
            PG8_LDA(At, 0, 1); PG8_STAGE(PG8_SA(0, 0), a2, voffA);
            PG8_BAR; PG8_WAIT_L(0); PG8_MMA(1, 0, At, B0); PG8_BAR; PG8_SCHED;
            PG8_STAGE(PG8_SB(0, 1), b2 + hstep, voffB);
            PG8_WAIT_V(6); PG8_BAR; PG8_MMA(1, 1, At, B1); PG8_BAR;
            PG8_LDB(B0, 1, 0); PG8_SCHED; PG8_LDA(At, 1, 0); PG8_STAGE(PG8_SA(0, 1), a2 + hstep, voffA);
            PG8_WAIT_L(8); PG8_BAR; PG8_WAIT_L(0); PG8_MMA(0, 0, At, B0); PG8_BAR; PG8_SCHED;
            PG8_LDB(B1, 1, 1); PG8_STAGE(PG8_SB(1, 0), b3, voffB);
            PG8_BAR; PG8_WAIT_L(0); PG8_MMA(0, 1, At, B1); PG8_BAR;
            PG8_LDA(At, 1, 1); PG8_STAGE(PG8_SA(1, 0), a3, voffA);
            PG8_BAR; PG8_WAIT_L(0); PG8_MMA(1, 0, At, B0); PG8_BAR; PG8_SCHED;
            PG8_STAGE(PG8_SB(1, 1), b3 + hstep, voffB);
            PG8_WAIT_V(6); PG8_BAR; PG8_MMA(1, 1, At, B1); PG8_BAR;
        }
        PG8_STAMP();
        if constexpr (!Epi::AFTER_DRAIN) { E(acc, cur, wr, wc, fr, fq); S.done(cur); }
        PG8_STAMP();
        if (!has_next) break;
#pragma unroll
        for (int a = 0; a < 2; ++a)
#pragma unroll
            for (int b = 0; b < 2; ++b)
#pragma unroll
                for (int m = 0; m < 4; ++m)
#pragma unroll
                    for (int n = 0; n < 2; ++n) acc[a][b][m][n] = (f32x4){0.f, 0.f, 0.f, 0.f};
        cur = nxt; cA = nA; cB = nB; ++ui;
    }
    PG8_WAIT_V(0);
    if (wr == 0) PG8_BAR;
    PG8_BAR;
    if constexpr (Epi::AFTER_DRAIN) { E.fused(acc, cur, wr, wc, fr, fq, lds, wid, lane); S.done(cur); }
    PG8_STAMP();
    if (STAMP && wid == 0) { stamps[lane] = lane < nts ? (((unsigned long long)(unsigned)ts_hi << 32) | (unsigned)ts_lo) : 0ull;
        if (lane == 62) stamps[62] = rt_entry; if (lane == 63) stamps[63] = (unsigned long long)wall_clock64(); }
#undef PG8_STAMP
#undef PG8_SA
#undef PG8_SB
#undef PG8_STAGE
#undef PG8_LDA
#undef PG8_LDB
#undef PG8_MMA
#undef PG8_WAIT_V
#undef PG8_WAIT_L
#undef PG8_BAR
#undef PG8_SCHED
}
}
using namespace pg8;
#define LAS __attribute__((address_space(3)))
typedef unsigned short u16;
typedef unsigned int u32;
typedef float f32x16 __attribute__((ext_vector_type(16)));

constexpr int TX = 65536, TCX = 8192, TT = 73728;
constexpr int DFF = 2816, NGU = 5632, NIN = 4864;
constexpr float EPSF = 1e-6f;
constexpr int LDS_BYTES = 160768;
constexpr int NPHASE = 15;

constexpr size_t SZ_WGU = (size_t)NGU * 1024 * 2, SZ_WD = (size_t)1024 * DFF * 2, SZ_WIN = (size_t)NIN * 1024 * 2, SZ_WOUT = (size_t)1024 * 2048 * 2;
constexpr size_t OFF_WGU1 = 0, OFF_WD1 = OFF_WGU1 + SZ_WGU, OFF_WGU2 = OFF_WD1 + SZ_WD, OFF_WD2 = OFF_WGU2 + SZ_WGU, OFF_WIN = OFF_WD2 + SZ_WD, OFF_WOUT = OFF_WIN + SZ_WIN;
constexpr size_t OFF_MOD = OFF_WOUT + SZ_WOUT;
constexpr size_t OFF_XC1 = OFF_MOD + (size_t)33 * 9216 * 4;
constexpr size_t OFF_DT = OFF_XC1 + (size_t)TCX * 1024 * 4;
constexpr size_t SZ_A16 = (size_t)TT * 16 * 4;
constexpr size_t OFF_DTF = OFF_DT + (size_t)TT * 32 * 4, OFF_DTB = OFF_DTF + SZ_A16, OFF_CSF = OFF_DTB + SZ_A16, OFF_CSB = OFF_CSF + SZ_A16;
constexpr size_t OFF_CDEC = OFF_CSB + SZ_A16;
constexpr size_t OFF_BAR = OFF_CDEC + (size_t)32 * 2 * 18 * 16 * 4;
constexpr size_t OFF_BIG = OFF_BAR + 256;
constexpr size_t SZ_H = (size_t)TT * 1024 * 2, SZ_ACT = (size_t)TT * DFF * 2, SZ_ST = (size_t)32 * 2 * 17 * 16 * 8192 * 2;
constexpr size_t OFF_H = OFF_BIG, OFF_ACT = OFF_BIG + SZ_H, OFF_ST = OFF_BIG;
constexpr size_t WS_TOTAL = (size_t)1 << 30;
constexpr size_t OFF_U = WS_TOTAL - (size_t)TX * 1024 * 2, OFF_XBC = OFF_U - (size_t)TT * 1536 * 2, OFF_Y = OFF_XBC - (size_t)TX * 2048 * 2;
static_assert(OFF_BIG % 256 == 0 && OFF_ACT + SZ_ACT <= WS_TOTAL && OFF_Y >= OFF_ST + SZ_ST && OFF_Y >= OFF_H + SZ_H, "workspace map");

struct Params {
    const float *x, *c, *ctx, *c_ctx, *w_mod, *b_mod, *norm_ffn1, *g1, *u1, *d1, *norm_mix, *w_in, *scw, *scb, *dtbf, *dtbb, *alf, *alb, *ssm_d, *ssm_nw, *ccw, *ccb, *lnw, *lnb,
        *w_out, *norm_ffn2, *g2, *u2, *d2, *fnorm;
    float* out; unsigned char* ws; int ph_lo, ph_hi;
};

__device__ __forceinline__ float bf2f(u16 v) { return __uint_as_float(((u32)v) << 16); }
__device__ __forceinline__ u16 f2bf(float f) { u32 u = __float_as_uint(f); u += 0x7FFFu + ((u >> 16) & 1u); return (u16)(u >> 16); }
__device__ __forceinline__ float lo_f(u32 v) { return __uint_as_float(v << 16); }
__device__ __forceinline__ float hi_f(u32 v) { return __uint_as_float(v & 0xffff0000u); }
__device__ __forceinline__ float silu_f(float x) { return x * __builtin_amdgcn_rcpf(1.0f + __expf(-x)); }
__device__ __forceinline__ float sigm_f(float x) { return __builtin_amdgcn_rcpf(1.0f + __expf(-x)); }
__device__ __forceinline__ float wave_sum(float v) {
#pragma unroll
    for (int o = 32; o >= 1; o >>= 1) v += __shfl_xor(v, o);
    return v;
}

struct InOrder : StaticOrder {
    __device__ bool next(int i, Unit& u) const {
        const long L = (long)i * G + c;
        if (L < nwg) return StaticOrder::next(i, u);
        const int e = (int)(L - nwg); if (e >= 192) return false;
        u.pm = 256 + (e & 31); u.pn = e >> 5; return true;
    }
};

struct EpiSwiGLU {
    static constexpr bool PERM = true, AFTER_DRAIN = false;
    bf16_t* O;
    __device__ __forceinline__ void operator()(const f32x4 (&acc)[2][2][4][2], const Unit& u, int wr, int wc, int fr, int fq) const {
        const int row0 = u.pm * BM + wr * 64 + fr, col0 = u.pn * 128 + wc * 32 + 8 * fq;
#pragma unroll
        for (int ai = 0; ai < 2; ++ai)
#pragma unroll
            for (int m = 0; m < 4; ++m) {
                bf16_t* rowp = O + (size_t)(row0 + ai * HALF + m * 16) * DFF + col0;
                const f32x4 g0 = acc[ai][0][m][0], g1 = acc[ai][0][m][1], u0 = acc[ai][1][m][0], u1 = acc[ai][1][m][1];
                u32x4 w;
                w.x = cvt_pk_bf16(silu_f(g0[0]) * u0[0], silu_f(g0[1]) * u0[1]); w.y = cvt_pk_bf16(silu_f(g0[2]) * u0[2], silu_f(g0[3]) * u0[3]);
                w.z = cvt_pk_bf16(silu_f(g1[0]) * u1[0], silu_f(g1[1]) * u1[1]); w.w = cvt_pk_bf16(silu_f(g1[2]) * u1[2], silu_f(g1[3]) * u1[3]);
                *(u32x4*)rowp = w;
            }
    }
};

struct EpiResid {
    static constexpr bool PERM = false, AFTER_DRAIN = false;
    const float* baseX; float* outX; const float* baseC; float* outC; const float* mod; float s;
    __device__ __forceinline__ void operator()(const f32x4 (&acc)[2][2][4][2], const Unit& u, int wr, int wc, int fr, int fq) const {
        const int row0 = u.pm * BM + wr * 64 + fr, col0 = u.pn * BM + wc * 32 + 4 * fq;
        const bool isx = u.pm < 256; const int b = isx ? (u.pm >> 3) : 32;
        const float* bp0 = isx ? baseX + (size_t)row0 * 1024 : baseC + (size_t)(row0 - TX) * 1024;
        float* op0 = isx ? outX + (size_t)row0 * 1024 : outC + (size_t)(row0 - TX) * 1024;
        f32x4 mv[2][2];
#pragma unroll
        for (int bj = 0; bj < 2; ++bj)
#pragma unroll
            for (int n = 0; n < 2; ++n) mv[bj][n] = *(const f32x4*)(mod + (size_t)b * 9216 + col0 + bj * HALF + n * 16) * s;
#pragma unroll
        for (int ai = 0; ai < 2; ++ai)
#pragma unroll
            for (int m = 0; m < 4; ++m) {
                const size_t ro = (size_t)(ai * HALF + m * 16) * 1024 + col0;
                f32x4 bv[2][2];
#pragma unroll
                for (int bj = 0; bj < 2; ++bj)
#pragma unroll
                    for (int n = 0; n < 2; ++n) bv[bj][n] = *(const f32x4*)(bp0 + ro + bj * HALF + n * 16);
#pragma unroll
                for (int bj = 0; bj < 2; ++bj)
#pragma unroll
                    for (int n = 0; n < 2; ++n) *(f32x4*)(op0 + ro + bj * HALF + n * 16) = bv[bj][n] + mv[bj][n] * acc[ai][bj][m][n];
            }
    }
};

struct EpiInProj {
    static constexpr bool PERM = true, AFTER_DRAIN = false;
    bf16_t* XBC; float* DT; bf16_t* Y; bf16_t* U;
    __device__ __forceinline__ void operator()(const f32x4 (&acc)[2][2][4][2], const Unit& u, int wr, int wc, int fr, int fq) const {
        const int row0 = u.pm * BM + wr * 64 + fr, cin = wc * 32 + 8 * fq, pn = u.pn;
        if (pn == 5) {
            if (wc == 0) {
#pragma unroll
                for (int ai = 0; ai < 2; ++ai)
#pragma unroll
                    for (int m = 0; m < 4; ++m) {
                        float* rp = DT + (size_t)(row0 + ai * HALF + m * 16) * 32 + 8 * fq;
                        *(f32x4*)rp = acc[ai][0][m][0]; *(f32x4*)(rp + 4) = acc[ai][0][m][1];
                    }
            }
        } else if (pn <= 10) {
            bf16_t* base; int ld;
            if (pn <= 4) { base = XBC + pn * 256; ld = 1536; } else if (pn == 6) { base = XBC + 1280; ld = 1536; } else { base = Y + (pn - 7) * 256; ld = 2048; }
#pragma unroll
            for (int ai = 0; ai < 2; ++ai)
#pragma unroll
                for (int m = 0; m < 4; ++m) {
                    bf16_t* rowp = base + (size_t)(row0 + ai * HALF + m * 16) * ld + cin;
#pragma unroll
                    for (int bj = 0; bj < 2; ++bj) {
                        const f32x4 v0 = acc[ai][bj][m][0], v1 = acc[ai][bj][m][1];
                        u32x4 w; w.x = cvt_pk_bf16(v0[0], v0[1]); w.y = cvt_pk_bf16(v0[2], v0[3]); w.z = cvt_pk_bf16(v1[0], v1[1]); w.w = cvt_pk_bf16(v1[2], v1[3]);
                        *(u32x4*)(rowp + bj * HALF) = w;
                    }
                }
        } else {
            bf16_t* base = U + (pn - 11) * 128 + cin;
#pragma unroll
            for (int ai = 0; ai < 2; ++ai)
#pragma unroll
                for (int m = 0; m < 4; ++m) {
                    bf16_t* rowp = base + (size_t)(row0 + ai * HALF + m * 16) * 1024;
                    const f32x4 a0 = acc[ai][0][m][0], a1 = acc[ai][0][m][1], b0 = acc[ai][1][m][0], b1 = acc[ai][1][m][1];
                    u32x4 w;
                    w.x = cvt_pk_bf16(a0[0] * sigm_f(b0[0]), a0[1] * sigm_f(b0[1])); w.y = cvt_pk_bf16(a0[2] * sigm_f(b0[2]), a0[3] * sigm_f(b0[3]));
                    w.z = cvt_pk_bf16(a1[0] * sigm_f(b1[0]), a1[1] * sigm_f(b1[1])); w.w = cvt_pk_bf16(a1[2] * sigm_f(b1[2]), a1[3] * sigm_f(b1[3]));
                    *(u32x4*)rowp = w;
                }
        }
    }
};

__device__ __forceinline__ void prep_mod_item(const Params& P, LAS unsigned char* lds, int it) {
    const int tid = tid_fresh();
    LAS float* cc = (LAS float*)lds;
    for (int i = tid; i < 33 * 1024; i += 512) { const int r = i >> 10, k = i & 1023; const float v = (r < 32) ? P.c[r * 1024 + k] : P.c_ctx[k]; cc[i] = silu_f(v); }
    __syncthreads();
    const int n0 = it * 64, col = tid & 63, kk = tid >> 6;
    float acc[33];
#pragma unroll
    for (int r = 0; r < 33; ++r) acc[r] = 0.f;
    const float* wp = P.w_mod + (size_t)(kk * 128) * 9216 + n0 + col;
    for (int k4 = 0; k4 < 32; ++k4) {
        const float w0 = wp[(size_t)(k4 * 4 + 0) * 9216], w1 = wp[(size_t)(k4 * 4 + 1) * 9216], w2 = wp[(size_t)(k4 * 4 + 2) * 9216], w3 = wp[(size_t)(k4 * 4 + 3) * 9216];
#pragma unroll
        for (int r = 0; r < 33; ++r) { const f32x4 c4 = *(const LAS f32x4*)(cc + r * 1024 + kk * 128 + k4 * 4); acc[r] += c4[0] * w0 + c4[1] * w1 + c4[2] * w2 + c4[3] * w3; }
    }
    __syncthreads();
    LAS float* red = (LAS float*)lds;
#pragma unroll
    for (int r = 0; r < 33; ++r) red[(kk * 33 + r) * 64 + col] = acc[r];
    __syncthreads();
    float* MOD = (float*)(P.ws + OFF_MOD);
    for (int o = tid; o < 33 * 64; o += 512) { const int r = o >> 6, cl = o & 63; float s = 0.f;
#pragma unroll
        for (int q = 0; q < 8; ++q) s += red[(q * 33 + r) * 64 + cl];
        MOD[(size_t)r * 9216 + n0 + cl] = s + P.b_mod[n0 + cl]; }
    __syncthreads();
}

__device__ __forceinline__ void prep_tile(const Params& P, LAS unsigned char* lds, int t) {
    const int tid = tid_fresh();
    const float* src; int sld, scol0, nvalid = 64, kt, n0, dld; u16* dst;
    if (t < 2816) {
        const int f = t >= 1408; const int tt = t - f * 1408; const int nt = tt >> 4; kt = tt & 15; n0 = nt * 64;
        const int j = n0 >> 8, s0 = n0 & 255;
        src = (s0 < 128) ? (f ? P.g2 : P.g1) : (f ? P.u2 : P.u1); scol0 = 128 * j + (s0 & 127); sld = DFF;
        dst = (u16*)(P.ws + (f ? OFF_WGU2 : OFF_WGU1)); dld = 1024;
    } else if (t < 2816 + 1408) {
        const int t2 = t - 2816; const int f = t2 >= 704; const int tt = t2 - f * 704; const int nt = tt / 44; kt = tt % 44; n0 = nt * 64;
        src = f ? P.d2 : P.d1; scol0 = n0; sld = 1024; dst = (u16*)(P.ws + (f ? OFF_WD2 : OFF_WD1)); dld = DFF;
    } else if (t < 2816 + 1408 + 1216) {
        const int tt = t - 4224; const int nt = tt >> 4; kt = tt & 15; n0 = nt * 64;
        const int pn = n0 >> 8, s0 = n0 & 255;
        if (pn < 4) scol0 = 1024 + n0; else if (pn == 4) scol0 = 2048 + s0; else if (pn == 5) { scol0 = 2560 + (s0 ? 0 : 0); nvalid = s0 ? 0 : 32; }
        else if (pn == 6) scol0 = 2304 + s0; else if (pn <= 10) scol0 = n0 - 1792;
        else { const int j = pn - 11; scol0 = (s0 < 128) ? (2592 + 128 * j + s0) : (2592 + 1024 + 128 * j + (s0 - 128)); }
        src = P.w_in; sld = 4640; dst = (u16*)(P.ws + OFF_WIN); dld = 1024;
    } else {
        const int tt = t - 5440; const int nt = tt >> 5; kt = tt & 31; n0 = nt * 64;
        src = P.w_out; scol0 = n0; sld = 1024; dst = (u16*)(P.ws + OFF_WOUT); dld = 2048;
    }
    LAS float* tile = (LAS float*)lds;
#pragma unroll
    for (int e = 0; e < 8; ++e) { const int idx = tid + 512 * e, kk = idx >> 6, nn = idx & 63;
        tile[kk * 65 + nn] = (nn < nvalid) ? src[(size_t)(kt * 64 + kk) * sld + scol0 + nn] : 0.f; }
    __syncthreads();
    { const int nn = tid >> 3, ks = (tid & 7) * 8; u32x4 w;
      w.x = cvt_pk_bf16(tile[(ks + 0) * 65 + nn], tile[(ks + 1) * 65 + nn]); w.y = cvt_pk_bf16(tile[(ks + 2) * 65 + nn], tile[(ks + 3) * 65 + nn]);
      w.z = cvt_pk_bf16(tile[(ks + 4) * 65 + nn], tile[(ks + 5) * 65 + nn]); w.w = cvt_pk_bf16(tile[(ks + 6) * 65 + nn], tile[(ks + 7) * 65 + nn]);
      *(u32x4*)(dst + (size_t)(n0 + nn) * dld + kt * 64 + ks) = w; }
    __syncthreads();
}

__device__ __forceinline__ void phase_prep(const Params& P, LAS unsigned char* lds) {
    constexpr int NMOD = 144, NTILE = 2816 + 1408 + 1216 + 512;
    for (int it = blockIdx.x; it < NMOD + NTILE; it += gridDim.x) { if (it < NMOD) prep_mod_item(P, lds, it); else prep_tile(P, lds, it - NMOD); }
}

template <int MODE>
__device__ __forceinline__ void phase_norm(const Params& P, const float* srcX, const float* srcC, int nrows, const float* nw, int shIdx, int scIdx, u16* H, float* outF) {
    constexpr int NR = 4;
    const int lane = tid_fresh() & 63, gw = blockIdx.x * 8 + (tid_fresh() >> 6), nwv = gridDim.x * 8;
    const float* MOD = (const float*)(P.ws + OFF_MOD);
    f32x4 w[4];
#pragma unroll
    for (int i = 0; i < 4; ++i) w[i] = *(const f32x4*)(nw + i * 256 + lane * 4);
    for (int row0 = gw * NR; row0 < nrows; row0 += nwv * NR) {
        f32x4 v[NR][4];
        const float* src0 = (row0 < TX) ? srcX + (size_t)row0 * 1024 : srcC + (size_t)(row0 - TX) * 1024;
#pragma unroll
        for (int q = 0; q < NR; ++q) {
#pragma unroll
            for (int i = 0; i < 4; ++i) v[q][i] = *(const f32x4*)(src0 + q * 1024 + i * 256 + lane * 4); }
        const int b = (row0 < TX) ? (row0 >> 11) : 32;
        float rstd[NR];
#pragma unroll
        for (int q = 0; q < NR; ++q) { float ss = 0.f;
#pragma unroll
            for (int i = 0; i < 4; ++i) ss += v[q][i][0] * v[q][i][0] + v[q][i][1] * v[q][i][1] + v[q][i][2] * v[q][i][2] + v[q][i][3] * v[q][i][3];
            rstd[q] = rsqrtf(wave_sum(ss) * (1.0f / 1024.0f) + EPSF); }
#pragma unroll
        for (int i = 0; i < 4; ++i) { const int col = i * 256 + lane * 4;
            if (MODE == 0) {
                const f32x4 sh = *(const f32x4*)(MOD + (size_t)b * 9216 + shIdx * 1024 + col), sc = *(const f32x4*)(MOD + (size_t)b * 9216 + scIdx * 1024 + col);
                const f32x4 ws = w[i] * (sc + 1.0f);
#pragma unroll
                for (int q = 0; q < NR; ++q) { const f32x4 o = v[q][i] * rstd[q] * ws + sh;
                    uint2 pk; pk.x = cvt_pk_bf16(o[0], o[1]); pk.y = cvt_pk_bf16(o[2], o[3]);
                    *(uint2*)(H + (size_t)(row0 + q) * 1024 + col) = pk; }
            } else {
#pragma unroll
                for (int q = 0; q < NR; ++q) *(f32x4*)(outF + (size_t)(row0 + q) * 1024 + col) = v[q][i] * rstd[q] * w[i];
            } }
    }
}

template <int NC>
__device__ __forceinline__ void stage_conv(LAS u16* dst, int ld, const u16* XBC, int row0, int seq0, int seq1, int col0, const float* cw, const float* cb) {
    constexpr int NP = NC / 2, NTG = 512 / NP, TPG = 128 / NTG;
    const int tid = tid_fresh(), cp = tid % NP, tg = tid / NP, ch = col0 + 2 * cp, l0 = tg * TPG;
    float w0[5], w1[5];
#pragma unroll
    for (int k = 0; k < 5; ++k) { w0[k] = cw[k * 1536 + ch]; w1[k] = cw[k * 1536 + ch + 1]; }
    const float b0 = cb[ch], b1 = cb[ch + 1];
    u32 win[5] = {0u, 0u, 0u, 0u, 0u};
    u32 ldv[TPG + 4];
#pragma unroll
    for (int i = 0; i < TPG + 4; ++i) { const int r = row0 + l0 - 2 + i; const int rc = min(max(r, seq0), seq1 - 1); ldv[i] = *(const u32*)(XBC + (size_t)rc * 1536 + ch); }
#pragma unroll
    for (int i = 0; i < TPG + 4; ++i) {
        const int r = row0 + l0 - 2 + i;
        const u32 v = (r >= seq0 && r < seq1) ? ldv[i] : 0u;
        win[0] = win[1]; win[1] = win[2]; win[2] = win[3]; win[3] = win[4]; win[4] = v;
        if (i >= 4) {
            float a0 = b0, a1 = b1;
#pragma unroll
            for (int k = 0; k < 5; ++k) { a0 += w0[k] * lo_f(win[k]); a1 += w1[k] * hi_f(win[k]); }
            *(LAS u32*)(dst + (l0 + i - 4) * ld + 2 * cp) = cvt_pk_bf16(silu_f(a0), silu_f(a1));
        }
    }
}

__device__ __forceinline__ void dtprep_item(const Params& P, LAS unsigned char* lds, int tc) {
    const int tid = tid_fresh(), dh = tid & 31, seg = tid >> 5, dir = dh >> 4, h = dh & 15;
    const bool isx = tc < 512; const int b = isx ? (tc >> 4) : ((tc - 512) >> 1); const int cidx = isx ? (tc & 15) : ((tc - 512) & 1);
    const int row0 = tc * 128;
    const int jscan = isx ? (dir ? 17 - cidx : cidx + 2) : (dir ? 1 - cidx : cidx);
    const float bias = dir ? P.dtbb[h] : P.dtbf[h]; const float a = -__expf(dir ? P.alb[h] : P.alf[h]);
    const float* DT = (const float*)(P.ws + OFF_DT);
    float dt[8], cs[8];
#pragma unroll
    for (int i = 0; i < 8; ++i) { const float raw = DT[(size_t)(row0 + seg * 8 + i) * 32 + dh] + bias; dt[i] = (raw > 20.f) ? raw : log1pf(__expf(raw)); }
    float run = 0.f;
    if (dir == 0) {
#pragma unroll
        for (int i = 0; i < 8; ++i) { run += dt[i] * a; cs[i] = run; }
    } else {
#pragma unroll
        for (int i = 7; i >= 0; --i) { run += dt[i] * a; cs[i] = run; }
    }
    LAS float* segsum = (LAS float*)lds;
    segsum[seg * 32 + dh] = run;
    __syncthreads();
    float off = 0.f, tot = 0.f;
#pragma unroll
    for (int s2 = 0; s2 < 16; ++s2) { const float v = segsum[s2 * 32 + dh]; tot += v; if (dir == 0 ? (s2 < seg) : (s2 > seg)) off += v; }
    float* DTO = (float*)(P.ws + (dir ? OFF_DTB : OFF_DTF)); float* CSO = (float*)(P.ws + (dir ? OFF_CSB : OFF_CSF));
#pragma unroll
    for (int i = 0; i < 8; ++i) { const size_t o = (size_t)(row0 + seg * 8 + i) * 16 + h; DTO[o] = dt[i]; CSO[o] = cs[i] + off; }
    if (seg == 0) ((float*)(P.ws + OFF_CDEC))[((b * 2 + dir) * 18 + jscan) * 16 + h] = __expf(tot);
    __syncthreads();
}

__device__ __forceinline__ void uconv_item(const Params& P, LAS unsigned char* lds, int item) {
    const int tid = tid_fresh(); const bool isH = item < 1024; const int e = item & 1023, b = e >> 5, q = e & 31;
    LAS u32* in = (LAS u32*)lds;
    const u16* Ug = (const u16*)(P.ws + OFF_U); u16* Yg = (u16*)(P.ws + OFF_Y);
    const int choff = isH ? 0 : 512;
#pragma unroll
    for (int i = 0; i < 8; ++i) { const int idx = tid + 512 * i, tok = idx >> 6, c16 = idx & 63; int grow, lrow;
        if (isH) { grow = b * 2048 + q * 64 + tok; lrow = 15 + tok; } else { const int line = tok >> 5, rr = tok & 31; grow = b * 2048 + rr * 64 + 2 * q + line; lrow = line * 62 + 15 + rr; }
        *(LAS u32x4*)(in + lrow * 256 + c16 * 4) = *(const u32x4*)(Ug + (size_t)grow * 1024 + choff + c16 * 8); }
    { const int npad = isH ? 30 : 60;
      for (int idx = tid; idx < npad * 64; idx += 512) { const int pr = idx >> 6, c16 = idx & 63; int lrow;
          if (isH) lrow = (pr < 15) ? pr : 64 + pr; else { const int line = pr / 30, k = pr % 30; lrow = line * 62 + ((k < 15) ? k : 32 + k); }
          *(LAS u32x4*)(in + lrow * 256 + c16 * 4) = (u32x4){0u, 0u, 0u, 0u}; } }
    __syncthreads();
    const int cp = tid & 255, half = tid >> 8, ch = choff + 2 * cp;
    float w0[31], w1[31];
#pragma unroll
    for (int k = 0; k < 31; ++k) { w0[k] = P.ccw[k * 1024 + ch]; w1[k] = P.ccw[k * 1024 + ch + 1]; }
    const float b0 = P.ccb[ch], b1 = P.ccb[ch + 1];
    const int base_row = isH ? 32 * half : 62 * half;
    for (int oo = 0; oo < 32; ++oo) {
        float a0 = b0, a1 = b1;
        const LAS u32* pr = in + (base_row + oo) * 256 + cp;
#pragma unroll
        for (int k = 0; k < 31; ++k) { const u32 v = pr[k * 256]; a0 += w0[k] * lo_f(v); a1 += w1[k] * hi_f(v); }
        const int grow = isH ? (b * 2048 + q * 64 + 32 * half + oo) : (b * 2048 + oo * 64 + 2 * q + half);
        *(u32*)(Yg + (size_t)grow * 2048 + 1024 + ch) = cvt_pk_bf16(a0, a1);
    }
    __syncthreads();
}

__device__ __forceinline__ void phase_p6(const Params& P, LAS unsigned char* lds) {
    for (int it = blockIdx.x; it < 576 + 2048; it += gridDim.x) { if (it < 576) dtprep_item(P, lds, it); else uconv_item(P, lds, it - 576); }
}

__device__ __forceinline__ bf16x8 gather8(const LAS u16* p, int stride) {
    bf16x8 r;
#pragma unroll
    for (int j = 0; j < 8; ++j) r[j] = (short)p[j * stride];
    return r;
}
#define MFMA32(a, b, c) __builtin_amdgcn_mfma_f32_32x32x16_bf16((a), (b), (c), 0, 0, 0)

__device__ __forceinline__ void s1_item(const Params& P, LAS unsigned char* lds, int item) {
    const int tid = tid_fresh(), w = tid >> 6, lane = tid & 63, r = lane & 31, hf = lane >> 5;
    const int g = item & 1, tc = (item >> 1) % 18, b = item / 36;
    const bool isx = tc < 16;
    const int seq0 = isx ? b * 2048 : TX + b * 256, seq1 = seq0 + (isx ? 2048 : 256), row0 = seq0 + 128 * (isx ? tc : tc - 16);
    const int jf = isx ? tc + 2 : tc - 16, jb = isx ? 17 - tc : 17 - tc;
    LAS u16* Bs = (LAS u16*)lds;
    LAS u16* Xs = (LAS u16*)(lds + 34816);
    LAS float* wfb = (LAS float*)(lds + 34816 + 18432);
    const u16* XBC = (const u16*)(P.ws + OFF_XBC);
    const float *CSF = (const float*)(P.ws + OFF_CSF), *CSB = (const float*)(P.ws + OFF_CSB), *DTF = (const float*)(P.ws + OFF_DTF), *DTB = (const float*)(P.ws + OFF_DTB);
    u16* ST = (u16*)(P.ws + OFF_ST);
    stage_conv<128>(Bs, 136, XBC, row0, seq0, seq1, 1024 + 128 * g, P.scw, P.scb);
    __syncthreads();
    const int pb = w >> 2, nb = w & 3;
    bf16x8 Bf[8];
#pragma unroll
    for (int ks = 0; ks < 8; ++ks) Bf[ks] = gather8(Bs + (16 * ks + 8 * hf) * 136 + 32 * nb + r, 136);
    for (int hh = 0; hh < 8; ++hh) {
        const int h = 8 * g + hh;
        stage_conv<64>(Xs, 72, XBC, row0, seq0, seq1, 64 * h, P.scw, P.scb);
        if (tid < 256) { const int l = tid & 127;
            if (tid < 128) wfb[l] = __expf(CSF[(size_t)(row0 + 127) * 16 + h] - CSF[(size_t)(row0 + l) * 16 + h]) * DTF[(size_t)(row0 + l) * 16 + h];
            else wfb[128 + l] = __expf(CSB[(size_t)row0 * 16 + h] - CSB[(size_t)(row0 + l) * 16 + h]) * DTB[(size_t)(row0 + l) * 16 + h]; }
        __syncthreads();
        f32x16 accf, accb;
#pragma unroll
        for (int i = 0; i < 16; ++i) { accf[i] = 0.f; accb[i] = 0.f; }
#pragma unroll
        for (int ks = 0; ks < 8; ++ks) {
            const int lb = 16 * ks + 8 * hf;
            float xv[8];
#pragma unroll
            for (int j = 0; j < 8; ++j) xv[j] = bf2f(Xs[(lb + j) * 72 + 32 * pb + r]);
            bf16x8 af, ab;
            u32 t;
#pragma unroll
            for (int j = 0; j < 8; j += 2) {
                t = cvt_pk_bf16(xv[j] * wfb[lb + j], xv[j + 1] * wfb[lb + j + 1]); af[j] = (short)(t & 0xffffu); af[j + 1] = (short)(t >> 16);
                t = cvt_pk_bf16(xv[j] * wfb[128 + lb + j], xv[j + 1] * wfb[128 + lb + j + 1]); ab[j] = (short)(t & 0xffffu); ab[j + 1] = (short)(t >> 16);
            }
            accf = MFMA32(af, Bf[ks], accf); accb = MFMA32(ab, Bf[ks], accb);
        }
        const int n = 32 * nb + r;
        if (jf <= 16) { u16* sp = ST + ((size_t)((b * 2 + 0) * 17 + jf) * 16 + h) * 8192;
#pragma unroll
            for (int i = 0; i < 16; ++i) { const int p = 32 * pb + (i & 3) + 8 * (i >> 2) + 4 * hf; sp[p * 128 + n] = f2bf(accf[i]); } }
        if (jb <= 16) { u16* sp = ST + ((size_t)((b * 2 + 1) * 17 + jb) * 16 + h) * 8192;
#pragma unroll
            for (int i = 0; i < 16; ++i) { const int p = 32 * pb + (i & 3) + 8 * (i >> 2) + 4 * hf; sp[p * 128 + n] = f2bf(accb[i]); } }
        __syncthreads();
    }
}

__device__ __forceinline__ void phase_s2(const Params& P) {
    u16* ST = (u16*)(P.ws + OFF_ST); const float* CDEC = (const float*)(P.ws + OFF_CDEC);
    const int nth = gridDim.x * 512;
    for (int v = blockIdx.x * 512 + tid_fresh(); v < 32 * 2 * 16 * 1024; v += nth) {
        const int pn = (v & 1023) * 8, h = (v >> 10) & 15, bd = v >> 14;
        float hs[8];
#pragma unroll
        for (int j = 0; j < 8; ++j) hs[j] = 0.f;
        u16* base = ST + ((size_t)(bd * 17) * 16 + h) * 8192 + pn;
        u32x4 q[17]; float dec[17];
#pragma unroll
        for (int s = 0; s < 17; ++s) { q[s] = *(const u32x4*)(base + (size_t)s * 16 * 8192); dec[s] = CDEC[(bd * 18 + s) * 16 + h]; }
#pragma unroll
        for (int s = 0; s < 17; ++s) {
            const float d = dec[s];
            hs[0] = hs[0] * d + lo_f(q[s].x); hs[1] = hs[1] * d + hi_f(q[s].x); hs[2] = hs[2] * d + lo_f(q[s].y); hs[3] = hs[3] * d + hi_f(q[s].y);
            hs[4] = hs[4] * d + lo_f(q[s].z); hs[5] = hs[5] * d + hi_f(q[s].z); hs[6] = hs[6] * d + lo_f(q[s].w); hs[7] = hs[7] * d + hi_f(q[s].w);
            u32x4 o; o.x = cvt_pk_bf16(hs[0], hs[1]); o.y = cvt_pk_bf16(hs[2], hs[3]); o.z = cvt_pk_bf16(hs[4], hs[5]); o.w = cvt_pk_bf16(hs[6], hs[7]);
            *(u32x4*)(base + (size_t)s * 16 * 8192) = o;
        }
    }
}

__device__ __forceinline__ void s3_item(const Params& P, LAS unsigned char* lds, int item) {
    const int tid = tid_fresh(), w = tid >> 6, lane = tid & 63, r = lane & 31, hf = lane >> 5;
    const int g = item & 1, c = (item >> 1) & 15, b = item >> 5;
    const int seq0 = b * 2048, seq1 = seq0 + 2048, row0 = seq0 + 128 * c;
    LAS u16* Cs = (LAS u16*)lds;
    LAS u16* Ms = (LAS u16*)(lds + 34816);
    LAS u16* Gs = (LAS u16*)(lds + 69632);
    LAS u16* Xs = (LAS u16*)(lds + 104448);
    LAS u16* Hf = (LAS u16*)(lds + 122880);
    LAS u16* Hb = (LAS u16*)(lds + 140288);
    LAS float* ar = (LAS float*)(lds + 157696);
    LAS float* ssq = (LAS float*)(lds + 159744);
    const u16* XBC = (const u16*)(P.ws + OFF_XBC); const u16* ST = (const u16*)(P.ws + OFF_ST); u16* Yg = (u16*)(P.ws + OFF_Y);
    const float *CSF = (const float*)(P.ws + OFF_CSF), *CSB = (const float*)(P.ws + OFF_CSB), *DTF = (const float*)(P.ws + OFF_DTF), *DTB = (const float*)(P.ws + OFF_DTB);
    stage_conv<128>(Cs, 136, XBC, row0, seq0, seq1, 1280 + 128 * g, P.scw, P.scb);
    stage_conv<128>(Ms, 136, XBC, row0, seq0, seq1, 1024 + 128 * g, P.scw, P.scb);
    if (tid < 128) ssq[tid] = 0.f;
    __syncthreads();
    {
        const int wr2 = w >> 1, wc2 = w & 1;
        f32x16 g0, g1;
#pragma unroll
        for (int i = 0; i < 16; ++i) { g0[i] = 0.f; g1[i] = 0.f; }
#pragma unroll
        for (int ks = 0; ks < 8; ++ks) {
            const bf16x8 a = *(const LAS bf16x8*)(Cs + (32 * wr2 + r) * 136 + 16 * ks + 8 * hf);
            const bf16x8 b0 = *(const LAS bf16x8*)(Ms + (64 * wc2 + r) * 136 + 16 * ks + 8 * hf);
            const bf16x8 b1 = *(const LAS bf16x8*)(Ms + (64 * wc2 + 32 + r) * 136 + 16 * ks + 8 * hf);
            g0 = MFMA32(a, b0, g0); g1 = MFMA32(a, b1, g1);
        }
#pragma unroll
        for (int i = 0; i < 16; ++i) { const int l = 32 * wr2 + (i & 3) + 8 * (i >> 2) + 4 * hf;
            Gs[l * 136 + 64 * wc2 + r] = f2bf(g0[i]); Gs[l * 136 + 64 * wc2 + 32 + r] = f2bf(g1[i]); }
    }
    const int rb = w >> 1, cb2 = w & 1;
    for (int hh = 0; hh < 8; ++hh) {
        const int h = 8 * g + hh;
        __syncthreads();
        stage_conv<64>(Xs, 72, XBC, row0, seq0, seq1, 64 * h, P.scw, P.scb);
        { const u16* stf = ST + ((size_t)((b * 2 + 0) * 17 + (c + 1)) * 16 + h) * 8192; const u16* stb = ST + ((size_t)((b * 2 + 1) * 17 + (16 - c)) * 16 + h) * 8192;
#pragma unroll
          for (int i = 0; i < 4; ++i) { const int idx = tid + 512 * i, mat = idx >> 10, chk = idx & 1023, p = chk >> 4, n8 = (chk & 15) * 8;
              *(LAS u32x4*)((mat ? Hb : Hf) + p * 136 + n8) = *(const u32x4*)((mat ? stb : stf) + p * 128 + n8); } }
        { const int which = tid >> 7, l = tid & 127; const float* srcp = (which == 0) ? CSF : (which == 1) ? CSB : (which == 2) ? DTF : DTB; ar[which * 128 + l] = srcp[(size_t)(row0 + l) * 16 + h]; }
        __syncthreads();
        {
            const int l = tid >> 2, s0 = (tid & 3) * 32; const float csf_l = ar[l], csb_l = ar[128 + l], dg = ar[256 + l] + ar[384 + l], dsk = P.ssm_d[h];
#pragma unroll
            for (int s8 = 0; s8 < 4; ++s8) { const int s = s0 + 8 * s8; const bf16x8 gv = *(const LAS bf16x8*)(Gs + l * 136 + s); float o[8];
#pragma unroll
                for (int j = 0; j < 8; ++j) { const int ss = s + j; float f;
                    if (ss < l) f = __expf(csf_l - ar[ss]) * ar[256 + ss]; else if (ss > l) f = __expf(csb_l - ar[128 + ss]) * ar[384 + ss]; else f = dg;
                    o[j] = bf2f((u16)gv[j]) * f + ((ss == l) ? dsk : 0.f); }
                u32x4 q; q.x = cvt_pk_bf16(o[0], o[1]); q.y = cvt_pk_bf16(o[2], o[3]); q.z = cvt_pk_bf16(o[4], o[5]); q.w = cvt_pk_bf16(o[6], o[7]);
                *(LAS u32x4*)(Ms + l * 136 + s) = q; }
        }
        __syncthreads();
        f32x16 ad, af, ab;
#pragma unroll
        for (int i = 0; i < 16; ++i) { ad[i] = 0.f; af[i] = 0.f; ab[i] = 0.f; }
#pragma unroll
        for (int ks = 0; ks < 8; ++ks) {
            const int ko = 16 * ks + 8 * hf;
            const bf16x8 am = *(const LAS bf16x8*)(Ms + (32 * rb + r) * 136 + ko);
            const bf16x8 bx = gather8(Xs + ko * 72 + 32 * cb2 + r, 72);
            ad = MFMA32(am, bx, ad);
            const bf16x8 ac = *(const LAS bf16x8*)(Cs + (32 * rb + r) * 136 + ko);
            const bf16x8 bhf = *(const LAS bf16x8*)(Hf + (32 * cb2 + r) * 136 + ko);
            const bf16x8 bhb = *(const LAS bf16x8*)(Hb + (32 * cb2 + r) * 136 + ko);
            af = MFMA32(ac, bhf, af); ab = MFMA32(ac, bhb, ab);
            if (ks & 1) __builtin_amdgcn_sched_barrier(0);
        }
        u16 zr[16];
#pragma unroll
        for (int i = 0; i < 16; ++i) zr[i] = Yg[(size_t)(row0 + 32 * rb + (i & 3) + 8 * (i >> 2) + 4 * hf) * 2048 + 64 * h + 32 * cb2 + r];
#pragma unroll
        for (int i = 0; i < 16; ++i) { const int l = 32 * rb + (i & 3) + 8 * (i >> 2) + 4 * hf;
            const float y = ad[i] + __expf(ar[l]) * af[i] + __expf(ar[128 + l]) * ab[i];
            u16* zp = Yg + (size_t)(row0 + l) * 2048 + 64 * h + 32 * cb2 + r;
            const float v = y * silu_f(bf2f(zr[i])); *zp = f2bf(v);
            float sv = v * v;
#pragma unroll
            for (int o = 16; o >= 1; o >>= 1) sv += __shfl_xor(sv, o);
            if (r == 0) atomicAdd((float*)(ssq + l), sv); }
    }
    __syncthreads();
    {
        const int c8 = (tid & 63) * 8;
        const f32x4 w0 = *(const f32x4*)(P.ssm_nw + 512 * g + c8), w1 = *(const f32x4*)(P.ssm_nw + 512 * g + c8 + 4);
        u16* ybase = Yg + (size_t)(row0 + (tid >> 6)) * 2048 + 512 * g + c8;
#pragma unroll
        for (int hb = 0; hb < 2; ++hb) {
            u32x4 qv[8];
#pragma unroll
            for (int i = 0; i < 8; ++i) qv[i] = *(const u32x4*)(ybase + (size_t)(hb * 8 + i) * 8 * 2048);
#pragma unroll
            for (int i = 0; i < 8; ++i) { const int l = (tid >> 6) + 8 * (hb * 8 + i);
                const float rstd = rsqrtf(ssq[l] * (1.0f / 512.0f) + EPSF); const u32x4 q = qv[i];
                u32x4 o; o.x = cvt_pk_bf16(lo_f(q.x) * rstd * w0[0], hi_f(q.x) * rstd * w0[1]); o.y = cvt_pk_bf16(lo_f(q.y) * rstd * w0[2], hi_f(q.y) * rstd * w0[3]);
                o.z = cvt_pk_bf16(lo_f(q.z) * rstd * w1[0], hi_f(q.z) * rstd * w1[1]); o.w = cvt_pk_bf16(lo_f(q.w) * rstd * w1[2], hi_f(q.w) * rstd * w1[3]);
                *(u32x4*)(ybase + (size_t)(hb * 8 + i) * 8 * 2048) = o; }
        }
    }
    __syncthreads();
}

__device__ __forceinline__ void phase_lnb(const Params& P) {
    const int lane = tid_fresh() & 63, gw = blockIdx.x * 8 + (tid_fresh() >> 6), nwv = gridDim.x * 8;
    u16* Yg = (u16*)(P.ws + OFF_Y);
    for (int row = gw; row < TX; row += nwv) {
        u16* p = Yg + (size_t)row * 2048 + 1024 + lane * 8;
        const u32x4 q0 = *(const u32x4*)p, q1 = *(const u32x4*)(p + 512);
        float v[16] = {lo_f(q0.x), hi_f(q0.x), lo_f(q0.y), hi_f(q0.y), lo_f(q0.z), hi_f(q0.z), lo_f(q0.w), hi_f(q0.w), lo_f(q1.x), hi_f(q1.x), lo_f(q1.y), hi_f(q1.y), lo_f(q1.z), hi_f(q1.z), lo_f(q1.w), hi_f(q1.w)};
        float s = 0.f;
#pragma unroll
        for (int j = 0; j < 16; ++j) s += v[j];
        const float mu = wave_sum(s) * (1.0f / 1024.0f);
        float q = 0.f;
#pragma unroll
        for (int j = 0; j < 16; ++j) { v[j] -= mu; q += v[j] * v[j]; }
        const float rstd = rsqrtf(wave_sum(q) * (1.0f / 1024.0f) + EPSF);
        float o[16];
#pragma unroll
        for (int j = 0; j < 16; ++j) { const int col = (j < 8) ? (lane * 8 + j) : (512 + lane * 8 + j - 8); o[j] = silu_f(v[j] * rstd * P.lnw[col] + P.lnb[col]); }
        u32x4 a, bq; a.x = cvt_pk_bf16(o[0], o[1]); a.y = cvt_pk_bf16(o[2], o[3]); a.z = cvt_pk_bf16(o[4], o[5]); a.w = cvt_pk_bf16(o[6], o[7]);
        bq.x = cvt_pk_bf16(o[8], o[9]); bq.y = cvt_pk_bf16(o[10], o[11]); bq.z = cvt_pk_bf16(o[12], o[13]); bq.w = cvt_pk_bf16(o[14], o[15]);
        *(u32x4*)p = a; *(u32x4*)(p + 512) = bq;
    }
}

template <int PH> __device__ __forceinline__ void run_phase(const Params& P, LAS unsigned char* lds) {
    unsigned char* ws = P.ws;
    const float* MOD = (const float*)(ws + OFF_MOD);
    if constexpr (PH == 0) phase_prep(P, lds);
    if constexpr (PH == 1) phase_norm<0>(P, P.x, P.ctx, TT, P.norm_ffn1, 0, 1, (u16*)(ws + OFF_H), nullptr);
    if constexpr (PH == 2) { Gemm gm{(const bf16_t*)(ws + OFF_H), (const bf16_t*)(ws + OFF_WGU1), TT, NGU, 1024}; StaticOrder S; S.init(TT, NGU, (int)gridDim.x, (int)blockIdx.x);
        EpiSwiGLU E{(bf16_t*)(ws + OFF_ACT)}; gemm_phase<EpiSwiGLU, StaticOrder, false>(lds, gm, S, E, nullptr); }
    if constexpr (PH == 3) { Gemm gm{(const bf16_t*)(ws + OFF_ACT), (const bf16_t*)(ws + OFF_WD1), TT, 1024, DFF}; StaticOrder S; S.init(TT, 1024, (int)gridDim.x, (int)blockIdx.x);
        EpiResid E{P.x, P.out, P.ctx, (float*)(ws + OFF_XC1), MOD + 2 * 1024, 0.5f}; gemm_phase<EpiResid, StaticOrder, false>(lds, gm, S, E, nullptr); }
    if constexpr (PH == 4) phase_norm<0>(P, P.out, (const float*)(ws + OFF_XC1), TT, P.norm_mix, 3, 4, (u16*)(ws + OFF_H), nullptr);
    if constexpr (PH == 5) { Gemm gm{(const bf16_t*)(ws + OFF_H), (const bf16_t*)(ws + OFF_WIN), TX, NIN, 1024}; InOrder S; S.init(TX, NIN, (int)gridDim.x, (int)blockIdx.x);
        EpiInProj E{(bf16_t*)(ws + OFF_XBC), (float*)(ws + OFF_DT), (bf16_t*)(ws + OFF_Y), (bf16_t*)(ws + OFF_U)}; gemm_phase<EpiInProj, InOrder, false>(lds, gm, S, E, nullptr); }
    if constexpr (PH == 6) phase_p6(P, lds);
    if constexpr (PH == 7) { for (int it = blockIdx.x; it < 1152; it += gridDim.x) s1_item(P, lds, it); }
    if constexpr (PH == 8) phase_s2(P);
    if constexpr (PH == 9) { for (int it = blockIdx.x; it < 1024; it += gridDim.x) s3_item(P, lds, it); phase_lnb(P); }
    if constexpr (PH == 10) { Gemm gm{(const bf16_t*)(ws + OFF_Y), (const bf16_t*)(ws + OFF_WOUT), TX, 1024, 2048}; StaticOrder S; S.init(TX, 1024, (int)gridDim.x, (int)blockIdx.x);
        EpiResid E{P.out, P.out, nullptr, nullptr, MOD + 5 * 1024, 1.0f}; gemm_phase<EpiResid, StaticOrder, false>(lds, gm, S, E, nullptr); }
    if constexpr (PH == 11) phase_norm<0>(P, P.out, nullptr, TX, P.norm_ffn2, 6, 7, (u16*)(ws + OFF_H), nullptr);
    if constexpr (PH == 12) { Gemm gm{(const bf16_t*)(ws + OFF_H), (const bf16_t*)(ws + OFF_WGU2), TX, NGU, 1024}; StaticOrder S; S.init(TX, NGU, (int)gridDim.x, (int)blockIdx.x);
        EpiSwiGLU E{(bf16_t*)(ws + OFF_ACT)}; gemm_phase<EpiSwiGLU, StaticOrder, false>(lds, gm, S, E, nullptr); }
    if constexpr (PH == 13) { Gemm gm{(const bf16_t*)(ws + OFF_ACT), (const bf16_t*)(ws + OFF_WD2), TX, 1024, DFF}; StaticOrder S; S.init(TX, 1024, (int)gridDim.x, (int)blockIdx.x);
        EpiResid E{P.out, P.out, nullptr, nullptr, MOD + 8 * 1024, 0.5f}; gemm_phase<EpiResid, StaticOrder, false>(lds, gm, S, E, nullptr); }
    if constexpr (PH == 14) phase_norm<1>(P, P.out, nullptr, TX, P.fnorm, 0, 0, nullptr, P.out);
}

template <int PH> __global__ void __launch_bounds__(512, 2) k_one(Params P) {
    extern __shared__ __attribute__((aligned(16))) unsigned char shm[];
    run_phase<PH>(P, (LAS unsigned char*)shm);
}

__device__ __forceinline__ void grid_bar(unsigned* ctr, unsigned target) {
    __syncthreads();
    if (tid_fresh() == 0) {
        __builtin_amdgcn_fence(__ATOMIC_RELEASE, "agent");
        __hip_atomic_fetch_add(ctr, 1u, __ATOMIC_RELAXED, __HIP_MEMORY_SCOPE_AGENT);
        unsigned v;
        do { __builtin_amdgcn_s_sleep(1); v = __hip_atomic_load(ctr, __ATOMIC_RELAXED, __HIP_MEMORY_SCOPE_AGENT); asm volatile("" : "+v"(v)); } while (v < target);
        __builtin_amdgcn_fence(__ATOMIC_ACQUIRE, "agent");
    }
    __syncthreads();
}
template <int PH> __device__ __forceinline__ void run_all(const Params& P, LAS unsigned char* lds, cg::grid_group& grid) {
    unsigned* ctr = (unsigned*)(P.ws + OFF_BAR);
    if constexpr (PH == 0) { if (blockIdx.x == 0 && threadIdx.x == 0) __hip_atomic_store(ctr, 0u, __ATOMIC_RELAXED, __HIP_MEMORY_SCOPE_AGENT); }
    run_phase<PH>(P, lds);
    if constexpr (PH + 1 < NPHASE) {
        if constexpr (PH == 0) grid.sync(); else grid_bar(ctr, (unsigned)PH * gridDim.x);
        run_all<PH + 1>(P, lds, grid);
    }
}
__global__ void __launch_bounds__(512, 2) mega(Params P) {
    extern __shared__ __attribute__((aligned(16))) unsigned char shm[];
    cg::grid_group grid = cg::this_grid();
    run_all<0>(P, (LAS unsigned char*)shm, grid);
}

template <int PH> static void launch_each(int grid, hipStream_t stream, const Params& p) {
    static bool attr = false; if (!attr) { (void)hipFuncSetAttribute((const void*)k_one<PH>, hipFuncAttributeMaxDynamicSharedMemorySize, LDS_BYTES); attr = true; }
    hipLaunchKernelGGL(k_one<PH>, dim3(grid), dim3(512), LDS_BYTES, stream, p);
    if constexpr (PH + 1 < NPHASE) launch_each<PH + 1>(grid, stream, p);
}

#ifndef MK_MULTI
#define MK_MULTI 0
#endif
extern "C" void kernel_launch(void* const* d_in, const int* in_sizes, int n_in, void* d_out, int out_size, void* d_ws, size_t ws_size, hipStream_t stream) {
    static int grid = 0;
    if (grid == 0) {
        if (n_in != 30 || ws_size < WS_TOTAL) { fprintf(stderr, "kernel_launch: expected 30 inputs and >= %zu bytes of workspace (got %d, %zu)\n", (size_t)WS_TOTAL, n_in, ws_size); grid = -1; return; }
        int dev = 0, cus = 0, per_cu = 0;
        (void)hipGetDevice(&dev); (void)hipDeviceGetAttribute(&cus, hipDeviceAttributeMultiprocessorCount, dev);
        if (hipFuncSetAttribute((const void*)mega, hipFuncAttributeMaxDynamicSharedMemorySize, LDS_BYTES) != hipSuccess) { fprintf(stderr, "kernel_launch: hipFuncSetAttribute failed\n"); }
        if (hipOccupancyMaxActiveBlocksPerMultiprocessor(&per_cu, (const void*)mega, 512, LDS_BYTES) != hipSuccess || per_cu < 1) { fprintf(stderr, "kernel_launch: occupancy query says %d\n", per_cu); per_cu = 1; }
        (void)hipGetLastError();
        grid = cus * per_cu;
    }
    if (grid < 0) return;
    Params p{};
    const float** pp = (const float**)&p;
    for (int i = 0; i < 30; ++i) pp[i] = (const float*)d_in[i];
    p.out = (float*)d_out; p.ws = (unsigned char*)d_ws;
#if MK_MULTI
    launch_each<0>(grid, stream, p);
#else
    void* args[] = {&p};
    hipError_t e = hipLaunchCooperativeKernel((const void*)mega, dim3(grid), dim3(512), args, LDS_BYTES, stream);
    if (e != hipSuccess) fprintf(stderr, "kernel_launch: cooperative launch failed: %s (grid %d)\n", hipGetErrorString(e), grid);
#endif
}
```

```cpp
#include <hip/hip_runtime.h>
#include <hip/hip_cooperative_groups.h>
#include <cstdio>
namespace cg = cooperative_groups;
__device__ __forceinline__ int tid_fresh() { int t = (int)threadIdx.x; asm volatile("" : "+v"(t)); return t; }
namespace pg8 {
#define PG8_LAS __attribute__((address_space(3)))
typedef unsigned short bf16_t;
typedef short bf16x8 __attribute__((ext_vector_type(8)));
typedef float f32x4 __attribute__((ext_vector_type(4)));
typedef unsigned u32x4 __attribute__((ext_vector_type(4)));
constexpr int BM = 256, BK = 64, HALF = 128, HTB = HALF * BK * 2  , STAGE_BYTES = 8 * HTB, NXCD = 8, WGM = 8;

__host__ __device__ __forceinline__ int lds_byte(int r, int c) { const int st = (r >> 4) * 2 + (c >> 5), rr = r & 15, cc = c & 31, ob = rr * 64 + cc * 2; return st * 1024 + (ob ^ (((ob >> 9) & 1) << 5)); }
__host__ __device__ __forceinline__ void stage_rc(int b, int& R, int& C) { const int st = b / 1024, sb = b % 1024, swz = sb ^ (((sb >> 9) & 1) << 5); R = (st >> 1) * 16 + swz / 64; C = (st & 1) * 32 + (swz % 64) / 2; }
__host__ __device__ __forceinline__ int perm32(int rho) { const int n = rho >> 4, i = rho & 15; return 8 * (i >> 2) + 4 * n + (i & 3); }

struct Unit { int pm, pn; };
struct Gemm { const bf16_t* A; const bf16_t* Bt; int M, N, K; };

struct StaticOrder {
    int nM, nN, nwg, G, c;
    __host__ __device__ void init(int M, int N, int G_, int c_) { nM = M / BM; nN = N / BM; nwg = nM * nN; G = G_; c = c_; }
    __host__ __device__ bool next(int i, Unit& u) const {
        const long L = (long)i * G + c; if (L >= nwg) return false;
        int wgid = (int)L; { const int q = nwg / NXCD, r = nwg % NXCD, xcd = wgid % NXCD, off = wgid / NXCD; wgid = (xcd < r ? xcd * (q + 1) : r * (q + 1) + (xcd - r) * q) + off; }
        const int nig = WGM * nN, gid = wgid / nig, fm = gid * WGM, gsz = (nM - fm) < WGM ? (nM - fm) : WGM;
        u.pm = fm + ((wgid % nig) % gsz); u.pn = (wgid % nig) / gsz; return true;
    }
    __device__ __forceinline__ void a_ready(const Unit&) const {}
    __device__ __forceinline__ void done(const Unit&) const {}
};
__device__ __forceinline__ unsigned cvt_pk_bf16(float lo, float hi) { unsigned r; asm volatile("v_cvt_pk_bf16_f32 %0, %1, %2" : "=v"(r) : "v"(lo), "v"(hi)); return r; }
typedef float f32x2 __attribute__((ext_vector_type(2)));
template <class Epi, class Sched, bool STAMP = false>
__device__ __forceinline__ void gemm_phase(PG8_LAS unsigned char* lds, const Gemm g, const Sched& S, const Epi& E, unsigned long long* stamps) {
    const int tid = tid_fresh(), wid = __builtin_amdgcn_readfirstlane(tid >> 6), lane = tid & 63, wr = wid >> 2, wc = wid & 3, fr = lane & 15, fq = lane >> 4;
    const int K = g.K, nt = K / BK;
    int ts_lo = 0, ts_hi = 0, nts = 0; const unsigned long long rt_entry = STAMP ? (unsigned long long)wall_clock64() : 0ull;
#define PG8_STAMP() do { if (STAMP && wid == 0 && nts < 64) { const unsigned long long _c = (unsigned long long)clock64(); \
        ts_lo = (lane == nts) ? (int)(unsigned)_c : ts_lo; ts_hi = (lane == nts) ? (int)(unsigned)(_c >> 32) : ts_hi; ++nts; } } while (0)
    PG8_STAMP();
    unsigned voffA[2], voffB[2];
#pragma unroll
    for (int i = 0; i < 2; ++i) { int R, C; stage_rc(tid * 16 + i * 8192, R, C); const int Rb = Epi::PERM ? ((R & ~31) + perm32(R & 31)) : R;
        voffA[i] = (unsigned)(R * K + C) * 2u; voffB[i] = (unsigned)(Rb * K + C) * 2u; }
    const size_t kstep = (size_t)(BK * 2);
    const size_t hstep = (size_t)HALF * K * 2;
    const size_t tstep = 2 * hstep;
    const unsigned ldsw = (unsigned)wid * 1024u;
    const int aoff = lds_byte(wr * 64 + fr, fq * 8), boff = lds_byte(wc * 32 + fr, fq * 8);
#define PG8_SA(b, h) (((b) * 2 + (h)) * HTB)
#define PG8_SB(b, h) ((4 + (b) * 2 + (h)) * HTB)
#define PG8_STAGE(bufoff, gbase, voff) do { _Pragma("unroll") for (int _i = 0; _i < 2; ++_i) \
        __builtin_amdgcn_global_load_lds((const unsigned*)((const char*)(gbase) + (voff)[_i]), (PG8_LAS unsigned*)(lds + (bufoff) + ldsw + _i * 8192), 16, 0, 0); } while (0)
#define PG8_LDA(dst, b, h) do { _Pragma("unroll") for (int m = 0; m < 4; ++m) _Pragma("unroll") for (int k = 0; k < 2; ++k) dst[m][k] = *(const PG8_LAS bf16x8*)(lds + PG8_SA(b, h) + aoff + m * 2048 + k * 1024); } while (0)
#define PG8_LDB(dst, b, h) do { _Pragma("unroll") for (int n = 0; n < 2; ++n) _Pragma("unroll") for (int k = 0; k < 2; ++k) dst[n][k] = *(const PG8_LAS bf16x8*)(lds + PG8_SB(b, h) + boff + n * 2048 + k * 1024); } while (0)
#define PG8_MMA(ai, bj, At, Bt) do { __builtin_amdgcn_s_setprio(1); _Pragma("unroll") for (int m = 0; m < 4; ++m) _Pragma("unroll") for (int n = 0; n < 2; ++n) _Pragma("unroll") for (int k = 0; k < 2; ++k) \
        acc[ai][bj][m][n] = __builtin_amdgcn_mfma_f32_16x16x32_bf16(Bt[n][k], At[m][k], acc[ai][bj][m][n], 0, 0, 0); __builtin_amdgcn_s_setprio(0); } while (0)
#define PG8_WAIT_V(n) asm volatile("s_waitcnt vmcnt(" #n ")" ::: "memory")
#define PG8_WAIT_L(n) asm volatile("s_waitcnt lgkmcnt(" #n ")" ::: "memory")
#define PG8_BAR __builtin_amdgcn_s_barrier()
#define PG8_SCHED __builtin_amdgcn_sched_barrier(0)
    Unit cur, nxt; int ui = 0;
    if (!S.next(0, cur)) return;
    f32x4 acc[2][2][4][2];
#pragma unroll
    for (int a = 0; a < 2; ++a)
#pragma unroll
        for (int b = 0; b < 2; ++b)
#pragma unroll
            for (int m = 0; m < 4; ++m)
#pragma unroll
                for (int n = 0; n < 2; ++n) acc[a][b][m][n] = (f32x4){0.f, 0.f, 0.f, 0.f};
    bf16x8 At[4][2], B0[2][2], B1[2][2];
    const char* cA = (const char*)g.A + (size_t)cur.pm * tstep; const char* cB = (const char*)g.Bt + (size_t)cur.pn * tstep;
    S.a_ready(cur);
    PG8_STAGE(PG8_SB(0, 0), cB, voffB); PG8_STAGE(PG8_SA(0, 0), cA, voffA); PG8_STAGE(PG8_SB(0, 1), cB + hstep, voffB); PG8_STAGE(PG8_SA(0, 1), cA + hstep, voffA);
    if (wr == 1) PG8_BAR;
    PG8_WAIT_V(4); PG8_BAR;
    PG8_STAGE(PG8_SB(1, 0), cB + kstep, voffB); PG8_STAGE(PG8_SA(1, 0), cA + kstep, voffA); PG8_STAGE(PG8_SB(1, 1), cB + hstep + kstep, voffB);
    PG8_WAIT_V(6); PG8_BAR;
    PG8_STAMP();
    for (;;) {
        const bool has_next = S.next(ui + 1, nxt);
        const char* nA = has_next ? (const char*)g.A + (size_t)nxt.pm * tstep : cA; const char* nB = has_next ? (const char*)g.Bt + (size_t)nxt.pn * tstep : cB;
        for (int t = 0; t < nt; t += 2) {
            const bool last = (t == nt - 2);
            const char* a1 = cA + (size_t)(t + 1) * kstep;
            const char* a2 = last ? nA : cA + (size_t)(t + 2) * kstep; const char* b2 = last ? nB : cB + (size_t)(t + 2) * kstep;
            const char* a3 = a2 + kstep; const char* b3 = b2 + kstep;
            if (last && has_next) S.a_ready(nxt);
            PG8_LDB(B0, 0, 0); PG8_SCHED; PG8_LDA(At, 0, 0); PG8_STAGE(PG8_SA(1, 1), a1 + hstep, voffA);
            PG8_WAIT_L(8); PG8_BAR; PG8_WAIT_L(0); PG8_MMA(0, 0, At, B0); PG8_BAR; PG8_SCHED;
            PG8_LDB(B1, 0, 1); PG8_STAGE(PG8_SB(0, 0), b2, voffB);
            PG8_BAR; PG8_WAIT_L(0); PG8_MMA(0, 1, At, B1); PG8_BAR;
            PG8_LDA(At, 0, 1); PG8_STAGE(PG8_SA(0, 0), a2, voffA);
            PG8_BAR; PG8_WAIT_L(0); PG8_MMA(1, 0, At, B0); PG8_BAR; PG8_SCHED;
            PG8_STAGE(PG8_SB(0, 1), b2 + hstep, voffB);
            PG8_WAIT_V(6); PG8_BAR; PG8_MMA(1, 1, At, B1); PG8_BAR;
            PG8_LDB(B0, 1, 0); PG8_SCHED; PG8_LDA(At, 1, 0); PG8_STAGE(PG8_SA(0, 1), a2 + hstep, voffA);
            PG8_WAIT_L(8); PG8_BAR; PG8_WAIT_L(0); PG8_MMA(0, 0, At, B0); PG8_BAR; PG8_SCHED;
            PG8_LDB(B1, 1, 1); PG8_STAGE(PG8_SB(1, 0), b3, voffB);
            PG8_BAR; PG8_WAIT_L(0); PG8_MMA(0, 1, At, B1); PG8_BAR;
            PG8_LDA(At, 1, 1); PG8_STAGE(PG8_SA(1, 0), a3, voffA);
            PG8_BAR; PG8_WAIT_L(0); PG8_MMA(1, 0, At, B0); PG8_BAR; PG8_SCHED;
            PG8_STAGE(PG8_SB(1, 1), b3 + hstep, voffB);
            PG8_WAIT_V(6); PG8_BAR; PG8_MMA(1, 1, At, B1); PG8_BAR;
        }
        PG8_STAMP();
        if constexpr (!Epi::AFTER_DRAIN) { E(acc, cur, wr, wc, fr, fq); S.done(cur); }
        PG8_STAMP();
        if (!has_next) break;
#pragma unroll
        for (int a = 0; a < 2; ++a)
#pragma unroll
            for (int b = 0; b < 2; ++b)
#pragma unroll
                for (int m = 0; m < 4; ++m)
#pragma unroll
                    for (int n = 0; n < 2; ++n) acc[a][b][m][n] = (f32x4){0.f, 0.f, 0.f, 0.f};
        cur = nxt; cA = nA; cB = nB; ++ui;
    }
    PG8_WAIT_V(0);
    if (wr == 0) PG8_BAR;
    PG8_BAR;
    if constexpr (Epi::AFTER_DRAIN) { E.fused(acc, cur, wr, wc, fr, fq, lds, wid, lane); S.done(cur); }
    PG8_STAMP();
    if (STAMP && wid == 0) { stamps[lane] = lane < nts ? (((unsigned long long)(unsigned)ts_hi << 32) | (unsigned)ts_lo) : 0ull;
        if (lane == 62) stamps[62] = rt_entry; if (lane == 63) stamps[63] = (unsigned long long)wall_clock64(); }
#undef PG8_STAMP
#undef PG8_SA
#undef PG8_SB
#undef PG8_STAGE
#undef PG8_LDA
#undef PG8_LDB
#undef PG8_MMA
#undef PG8_WAIT_V
#undef PG8_WAIT_L
#undef PG8_BAR
#undef PG8_SCHED
}
}
using namespace pg8;
#define LAS __attribute__((address_space(3)))
typedef unsigned short u16;
typedef unsigned int u32;
typedef float f32x16 __attribute__((ext_vector_type(16)));
typedef unsigned int u32x2 __attribute__((ext_vector_type(2)));

constexpr int TX = 65536, TCX = 8192, TT = 73728;
constexpr int DFF = 2816, NGU = 5632, NIN = 4864;
constexpr float EPSF = 1e-6f;
constexpr int LDS_BYTES = 160768;
constexpr int NPHASE = 15;

constexpr size_t SZ_WGU = (size_t)NGU * 1024 * 2, SZ_WD = (size_t)1024 * DFF * 2, SZ_WIN = (size_t)NIN * 1024 * 2, SZ_WOUT = (size_t)1024 * 2048 * 2;
constexpr size_t OFF_WGU1 = 0, OFF_WD1 = OFF_WGU1 + SZ_WGU, OFF_WGU2 = OFF_WD1 + SZ_WD, OFF_WD2 = OFF_WGU2 + SZ_WGU, OFF_WIN = OFF_WD2 + SZ_WD, OFF_WOUT = OFF_WIN + SZ_WIN;
constexpr size_t OFF_MOD = OFF_WOUT + SZ_WOUT;
constexpr size_t OFF_XC1 = OFF_MOD + (size_t)33 * 9216 * 4;
constexpr size_t OFF_DT = OFF_XC1 + (size_t)TCX * 1024 * 4;
constexpr size_t SZ_A16 = (size_t)TT * 16 * 4;
constexpr size_t OFF_DTF = OFF_DT + (size_t)TT * 32 * 4, OFF_DTB = OFF_DTF + SZ_A16, OFF_CSF = OFF_DTB + SZ_A16, OFF_CSB = OFF_CSF + SZ_A16;
constexpr size_t OFF_CDEC = OFF_CSB + SZ_A16;
constexpr size_t OFF_BAR = OFF_CDEC + (size_t)32 * 2 * 18 * 16 * 4;
constexpr size_t OFF_BIG = OFF_BAR + 256;
constexpr size_t SZ_H = (size_t)TT * 1024 * 2, SZ_ACT = (size_t)TT * DFF * 2, SZ_ST = (size_t)32 * 2 * 17 * 16 * 8192 * 2;
constexpr size_t OFF_H = OFF_BIG, OFF_ACT = OFF_BIG + SZ_H, OFF_ST = OFF_BIG;
constexpr size_t WS_TOTAL = (size_t)1 << 30;
constexpr size_t OFF_U = WS_TOTAL - (size_t)TX * 1024 * 2, OFF_XBC = OFF_U - (size_t)TT * 1536 * 2, OFF_Y = OFF_XBC - (size_t)TX * 2048 * 2;
static_assert(OFF_BIG % 256 == 0 && OFF_ACT + SZ_ACT <= WS_TOTAL && OFF_Y >= OFF_ST + SZ_ST && OFF_Y >= OFF_H + SZ_H, "workspace map");

struct Params {
    const float *x, *c, *ctx, *c_ctx, *w_mod, *b_mod, *norm_ffn1, *g1, *u1, *d1, *norm_mix, *w_in, *scw, *scb, *dtbf, *dtbb, *alf, *alb, *ssm_d, *ssm_nw, *ccw, *ccb, *lnw, *lnb,
        *w_out, *norm_ffn2, *g2, *u2, *d2, *fnorm;
    float* out; unsigned char* ws; int ph_lo, ph_hi;
};

__device__ __forceinline__ float bf2f(u16 v) { return __uint_as_float(((u32)v) << 16); }
__device__ __forceinline__ u16 f2bf(float f) { u32 u = __float_as_uint(f); u += 0x7FFFu + ((u >> 16) & 1u); return (u16)(u >> 16); }
__device__ __forceinline__ float lo_f(u32 v) { return __uint_as_float(v << 16); }
__device__ __forceinline__ float hi_f(u32 v) { return __uint_as_float(v & 0xffff0000u); }
__device__ __forceinline__ float silu_f(float x) { return x * __builtin_amdgcn_rcpf(1.0f + __expf(-x)); }
__device__ __forceinline__ float sigm_f(float x) { return __builtin_amdgcn_rcpf(1.0f + __expf(-x)); }
__device__ __forceinline__ float wave_sum(float v) {
#pragma unroll
    for (int o = 32; o >= 1; o >>= 1) v += __shfl_xor(v, o);
    return v;
}

struct InOrder : StaticOrder {
    __device__ bool next(int i, Unit& u) const {
        const long L = (long)i * G + c;
        if (L < nwg) return StaticOrder::next(i, u);
        const int e = (int)(L - nwg); if (e >= 192) return false;
        u.pm = 256 + (e & 31); u.pn = e >> 5; return true;
    }
};

struct EpiSwiGLU {
    static constexpr bool PERM = true, AFTER_DRAIN = false;
    bf16_t* O;
    __device__ __forceinline__ void operator()(const f32x4 (&acc)[2][2][4][2], const Unit& u, int wr, int wc, int fr, int fq) const {
        const int row0 = u.pm * BM + wr * 64 + fr, col0 = u.pn * 128 + wc * 32 + 8 * fq;
#pragma unroll
        for (int ai = 0; ai < 2; ++ai)
#pragma unroll
            for (int m = 0; m < 4; ++m) {
                bf16_t* rowp = O + (size_t)(row0 + ai * HALF + m * 16) * DFF + col0;
                const f32x4 g0 = acc[ai][0][m][0], g1 = acc[ai][0][m][1], u0 = acc[ai][1][m][0], u1 = acc[ai][1][m][1];
                u32x4 w;
                w.x = cvt_pk_bf16(silu_f(g0[0]) * u0[0], silu_f(g0[1]) * u0[1]); w.y = cvt_pk_bf16(silu_f(g0[2]) * u0[2], silu_f(g0[3]) * u0[3]);
                w.z = cvt_pk_bf16(silu_f(g1[0]) * u1[0], silu_f(g1[1]) * u1[1]); w.w = cvt_pk_bf16(silu_f(g1[2]) * u1[2], silu_f(g1[3]) * u1[3]);
                *(u32x4*)rowp = w;
            }
    }
};

struct EpiResid {
    static constexpr bool PERM = false, AFTER_DRAIN = false;
    const float* baseX; float* outX; const float* baseC; float* outC; const float* mod; float s;
    __device__ __forceinline__ void operator()(const f32x4 (&acc)[2][2][4][2], const Unit& u, int wr, int wc, int fr, int fq) const {
        const int row0 = u.pm * BM + wr * 64 + fr, col0 = u.pn * BM + wc * 32 + 4 * fq;
        const bool isx = u.pm < 256; const int b = isx ? (u.pm >> 3) : 32;
        const float* bp0 = isx ? baseX + (size_t)row0 * 1024 : baseC + (size_t)(row0 - TX) * 1024;
        float* op0 = isx ? outX + (size_t)row0 * 1024 : outC + (size_t)(row0 - TX) * 1024;
        f32x4 mv[2][2];
#pragma unroll
        for (int bj = 0; bj < 2; ++bj)
#pragma unroll
            for (int n = 0; n < 2; ++n) mv[bj][n] = *(const f32x4*)(mod + (size_t)b * 9216 + col0 + bj * HALF + n * 16) * s;
#pragma unroll
        for (int ai = 0; ai < 2; ++ai)
#pragma unroll
            for (int m = 0; m < 4; ++m) {
                const size_t ro = (size_t)(ai * HALF + m * 16) * 1024 + col0;
                f32x4 bv[2][2];
#pragma unroll
                for (int bj = 0; bj < 2; ++bj)
#pragma unroll
                    for (int n = 0; n < 2; ++n) bv[bj][n] = *(const f32x4*)(bp0 + ro + bj * HALF + n * 16);
#pragma unroll
                for (int bj = 0; bj < 2; ++bj)
#pragma unroll
                    for (int n = 0; n < 2; ++n) *(f32x4*)(op0 + ro + bj * HALF + n * 16) = bv[bj][n] + mv[bj][n] * acc[ai][bj][m][n];
            }
    }
};

struct EpiInProj {
    static constexpr bool PERM = true, AFTER_DRAIN = false;
    bf16_t* XBC; float* DT; bf16_t* Y; bf16_t* U;
    __device__ __forceinline__ void operator()(const f32x4 (&acc)[2][2][4][2], const Unit& u, int wr, int wc, int fr, int fq) const {
        const int row0 = u.pm * BM + wr * 64 + fr, cin = wc * 32 + 8 * fq, pn = u.pn;
        if (pn == 5) {
            if (wc == 0) {
#pragma unroll
                for (int ai = 0; ai < 2; ++ai)
#pragma unroll
                    for (int m = 0; m < 4; ++m) {
                        float* rp = DT + (size_t)(row0 + ai * HALF + m * 16) * 32 + 8 * fq;
                        *(f32x4*)rp = acc[ai][0][m][0]; *(f32x4*)(rp + 4) = acc[ai][0][m][1];
                    }
            }
        } else if (pn <= 10) {
            bf16_t* base; int ld;
            if (pn <= 4) { base = XBC + pn * 256; ld = 1536; } else if (pn == 6) { base = XBC + 1280; ld = 1536; } else { base = Y + (pn - 7) * 256; ld = 2048; }
#pragma unroll
            for (int ai = 0; ai < 2; ++ai)
#pragma unroll
                for (int m = 0; m < 4; ++m) {
                    bf16_t* rowp = base + (size_t)(row0 + ai * HALF + m * 16) * ld + cin;
#pragma unroll
                    for (int bj = 0; bj < 2; ++bj) {
                        const f32x4 v0 = acc[ai][bj][m][0], v1 = acc[ai][bj][m][1];
                        u32x4 w; w.x = cvt_pk_bf16(v0[0], v0[1]); w.y = cvt_pk_bf16(v0[2], v0[3]); w.z = cvt_pk_bf16(v1[0], v1[1]); w.w = cvt_pk_bf16(v1[2], v1[3]);
                        *(u32x4*)(rowp + bj * HALF) = w;
                    }
                }
        } else {
            bf16_t* base = U + (pn - 11) * 128 + cin;
#pragma unroll
            for (int ai = 0; ai < 2; ++ai)
#pragma unroll
                for (int m = 0; m < 4; ++m) {
                    bf16_t* rowp = base + (size_t)(row0 + ai * HALF + m * 16) * 1024;
                    const f32x4 a0 = acc[ai][0][m][0], a1 = acc[ai][0][m][1], b0 = acc[ai][1][m][0], b1 = acc[ai][1][m][1];
                    u32x4 w;
                    w.x = cvt_pk_bf16(a0[0] * sigm_f(b0[0]), a0[1] * sigm_f(b0[1])); w.y = cvt_pk_bf16(a0[2] * sigm_f(b0[2]), a0[3] * sigm_f(b0[3]));
                    w.z = cvt_pk_bf16(a1[0] * sigm_f(b1[0]), a1[1] * sigm_f(b1[1])); w.w = cvt_pk_bf16(a1[2] * sigm_f(b1[2]), a1[3] * sigm_f(b1[3]));
                    *(u32x4*)rowp = w;
                }
        }
    }
};

__device__ __forceinline__ void prep_mod_item(const Params& P, LAS unsigned char* lds, int it) {
    const int tid = tid_fresh();
    LAS float* cc = (LAS float*)lds;
    for (int i = tid; i < 33 * 1024; i += 512) { const int r = i >> 10, k = i & 1023; const float v = (r < 32) ? P.c[r * 1024 + k] : P.c_ctx[k]; cc[i] = silu_f(v); }
    __syncthreads();
    const int n0 = it * 64, col = tid & 63, kk = tid >> 6;
    float acc[33];
#pragma unroll
    for (int r = 0; r < 33; ++r) acc[r] = 0.f;
    const float* wp = P.w_mod + (size_t)(kk * 128) * 9216 + n0 + col;
    for (int k4 = 0; k4 < 32; ++k4) {
        const float w0 = wp[(size_t)(k4 * 4 + 0) * 9216], w1 = wp[(size_t)(k4 * 4 + 1) * 9216], w2 = wp[(size_t)(k4 * 4 + 2) * 9216], w3 = wp[(size_t)(k4 * 4 + 3) * 9216];
#pragma unroll
        for (int r = 0; r < 33; ++r) { const f32x4 c4 = *(const LAS f32x4*)(cc + r * 1024 + kk * 128 + k4 * 4); acc[r] += c4[0] * w0 + c4[1] * w1 + c4[2] * w2 + c4[3] * w3; }
    }
    __syncthreads();
    LAS float* red = (LAS float*)lds;
#pragma unroll
    for (int r = 0; r < 33; ++r) red[(kk * 33 + r) * 64 + col] = acc[r];
    __syncthreads();
    float* MOD = (float*)(P.ws + OFF_MOD);
    for (int o = tid; o < 33 * 64; o += 512) { const int r = o >> 6, cl = o & 63; float s = 0.f;
#pragma unroll
        for (int q = 0; q < 8; ++q) s += red[(q * 33 + r) * 64 + cl];
        MOD[(size_t)r * 9216 + n0 + cl] = s + P.b_mod[n0 + cl]; }
    __syncthreads();
}

__device__ __forceinline__ void prep_tile(const Params& P, LAS unsigned char* lds, int t) {
    const int tid = tid_fresh();
    const float* src; int sld, scol0, nvalid = 64, kt, n0, dld; u16* dst;
    if (t < 2816) {
        const int f = t >= 1408; const int tt = t - f * 1408; const int nt = tt >> 4; kt = tt & 15; n0 = nt * 64;
        const int j = n0 >> 8, s0 = n0 & 255;
        src = (s0 < 128) ? (f ? P.g2 : P.g1) : (f ? P.u2 : P.u1); scol0 = 128 * j + (s0 & 127); sld = DFF;
        dst = (u16*)(P.ws + (f ? OFF_WGU2 : OFF_WGU1)); dld = 1024;
    } else if (t < 2816 + 1408) {
        const int t2 = t - 2816; const int f = t2 >= 704; const int tt = t2 - f * 704; const int nt = tt / 44; kt = tt % 44; n0 = nt * 64;
        src = f ? P.d2 : P.d1; scol0 = n0; sld = 1024; dst = (u16*)(P.ws + (f ? OFF_WD2 : OFF_WD1)); dld = DFF;
    } else if (t < 2816 + 1408 + 1216) {
        const int tt = t - 4224; const int nt = tt >> 4; kt = tt & 15; n0 = nt * 64;
        const int pn = n0 >> 8, s0 = n0 & 255;
        if (pn < 4) scol0 = 1024 + n0; else if (pn == 4) scol0 = 2048 + s0; else if (pn == 5) { scol0 = 2560 + (s0 ? 0 : 0); nvalid = s0 ? 0 : 32; }
        else if (pn == 6) scol0 = 2304 + s0; else if (pn <= 10) scol0 = n0 - 1792;
        else { const int j = pn - 11; scol0 = (s0 < 128) ? (2592 + 128 * j + s0) : (2592 + 1024 + 128 * j + (s0 - 128)); }
        src = P.w_in; sld = 4640; dst = (u16*)(P.ws + OFF_WIN); dld = 1024;
    } else {
        const int tt = t - 5440; const int nt = tt >> 5; kt = tt & 31; n0 = nt * 64;
        src = P.w_out; scol0 = n0; sld = 1024; dst = (u16*)(P.ws + OFF_WOUT); dld = 2048;
    }
    LAS float* tile = (LAS float*)lds;
#pragma unroll
    for (int e = 0; e < 8; ++e) { const int idx = tid + 512 * e, kk = idx >> 6, nn = idx & 63;
        tile[kk * 65 + nn] = (nn < nvalid) ? src[(size_t)(kt * 64 + kk) * sld + scol0 + nn] : 0.f; }
    __syncthreads();
    { const int nn = tid >> 3, ks = (tid & 7) * 8; u32x4 w;
      w.x = cvt_pk_bf16(tile[(ks + 0) * 65 + nn], tile[(ks + 1) * 65 + nn]); w.y = cvt_pk_bf16(tile[(ks + 2) * 65 + nn], tile[(ks + 3) * 65 + nn]);
      w.z = cvt_pk_bf16(tile[(ks + 4) * 65 + nn], tile[(ks + 5) * 65 + nn]); w.w = cvt_pk_bf16(tile[(ks + 6) * 65 + nn], tile[(ks + 7) * 65 + nn]);
      *(u32x4*)(dst + (size_t)(n0 + nn) * dld + kt * 64 + ks) = w; }
    __syncthreads();
}

__device__ __forceinline__ void phase_prep(const Params& P, LAS unsigned char* lds) {
    constexpr int NMOD = 144, NTILE = 2816 + 1408 + 1216 + 512;
    for (int it = blockIdx.x; it < NMOD + NTILE; it += gridDim.x) { if (it < NMOD) prep_mod_item(P, lds, it); else prep_tile(P, lds, it - NMOD); }
}

template <int MODE>
__device__ __forceinline__ void phase_norm(const Params& P, const float* srcX, const float* srcC, int nrows, const float* nw, int shIdx, int scIdx, u16* H, float* outF) {
    constexpr int NR = 4;
    const int lane = tid_fresh() & 63, gw = blockIdx.x * 8 + (tid_fresh() >> 6), nwv = gridDim.x * 8;
    const float* MOD = (const float*)(P.ws + OFF_MOD);
    f32x4 w[4];
#pragma unroll
    for (int i = 0; i < 4; ++i) w[i] = *(const f32x4*)(nw + i * 256 + lane * 4);
    for (int row0 = gw * NR; row0 < nrows; row0 += nwv * NR) {
        f32x4 v[NR][4];
        const float* src0 = (row0 < TX) ? srcX + (size_t)row0 * 1024 : srcC + (size_t)(row0 - TX) * 1024;
#pragma unroll
        for (int q = 0; q < NR; ++q) {
#pragma unroll
            for (int i = 0; i < 4; ++i) v[q][i] = *(const f32x4*)(src0 + q * 1024 + i * 256 + lane * 4); }
        const int b = (row0 < TX) ? (row0 >> 11) : 32;
        float rstd[NR];
#pragma unroll
        for (int q = 0; q < NR; ++q) { float ss = 0.f;
#pragma unroll
            for (int i = 0; i < 4; ++i) ss += v[q][i][0] * v[q][i][0] + v[q][i][1] * v[q][i][1] + v[q][i][2] * v[q][i][2] + v[q][i][3] * v[q][i][3];
            rstd[q] = rsqrtf(wave_sum(ss) * (1.0f / 1024.0f) + EPSF); }
#pragma unroll
        for (int i = 0; i < 4; ++i) { const int col = i * 256 + lane * 4;
            if (MODE == 0) {
                const f32x4 sh = *(const f32x4*)(MOD + (size_t)b * 9216 + shIdx * 1024 + col), sc = *(const f32x4*)(MOD + (size_t)b * 9216 + scIdx * 1024 + col);
                const f32x4 ws = w[i] * (sc + 1.0f);
#pragma unroll
                for (int q = 0; q < NR; ++q) { const f32x4 o = v[q][i] * rstd[q] * ws + sh;
                    uint2 pk; pk.x = cvt_pk_bf16(o[0], o[1]); pk.y = cvt_pk_bf16(o[2], o[3]);
                    *(uint2*)(H + (size_t)(row0 + q) * 1024 + col) = pk; }
            } else {
#pragma unroll
                for (int q = 0; q < NR; ++q) *(f32x4*)(outF + (size_t)(row0 + q) * 1024 + col) = v[q][i] * rstd[q] * w[i];
            } }
    }
}

template <int NC>
__device__ __forceinline__ void stage_conv(LAS u16* dst, int ld, const u16* XBC, int row0, int seq0, int seq1, int col0, const float* cw, const float* cb) {
    constexpr int NP = NC / 2, NTG = 512 / NP, TPG = 128 / NTG;
    const int tid = tid_fresh(), cp = tid % NP, tg = tid / NP, ch = col0 + 2 * cp, l0 = tg * TPG;
    float w0[5], w1[5];
#pragma unroll
    for (int k = 0; k < 5; ++k) { w0[k] = cw[k * 1536 + ch]; w1[k] = cw[k * 1536 + ch + 1]; }
    const float b0 = cb[ch], b1 = cb[ch + 1];
    u32 win[5] = {0u, 0u, 0u, 0u, 0u};
    u32 ldv[TPG + 4];
#pragma unroll
    for (int i = 0; i < TPG + 4; ++i) { const int r = row0 + l0 - 2 + i; const int rc = min(max(r, seq0), seq1 - 1); ldv[i] = *(const u32*)(XBC + (size_t)rc * 1536 + ch); }
#pragma unroll
    for (int i = 0; i < TPG + 4; ++i) {
        const int r = row0 + l0 - 2 + i;
        const u32 v = (r >= seq0 && r < seq1) ? ldv[i] : 0u;
        win[0] = win[1]; win[1] = win[2]; win[2] = win[3]; win[3] = win[4]; win[4] = v;
        if (i >= 4) {
            float a0 = b0, a1 = b1;
#pragma unroll
            for (int k = 0; k < 5; ++k) { a0 += w0[k] * lo_f(win[k]); a1 += w1[k] * hi_f(win[k]); }
            *(LAS u32*)(dst + (l0 + i - 4) * ld + 2 * cp) = cvt_pk_bf16(silu_f(a0), silu_f(a1));
        }
    }
}

template <int NC>
__device__ __forceinline__ void stage_conv_t(LAS u16* dst, int ld, const u16* XBC, int row0, int seq0, int seq1, int col0, const float* cw, const float* cb) {
    constexpr int NP = NC / 2, NTG = 512 / NP, TPG = 128 / NTG;
    const int tid = tid_fresh(), cp = tid % NP, tg = tid / NP, ch = col0 + 2 * cp, l0 = tg * TPG;
    float w0[5], w1[5];
#pragma unroll
    for (int k = 0; k < 5; ++k) { w0[k] = cw[k * 1536 + ch]; w1[k] = cw[k * 1536 + ch + 1]; }
    const float b0 = cb[ch], b1 = cb[ch + 1];
    u32 ldv[TPG + 4];
#pragma unroll
    for (int i = 0; i < TPG + 4; ++i) { const int r = row0 + l0 - 2 + i; const int rc = min(max(r, seq0), seq1 - 1); ldv[i] = *(const u32*)(XBC + (size_t)rc * 1536 + ch); }
#pragma unroll
    for (int i = 0; i < TPG + 4; ++i) { const int r = row0 + l0 - 2 + i; if (!(r >= seq0 && r < seq1)) ldv[i] = 0u; }
    float o0[TPG], o1[TPG];
#pragma unroll
    for (int t = 0; t < TPG; ++t) { float a0 = b0, a1 = b1;
#pragma unroll
        for (int k = 0; k < 5; ++k) { a0 += w0[k] * lo_f(ldv[t + k]); a1 += w1[k] * hi_f(ldv[t + k]); }
        o0[t] = silu_f(a0); o1[t] = silu_f(a1); }
#pragma unroll
    for (int q = 0; q < TPG / 8; ++q) {
        u32x4 a, b;
        a.x = cvt_pk_bf16(o0[8 * q + 0], o0[8 * q + 1]); a.y = cvt_pk_bf16(o0[8 * q + 2], o0[8 * q + 3]); a.z = cvt_pk_bf16(o0[8 * q + 4], o0[8 * q + 5]); a.w = cvt_pk_bf16(o0[8 * q + 6], o0[8 * q + 7]);
        b.x = cvt_pk_bf16(o1[8 * q + 0], o1[8 * q + 1]); b.y = cvt_pk_bf16(o1[8 * q + 2], o1[8 * q + 3]); b.z = cvt_pk_bf16(o1[8 * q + 4], o1[8 * q + 5]); b.w = cvt_pk_bf16(o1[8 * q + 6], o1[8 * q + 7]);
        *(LAS u32x4*)(dst + (2 * cp) * ld + l0 + 8 * q) = a; *(LAS u32x4*)(dst + (2 * cp + 1) * ld + l0 + 8 * q) = b;
    }
}

__device__ __forceinline__ void dtprep_item(const Params& P, LAS unsigned char* lds, int tc) {
    const int tid = tid_fresh(), dh = tid & 31, seg = tid >> 5, dir = dh >> 4, h = dh & 15;
    const bool isx = tc < 512; const int b = isx ? (tc >> 4) : ((tc - 512) >> 1); const int cidx = isx ? (tc & 15) : ((tc - 512) & 1);
    const int row0 = tc * 128;
    const int jscan = isx ? (dir ? 17 - cidx : cidx + 2) : (dir ? 1 - cidx : cidx);
    const float bias = dir ? P.dtbb[h] : P.dtbf[h]; const float a = -__expf(dir ? P.alb[h] : P.alf[h]);
    const float* DT = (const float*)(P.ws + OFF_DT);
    float dt[8], cs[8];
#pragma unroll
    for (int i = 0; i < 8; ++i) { const float raw = DT[(size_t)(row0 + seg * 8 + i) * 32 + dh] + bias; dt[i] = (raw > 20.f) ? raw : log1pf(__expf(raw)); }
    float run = 0.f;
    if (dir == 0) {
#pragma unroll
        for (int i = 0; i < 8; ++i) { run += dt[i] * a; cs[i] = run; }
    } else {
#pragma unroll
        for (int i = 7; i >= 0; --i) { run += dt[i] * a; cs[i] = run; }
    }
    LAS float* segsum = (LAS float*)lds;
    segsum[seg * 32 + dh] = run;
    __syncthreads();
    float off = 0.f, tot = 0.f;
#pragma unroll
    for (int s2 = 0; s2 < 16; ++s2) { const float v = segsum[s2 * 32 + dh]; tot += v; if (dir == 0 ? (s2 < seg) : (s2 > seg)) off += v; }
    float* DTO = (float*)(P.ws + (dir ? OFF_DTB : OFF_DTF)); float* CSO = (float*)(P.ws + (dir ? OFF_CSB : OFF_CSF));
#pragma unroll
    for (int i = 0; i < 8; ++i) { const size_t o = (size_t)(row0 + seg * 8 + i) * 16 + h; DTO[o] = dt[i]; CSO[o] = cs[i] + off; }
    if (seg == 0) ((float*)(P.ws + OFF_CDEC))[((b * 2 + dir) * 18 + jscan) * 16 + h] = __expf(tot);
    __syncthreads();
}

typedef float f32x2 __attribute__((ext_vector_type(2)));
__device__ __forceinline__ void uconv_item(const Params& P, LAS unsigned char* lds, int item) {
    const int tid = tid_fresh(); const bool isH = item < 2048; const int e = item & 2047, b = e >> 6, q = (e >> 1) & 31, chalf = e & 1;
    LAS float* in = (LAS float*)lds;
    const u16* Ug = (const u16*)(P.ws + OFF_U); u16* Yg = (u16*)(P.ws + OFF_Y);
    const int choff = (isH ? 0 : 512) + 256 * chalf;
    u32x4 raw[4];
#pragma unroll
    for (int i = 0; i < 4; ++i) { const int idx = tid + 512 * i, tok = idx >> 5, c8 = idx & 31; int grow;
        if (isH) grow = b * 2048 + q * 64 + tok; else grow = b * 2048 + (tok & 31) * 64 + 2 * q + (tok >> 5);
        raw[i] = *(const u32x4*)(Ug + (size_t)grow * 1024 + choff + c8 * 8); }
    const int cp = tid & 127, tq = tid >> 7, ch = choff + 2 * cp;
    f32x2 w[31];
#pragma unroll
    for (int k = 0; k < 31; ++k) w[k] = *(const f32x2*)(P.ccw + k * 1024 + ch);
    const f32x2 bias = *(const f32x2*)(P.ccb + ch);
#pragma unroll
    for (int i = 0; i < 4; ++i) { const int idx = tid + 512 * i, tok = idx >> 5, c8 = idx & 31; const int lrow = isH ? (15 + tok) : ((tok >> 5) * 62 + 15 + (tok & 31));
        const u32x4 v = raw[i];
        *(LAS f32x4*)(in + lrow * 256 + c8 * 8) = (f32x4){lo_f(v.x), hi_f(v.x), lo_f(v.y), hi_f(v.y)};
        *(LAS f32x4*)(in + lrow * 256 + c8 * 8 + 4) = (f32x4){lo_f(v.z), hi_f(v.z), lo_f(v.w), hi_f(v.w)}; }
    { const int npad = isH ? 30 : 60;
      for (int idx = tid; idx < npad * 64; idx += 512) { const int pr = idx >> 6, c4 = idx & 63; int lrow;
          if (isH) lrow = (pr < 15) ? pr : 64 + pr; else { const int line = pr / 30, k = pr % 30; lrow = line * 62 + ((k < 15) ? k : 32 + k); }
          *(LAS f32x4*)(in + lrow * 256 + c4 * 4) = (f32x4){0.f, 0.f, 0.f, 0.f}; } }
    __syncthreads();
    const int base_row = isH ? 16 * tq : (62 * (tq >> 1) + 16 * (tq & 1));
    f32x2 win[46];
#pragma unroll
    for (int i = 0; i < 46; ++i) win[i] = *(const LAS f32x2*)(in + (base_row + i) * 256 + 2 * cp);
    const int g0 = isH ? (b * 2048 + q * 64 + 16 * tq) : (b * 2048 + (16 * (tq & 1)) * 64 + 2 * q + (tq >> 1));
    const int gstep = isH ? 1 : 64;
#pragma unroll
    for (int oo = 0; oo < 16; ++oo) {
        f32x2 a = bias;
#pragma unroll
        for (int k = 0; k < 31; ++k) a = win[oo + k] * w[k] + a;
        *(u32*)(Yg + (size_t)(g0 + oo * gstep) * 2048 + 1024 + ch) = cvt_pk_bf16(a[0], a[1]);
    }
    __syncthreads();
}

__device__ __forceinline__ void phase_p6(const Params& P, LAS unsigned char* lds) {
    for (int it = blockIdx.x; it < 576 + 4096; it += gridDim.x) { if (it < 576) dtprep_item(P, lds, it); else uconv_item(P, lds, it - 576); }
}

__device__ __forceinline__ bf16x8 gather8(const LAS u16* p, int stride) {
    bf16x8 r;
#pragma unroll
    for (int j = 0; j < 8; ++j) r[j] = (short)p[j * stride];
    return r;
}
#define MFMA32(a, b, c) __builtin_amdgcn_mfma_f32_32x32x16_bf16((a), (b), (c), 0, 0, 0)

__device__ __forceinline__ void s1_item(const Params& P, LAS unsigned char* lds, int item) {
    const int tid = tid_fresh(), w = tid >> 6, lane = tid & 63, r = lane & 31, hf = lane >> 5;
    const int g = item & 1, tc = (item >> 1) % 18, b = item / 36;
    const bool isx = tc < 16;
    const int seq0 = isx ? b * 2048 : TX + b * 256, seq1 = seq0 + (isx ? 2048 : 256), row0 = seq0 + 128 * (isx ? tc : tc - 16);
    const int jf = isx ? tc + 2 : tc - 16, jb = 17 - tc;
    LAS u16* BT = (LAS u16*)lds;
    LAS u16* XT = (LAS u16*)(lds + 34816);
    LAS float* wfb = (LAS float*)(lds + 34816 + 69632);
    const u16* XBC = (const u16*)(P.ws + OFF_XBC);
    const float *CSF = (const float*)(P.ws + OFF_CSF), *CSB = (const float*)(P.ws + OFF_CSB), *DTF = (const float*)(P.ws + OFF_DTF), *DTB = (const float*)(P.ws + OFF_DTB);
    u16* ST = (u16*)(P.ws + OFF_ST);
    stage_conv_t<128>(BT, 136, XBC, row0, seq0, seq1, 1024 + 128 * g, P.scw, P.scb);
    const int hq = w >> 1, pb = w & 1;
    for (int pass = 0; pass < 2; ++pass) {
        const int h0 = 8 * g + 4 * pass, h = h0 + hq;
        stage_conv_t<256>(XT, 136, XBC, row0, seq0, seq1, 64 * h0, P.scw, P.scb);
#pragma unroll
        for (int e = 0; e < 2; ++e) { const int idx = tid + 512 * e, hh = idx >> 8, dir = (idx >> 7) & 1, l = idx & 127, hx = h0 + hh;
            const float* CS = dir ? CSB : CSF; const float* DTA = dir ? DTB : DTF; const int rend = dir ? row0 : row0 + 127;
            wfb[(hh * 2 + dir) * 128 + l] = __expf(CS[(size_t)rend * 16 + hx] - CS[(size_t)(row0 + l) * 16 + hx]) * DTA[(size_t)(row0 + l) * 16 + hx]; }
        __syncthreads();
        f32x16 acc[2][4];
#pragma unroll
        for (int d = 0; d < 2; ++d)
#pragma unroll
            for (int nb = 0; nb < 4; ++nb)
#pragma unroll
                for (int i = 0; i < 16; ++i) acc[d][nb][i] = 0.f;
#pragma unroll 2
        for (int ks = 0; ks < 8; ++ks) {
            const int lb = 16 * ks + 8 * hf;
            const bf16x8 xr = *(const LAS bf16x8*)(XT + (hq * 64 + 32 * pb + r) * 136 + lb);
            const f32x4 wf0 = *(const LAS f32x4*)(wfb + (hq * 2 + 0) * 128 + lb), wf1 = *(const LAS f32x4*)(wfb + (hq * 2 + 0) * 128 + lb + 4);
            const f32x4 wb0 = *(const LAS f32x4*)(wfb + (hq * 2 + 1) * 128 + lb), wb1 = *(const LAS f32x4*)(wfb + (hq * 2 + 1) * 128 + lb + 4);
            float xv[8];
#pragma unroll
            for (int j = 0; j < 8; ++j) xv[j] = bf2f((u16)xr[j]);
            u32x4 qf, qb;
            qf.x = cvt_pk_bf16(xv[0] * wf0[0], xv[1] * wf0[1]); qf.y = cvt_pk_bf16(xv[2] * wf0[2], xv[3] * wf0[3]); qf.z = cvt_pk_bf16(xv[4] * wf1[0], xv[5] * wf1[1]); qf.w = cvt_pk_bf16(xv[6] * wf1[2], xv[7] * wf1[3]);
            qb.x = cvt_pk_bf16(xv[0] * wb0[0], xv[1] * wb0[1]); qb.y = cvt_pk_bf16(xv[2] * wb0[2], xv[3] * wb0[3]); qb.z = cvt_pk_bf16(xv[4] * wb1[0], xv[5] * wb1[1]); qb.w = cvt_pk_bf16(xv[6] * wb1[2], xv[7] * wb1[3]);
            const bf16x8 xf = __builtin_bit_cast(bf16x8, qf), xb = __builtin_bit_cast(bf16x8, qb);
#pragma unroll
            for (int nb = 0; nb < 4; ++nb) { const bf16x8 bfr = *(const LAS bf16x8*)(BT + (32 * nb + r) * 136 + lb);
                acc[0][nb] = MFMA32(bfr, xf, acc[0][nb]); acc[1][nb] = MFMA32(bfr, xb, acc[1][nb]); }
        }
#pragma unroll
        for (int d = 0; d < 2; ++d) { const int j = d ? jb : jf;
            if (j <= 16) { u16* sp = ST + ((size_t)((b * 2 + d) * 17 + j) * 16 + h) * 8192 + ((pb * 4) * 64 + lane) * 16;
#pragma unroll
                for (int nb = 0; nb < 4; ++nb) { u32x4 q0, q1;
                    q0.x = cvt_pk_bf16(acc[d][nb][0], acc[d][nb][1]); q0.y = cvt_pk_bf16(acc[d][nb][2], acc[d][nb][3]); q0.z = cvt_pk_bf16(acc[d][nb][4], acc[d][nb][5]); q0.w = cvt_pk_bf16(acc[d][nb][6], acc[d][nb][7]);
                    q1.x = cvt_pk_bf16(acc[d][nb][8], acc[d][nb][9]); q1.y = cvt_pk_bf16(acc[d][nb][10], acc[d][nb][11]); q1.z = cvt_pk_bf16(acc[d][nb][12], acc[d][nb][13]); q1.w = cvt_pk_bf16(acc[d][nb][14], acc[d][nb][15]);
                    *(u32x4*)(sp + nb * 1024) = q0; *(u32x4*)(sp + nb * 1024 + 8) = q1; } } }
        __syncthreads();
    }
}

__device__ __forceinline__ void phase_s2(const Params& P) {
    u16* ST = (u16*)(P.ws + OFF_ST); const float* CDEC = (const float*)(P.ws + OFF_CDEC);
    const int nth = gridDim.x * 512;
    for (int v = blockIdx.x * 512 + tid_fresh(); v < 32 * 2 * 16 * 1024; v += nth) {
        const int pn = (v & 1023) * 8, h = (v >> 10) & 15, bd = v >> 14;
        float hs[8];
#pragma unroll
        for (int j = 0; j < 8; ++j) hs[j] = 0.f;
        u16* base = ST + ((size_t)(bd * 17) * 16 + h) * 8192 + pn;
        u32x4 q[17]; float dec[17];
#pragma unroll
        for (int s = 0; s < 17; ++s) { q[s] = *(const u32x4*)(base + (size_t)s * 16 * 8192); dec[s] = CDEC[(bd * 18 + s) * 16 + h]; }
#pragma unroll
        for (int s = 0; s < 17; ++s) {
            const float d = dec[s];
            hs[0] = hs[0] * d + lo_f(q[s].x); hs[1] = hs[1] * d + hi_f(q[s].x); hs[2] = hs[2] * d + lo_f(q[s].y); hs[3] = hs[3] * d + hi_f(q[s].y);
            hs[4] = hs[4] * d + lo_f(q[s].z); hs[5] = hs[5] * d + hi_f(q[s].z); hs[6] = hs[6] * d + lo_f(q[s].w); hs[7] = hs[7] * d + hi_f(q[s].w);
            u32x4 o; o.x = cvt_pk_bf16(hs[0], hs[1]); o.y = cvt_pk_bf16(hs[2], hs[3]); o.z = cvt_pk_bf16(hs[4], hs[5]); o.w = cvt_pk_bf16(hs[6], hs[7]);
            *(u32x4*)(base + (size_t)s * 16 * 8192) = o;
        }
    }
}

__device__ __forceinline__ void s3_item(const Params& P, LAS unsigned char* lds, int item) {
    const int tid = tid_fresh(), w = tid >> 6, lane = tid & 63, r = lane & 31, hf = lane >> 5;
    const int g = item & 1, c = (item >> 1) & 15, b = item >> 5;
    const int seq0 = b * 2048, seq1 = seq0 + 2048, row0 = seq0 + 128 * c;
    LAS u16* Cs = (LAS u16*)lds;
    LAS u16* Gs = (LAS u16*)(lds + 34816);
    LAS u16* XT = (LAS u16*)(lds + 69632);
    LAS u16* Bs = XT;
    LAS float* ar = (LAS float*)(lds + 139264);
    LAS float* ssq = (LAS float*)(lds + 147456);
    const u16* XBC = (const u16*)(P.ws + OFF_XBC); const u16* ST = (const u16*)(P.ws + OFF_ST); u16* Yg = (u16*)(P.ws + OFF_Y);
    const float *CSF = (const float*)(P.ws + OFF_CSF), *CSB = (const float*)(P.ws + OFF_CSB), *DTF = (const float*)(P.ws + OFF_DTF), *DTB = (const float*)(P.ws + OFF_DTB);
    stage_conv<128>(Cs, 136, XBC, row0, seq0, seq1, 1280 + 128 * g, P.scw, P.scb);
    stage_conv<128>(Bs, 136, XBC, row0, seq0, seq1, 1024 + 128 * g, P.scw, P.scb);
    if (tid < 128) ssq[tid] = 0.f;
    __syncthreads();
    {
        const int wr2 = w >> 1, wc2 = w & 1;
        f32x16 g0, g1;
#pragma unroll
        for (int i = 0; i < 16; ++i) { g0[i] = 0.f; g1[i] = 0.f; }
#pragma unroll 2
        for (int ks = 0; ks < 8; ++ks) {
            const bf16x8 a = *(const LAS bf16x8*)(Cs + (32 * wr2 + r) * 136 + 16 * ks + 8 * hf);
            const bf16x8 b0 = *(const LAS bf16x8*)(Bs + (64 * wc2 + r) * 136 + 16 * ks + 8 * hf);
            const bf16x8 b1 = *(const LAS bf16x8*)(Bs + (64 * wc2 + 32 + r) * 136 + 16 * ks + 8 * hf);
            g0 = MFMA32(a, b0, g0); g1 = MFMA32(a, b1, g1);
        }
#pragma unroll
        for (int i = 0; i < 16; ++i) { const int l = 32 * wr2 + (i & 3) + 8 * (i >> 2) + 4 * hf;
            Gs[l * 136 + 64 * wc2 + r] = f2bf(g0[i]); Gs[l * 136 + 64 * wc2 + 32 + r] = f2bf(g1[i]); }
    }
    __syncthreads();
    const int hq = w >> 1, rbh = w & 1;
    for (int pass = 0; pass < 2; ++pass) {
        const int h0 = 8 * g + 4 * pass, h = h0 + hq;
        stage_conv_t<256>(XT, 136, XBC, row0, seq0, seq1, 64 * h0, P.scw, P.scb);
#pragma unroll
        for (int e = 0; e < 4; ++e) { const int idx = tid + 512 * e, hh = idx >> 9, which = (idx >> 7) & 3, l = idx & 127;
            const float* srcp = (which == 0) ? CSF : (which == 1) ? CSB : (which == 2) ? DTF : DTB; ar[(hh * 4 + which) * 128 + l] = srcp[(size_t)(row0 + l) * 16 + h0 + hh]; }
        const u16* stf = ST + ((size_t)((b * 2 + 0) * 17 + (c + 1)) * 16 + h) * 8192 + lane * 16;
        const u16* stb = ST + ((size_t)((b * 2 + 1) * 17 + (16 - c)) * 16 + h) * 8192 + lane * 16;
        u32x4 hfr[2][2][2][2];
#pragma unroll
        for (int cb = 0; cb < 2; ++cb)
#pragma unroll
            for (int nl = 0; nl < 2; ++nl)
#pragma unroll
                for (int sx = 0; sx < 2; ++sx) { const int off = ((cb * 4 + nl) * 64) * 16 + 8 * sx; hfr[0][cb][nl][sx] = *(const u32x4*)(stf + off); hfr[1][cb][nl][sx] = *(const u32x4*)(stb + off); }
        __syncthreads();
        LAS float* A = ar + hq * 512;
        f32x16 acc[2][2];
#pragma unroll
        for (int a = 0; a < 2; ++a)
#pragma unroll
            for (int cb = 0; cb < 2; ++cb)
#pragma unroll
                for (int i = 0; i < 16; ++i) acc[a][cb][i] = 0.f;
        const int l0 = 64 * rbh + r, l1 = l0 + 32;
        const float csf0 = A[l0], csb0 = A[128 + l0], dg0 = A[256 + l0] + A[384 + l0], csf1 = A[l1], csb1 = A[128 + l1], dg1 = A[256 + l1] + A[384 + l1];
        const float ef0 = __expf(csf0), eb0 = __expf(csb0), ef1 = __expf(csf1), eb1 = __expf(csb1), dsk = P.ssm_d[h];
#define S3_OFF(NBH) do { _Pragma("unroll") for (int nl = 0; nl < 2; ++nl) _Pragma("unroll") for (int sx = 0; sx < 2; ++sx) { const int no = 32 * (2 * (NBH) + nl) + 16 * sx + 4 * hf; \
            _Pragma("unroll") for (int rb2 = 0; rb2 < 2; ++rb2) { const int l = rb2 ? l1 : l0; const float ef = rb2 ? ef1 : ef0, eb = rb2 ? eb1 : eb0; \
                const u32x2 clo = *(const LAS u32x2*)(Cs + l * 136 + no), chi = *(const LAS u32x2*)(Cs + l * 136 + no + 8); \
                const float c0 = lo_f(clo.x), c1 = hi_f(clo.x), c2 = lo_f(clo.y), c3 = hi_f(clo.y), c4 = lo_f(chi.x), c5 = hi_f(chi.x), c6 = lo_f(chi.y), c7 = hi_f(chi.y); \
                u32x4 qf, qb; qf.x = cvt_pk_bf16(c0 * ef, c1 * ef); qf.y = cvt_pk_bf16(c2 * ef, c3 * ef); qf.z = cvt_pk_bf16(c4 * ef, c5 * ef); qf.w = cvt_pk_bf16(c6 * ef, c7 * ef); \
                qb.x = cvt_pk_bf16(c0 * eb, c1 * eb); qb.y = cvt_pk_bf16(c2 * eb, c3 * eb); qb.z = cvt_pk_bf16(c4 * eb, c5 * eb); qb.w = cvt_pk_bf16(c6 * eb, c7 * eb); \
                const bf16x8 af = __builtin_bit_cast(bf16x8, qf), ab = __builtin_bit_cast(bf16x8, qb); \
                _Pragma("unroll") for (int cb = 0; cb < 2; ++cb) { acc[rb2][cb] = MFMA32(af, __builtin_bit_cast(bf16x8, hfr[0][cb][nl][sx]), acc[rb2][cb]); \
                    acc[rb2][cb] = MFMA32(ab, __builtin_bit_cast(bf16x8, hfr[1][cb][nl][sx]), acc[rb2][cb]); } } } } while (0)
        S3_OFF(0);
#pragma unroll
        for (int cb = 0; cb < 2; ++cb)
#pragma unroll
            for (int nl = 0; nl < 2; ++nl)
#pragma unroll
                for (int sx = 0; sx < 2; ++sx) { const int off = ((cb * 4 + 2 + nl) * 64) * 16 + 8 * sx; hfr[0][cb][nl][sx] = *(const u32x4*)(stf + off); hfr[1][cb][nl][sx] = *(const u32x4*)(stb + off); }
#pragma unroll 1
        for (int ks = 0; ks < 8; ++ks) {
            const int sb = 16 * ks + 8 * hf;
            const bf16x8 x0 = *(const LAS bf16x8*)(XT + (hq * 64 + r) * 136 + sb), x1 = *(const LAS bf16x8*)(XT + (hq * 64 + 32 + r) * 136 + sb);
            float cfs[8], cbs[8], dfs[8], dbs[8];
#pragma unroll
            for (int q = 0; q < 2; ++q) { const f32x4 t0 = *(const LAS f32x4*)(A + sb + 4 * q), t1 = *(const LAS f32x4*)(A + 128 + sb + 4 * q), t2 = *(const LAS f32x4*)(A + 256 + sb + 4 * q), t3 = *(const LAS f32x4*)(A + 384 + sb + 4 * q);
#pragma unroll
                for (int j = 0; j < 4; ++j) { cfs[4 * q + j] = t0[j]; cbs[4 * q + j] = t1[j]; dfs[4 * q + j] = t2[j]; dbs[4 * q + j] = t3[j]; } }
#pragma unroll
            for (int rb2 = 0; rb2 < 2; ++rb2) { const int l = rb2 ? l1 : l0; const float csf_l = rb2 ? csf1 : csf0, csb_l = rb2 ? csb1 : csb0, dg = rb2 ? dg1 : dg0;
                const bf16x8 gv = *(const LAS bf16x8*)(Gs + l * 136 + sb); float o[8];
#pragma unroll
                for (int j = 0; j < 8; ++j) { const int ss = sb + j; float f;
                    if (ss < l) f = __expf(csf_l - cfs[j]) * dfs[j]; else if (ss > l) f = __expf(csb_l - cbs[j]) * dbs[j]; else f = dg;
                    o[j] = bf2f((u16)gv[j]) * f + ((ss == l) ? dsk : 0.f); }
                u32x4 q; q.x = cvt_pk_bf16(o[0], o[1]); q.y = cvt_pk_bf16(o[2], o[3]); q.z = cvt_pk_bf16(o[4], o[5]); q.w = cvt_pk_bf16(o[6], o[7]);
                const bf16x8 am = __builtin_bit_cast(bf16x8, q);
                acc[rb2][0] = MFMA32(am, x0, acc[rb2][0]); acc[rb2][1] = MFMA32(am, x1, acc[rb2][1]); }
        }
        S3_OFF(1);
#undef S3_OFF
        __syncthreads();
#pragma unroll
        for (int rb2 = 0; rb2 < 2; ++rb2)
#pragma unroll
            for (int cb = 0; cb < 2; ++cb)
#pragma unroll
                for (int i = 0; i < 16; ++i) XT[(64 * rbh + 32 * rb2 + 8 * (i >> 2) + 4 * hf + (i & 3)) * 264 + hq * 64 + 32 * cb + r] = f2bf(acc[rb2][cb][i]);
        __syncthreads();
        {
            const int t2 = tid_fresh();
            u16* yb = Yg + (size_t)row0 * 2048 + 64 * h0 + (t2 & 31) * 8;
            u32x4 zv[8];
#pragma unroll
            for (int e = 0; e < 8; ++e) zv[e] = *(const u32x4*)(yb + (size_t)((t2 >> 5) + 16 * e) * 2048);
#pragma unroll
            for (int e = 0; e < 8; ++e) { const int l = (t2 >> 5) + 16 * e; const u32x4 yv = *(const LAS u32x4*)(XT + l * 264 + (t2 & 31) * 8); const u32x4 z = zv[e];
                float v[8] = {lo_f(yv.x) * silu_f(lo_f(z.x)), hi_f(yv.x) * silu_f(hi_f(z.x)), lo_f(yv.y) * silu_f(lo_f(z.y)), hi_f(yv.y) * silu_f(hi_f(z.y)),
                              lo_f(yv.z) * silu_f(lo_f(z.z)), hi_f(yv.z) * silu_f(hi_f(z.z)), lo_f(yv.w) * silu_f(lo_f(z.w)), hi_f(yv.w) * silu_f(hi_f(z.w))};
                float sv = 0.f;
#pragma unroll
                for (int j = 0; j < 8; ++j) sv += v[j] * v[j];
#pragma unroll
                for (int o = 16; o >= 1; o >>= 1) sv += __shfl_xor(sv, o);
                if ((t2 & 31) == 0) atomicAdd((float*)(ssq + l), sv);
                u32x4 q; q.x = cvt_pk_bf16(v[0], v[1]); q.y = cvt_pk_bf16(v[2], v[3]); q.z = cvt_pk_bf16(v[4], v[5]); q.w = cvt_pk_bf16(v[6], v[7]);
                *(u32x4*)(yb + (size_t)l * 2048) = q; }
        }
        __syncthreads();
    }
    {
        const int c8 = (tid & 63) * 8;
        const f32x4 w0 = *(const f32x4*)(P.ssm_nw + 512 * g + c8), w1 = *(const f32x4*)(P.ssm_nw + 512 * g + c8 + 4);
        u16* ybase = Yg + (size_t)(row0 + (tid >> 6)) * 2048 + 512 * g + c8;
#pragma unroll
        for (int hb = 0; hb < 2; ++hb) {
            u32x4 qv[8];
#pragma unroll
            for (int i = 0; i < 8; ++i) qv[i] = *(const u32x4*)(ybase + (size_t)(hb * 8 + i) * 8 * 2048);
#pragma unroll
            for (int i = 0; i < 8; ++i) { const int l = (tid >> 6) + 8 * (hb * 8 + i);
                const float rstd = rsqrtf(ssq[l] * (1.0f / 512.0f) + EPSF); const u32x4 q = qv[i];
                u32x4 o; o.x = cvt_pk_bf16(lo_f(q.x) * rstd * w0[0], hi_f(q.x) * rstd * w0[1]); o.y = cvt_pk_bf16(lo_f(q.y) * rstd * w0[2], hi_f(q.y) * rstd * w0[3]);
                o.z = cvt_pk_bf16(lo_f(q.z) * rstd * w1[0], hi_f(q.z) * rstd * w1[1]); o.w = cvt_pk_bf16(lo_f(q.w) * rstd * w1[2], hi_f(q.w) * rstd * w1[3]);
                *(u32x4*)(ybase + (size_t)(hb * 8 + i) * 8 * 2048) = o; }
        }
    }
    __syncthreads();
}

__device__ __forceinline__ void phase_lnb(const Params& P) {
    const int lane = tid_fresh() & 63, gw = blockIdx.x * 8 + (tid_fresh() >> 6), nwv = gridDim.x * 8;
    u16* Yg = (u16*)(P.ws + OFF_Y);
    for (int row = gw; row < TX; row += nwv) {
        u16* p = Yg + (size_t)row * 2048 + 1024 + lane * 8;
        const u32x4 q0 = *(const u32x4*)p, q1 = *(const u32x4*)(p + 512);
        float v[16] = {lo_f(q0.x), hi_f(q0.x), lo_f(q0.y), hi_f(q0.y), lo_f(q0.z), hi_f(q0.z), lo_f(q0.w), hi_f(q0.w), lo_f(q1.x), hi_f(q1.x), lo_f(q1.y), hi_f(q1.y), lo_f(q1.z), hi_f(q1.z), lo_f(q1.w), hi_f(q1.w)};
        float s = 0.f;
#pragma unroll
        for (int j = 0; j < 16; ++j) s += v[j];
        const float mu = wave_sum(s) * (1.0f / 1024.0f);
        float q = 0.f;
#pragma unroll
        for (int j = 0; j < 16; ++j) { v[j] -= mu; q += v[j] * v[j]; }
        const float rstd = rsqrtf(wave_sum(q) * (1.0f / 1024.0f) + EPSF);
        float o[16];
#pragma unroll
        for (int j = 0; j < 16; ++j) { const int col = (j < 8) ? (lane * 8 + j) : (512 + lane * 8 + j - 8); o[j] = silu_f(v[j] * rstd * P.lnw[col] + P.lnb[col]); }
        u32x4 a, bq; a.x = cvt_pk_bf16(o[0], o[1]); a.y = cvt_pk_bf16(o[2], o[3]); a.z = cvt_pk_bf16(o[4], o[5]); a.w = cvt_pk_bf16(o[6], o[7]);
        bq.x = cvt_pk_bf16(o[8], o[9]); bq.y = cvt_pk_bf16(o[10], o[11]); bq.z = cvt_pk_bf16(o[12], o[13]); bq.w = cvt_pk_bf16(o[14], o[15]);
        *(u32x4*)p = a; *(u32x4*)(p + 512) = bq;
    }
}

template <int PH> __device__ __forceinline__ void run_phase(const Params& P, LAS unsigned char* lds) {
    unsigned char* ws = P.ws;
    const float* MOD = (const float*)(ws + OFF_MOD);
    if constexpr (PH == 0) phase_prep(P, lds);
    if constexpr (PH == 1) phase_norm<0>(P, P.x, P.ctx, TT, P.norm_ffn1, 0, 1, (u16*)(ws + OFF_H), nullptr);
    if constexpr (PH == 2) { Gemm gm{(const bf16_t*)(ws + OFF_H), (const bf16_t*)(ws + OFF_WGU1), TT, NGU, 1024}; StaticOrder S; S.init(TT, NGU, (int)gridDim.x, (int)blockIdx.x);
        EpiSwiGLU E{(bf16_t*)(ws + OFF_ACT)}; gemm_phase<EpiSwiGLU, StaticOrder, false>(lds, gm, S, E, nullptr); }
    if constexpr (PH == 3) { Gemm gm{(const bf16_t*)(ws + OFF_ACT), (const bf16_t*)(ws + OFF_WD1), TT, 1024, DFF}; StaticOrder S; S.init(TT, 1024, (int)gridDim.x, (int)blockIdx.x);
        EpiResid E{P.x, P.out, P.ctx, (float*)(ws + OFF_XC1), MOD + 2 * 1024, 0.5f}; gemm_phase<EpiResid, StaticOrder, false>(lds, gm, S, E, nullptr); }
    if constexpr (PH == 4) phase_norm<0>(P, P.out, (const float*)(ws + OFF_XC1), TT, P.norm_mix, 3, 4, (u16*)(ws + OFF_H), nullptr);
    if constexpr (PH == 5) { Gemm gm{(const bf16_t*)(ws + OFF_H), (const bf16_t*)(ws + OFF_WIN), TX, NIN, 1024}; InOrder S; S.init(TX, NIN, (int)gridDim.x, (int)blockIdx.x);
        EpiInProj E{(bf16_t*)(ws + OFF_XBC), (float*)(ws + OFF_DT), (bf16_t*)(ws + OFF_Y), (bf16_t*)(ws + OFF_U)}; gemm_phase<EpiInProj, InOrder, false>(lds, gm, S, E, nullptr); }
    if constexpr (PH == 6) phase_p6(P, lds);
    if constexpr (PH == 7) { for (int it = blockIdx.x; it < 1152; it += gridDim.x) s1_item(P, lds, it); }
    if constexpr (PH == 8) phase_s2(P);
    if constexpr (PH == 9) { for (int it = blockIdx.x; it < 1024; it += gridDim.x) s3_item(P, lds, it); phase_lnb(P); }
    if constexpr (PH == 10) { Gemm gm{(const bf16_t*)(ws + OFF_Y), (const bf16_t*)(ws + OFF_WOUT), TX, 1024, 2048}; StaticOrder S; S.init(TX, 1024, (int)gridDim.x, (int)blockIdx.x);
        EpiResid E{P.out, P.out, nullptr, nullptr, MOD + 5 * 1024, 1.0f}; gemm_phase<EpiResid, StaticOrder, false>(lds, gm, S, E, nullptr); }
    if constexpr (PH == 11) phase_norm<0>(P, P.out, nullptr, TX, P.norm_ffn2, 6, 7, (u16*)(ws + OFF_H), nullptr);
    if constexpr (PH == 12) { Gemm gm{(const bf16_t*)(ws + OFF_H), (const bf16_t*)(ws + OFF_WGU2), TX, NGU, 1024}; StaticOrder S; S.init(TX, NGU, (int)gridDim.x, (int)blockIdx.x);
        EpiSwiGLU E{(bf16_t*)(ws + OFF_ACT)}; gemm_phase<EpiSwiGLU, StaticOrder, false>(lds, gm, S, E, nullptr); }
    if constexpr (PH == 13) { Gemm gm{(const bf16_t*)(ws + OFF_ACT), (const bf16_t*)(ws + OFF_WD2), TX, 1024, DFF}; StaticOrder S; S.init(TX, 1024, (int)gridDim.x, (int)blockIdx.x);
        EpiResid E{P.out, P.out, nullptr, nullptr, MOD + 8 * 1024, 0.5f}; gemm_phase<EpiResid, StaticOrder, false>(lds, gm, S, E, nullptr); }
    if constexpr (PH == 14) phase_norm<1>(P, P.out, nullptr, TX, P.fnorm, 0, 0, nullptr, P.out);
}

template <int PH> __global__ void __launch_bounds__(512, 2) k_one(Params P) {
    extern __shared__ __attribute__((aligned(16))) unsigned char shm[];
    run_phase<PH>(P, (LAS unsigned char*)shm);
}

__device__ __forceinline__ void grid_bar(unsigned* ctr, unsigned target) {
    __syncthreads();
    if (tid_fresh() == 0) {
        __builtin_amdgcn_fence(__ATOMIC_RELEASE, "agent");
        __hip_atomic_fetch_add(ctr, 1u, __ATOMIC_RELAXED, __HIP_MEMORY_SCOPE_AGENT);
        unsigned v;
        do { __builtin_amdgcn_s_sleep(1); v = __hip_atomic_load(ctr, __ATOMIC_RELAXED, __HIP_MEMORY_SCOPE_AGENT); asm volatile("" : "+v"(v)); } while (v < target);
        __builtin_amdgcn_fence(__ATOMIC_ACQUIRE, "agent");
    }
    __syncthreads();
}
template <int PH> __device__ __forceinline__ void run_all(const Params& P, LAS unsigned char* lds, cg::grid_group& grid) {
    unsigned* ctr = (unsigned*)(P.ws + OFF_BAR);
    if constexpr (PH == 0) { if (blockIdx.x == 0 && threadIdx.x == 0) __hip_atomic_store(ctr, 0u, __ATOMIC_RELAXED, __HIP_MEMORY_SCOPE_AGENT); }
    run_phase<PH>(P, lds);
    if constexpr (PH + 1 < NPHASE) {
        if constexpr (PH == 0) grid.sync(); else grid_bar(ctr, (unsigned)PH * gridDim.x);
        run_all<PH + 1>(P, lds, grid);
    }
}
__global__ void __launch_bounds__(512, 2) mega(Params P) {
    extern __shared__ __attribute__((aligned(16))) unsigned char shm[];
    cg::grid_group grid = cg::this_grid();
    run_all<0>(P, (LAS unsigned char*)shm, grid);
}

template <int PH> static void launch_each(int grid, hipStream_t stream, const Params& p) {
    static bool attr = false; if (!attr) { (void)hipFuncSetAttribute((const void*)k_one<PH>, hipFuncAttributeMaxDynamicSharedMemorySize, LDS_BYTES); attr = true; }
    hipLaunchKernelGGL(k_one<PH>, dim3(grid), dim3(512), LDS_BYTES, stream, p);
    if constexpr (PH + 1 < NPHASE) launch_each<PH + 1>(grid, stream, p);
}

#ifndef MK_MULTI
#define MK_MULTI 0
#endif
extern "C" void kernel_launch(void* const* d_in, const int* in_sizes, int n_in, void* d_out, int out_size, void* d_ws, size_t ws_size, hipStream_t stream) {
    static int grid = 0;
    if (grid == 0) {
        if (n_in != 30 || ws_size < WS_TOTAL) { fprintf(stderr, "kernel_launch: expected 30 inputs and >= %zu bytes of workspace (got %d, %zu)\n", (size_t)WS_TOTAL, n_in, ws_size); grid = -1; return; }
        int dev = 0, cus = 0, per_cu = 0;
        (void)hipGetDevice(&dev); (void)hipDeviceGetAttribute(&cus, hipDeviceAttributeMultiprocessorCount, dev);
        if (hipFuncSetAttribute((const void*)mega, hipFuncAttributeMaxDynamicSharedMemorySize, LDS_BYTES) != hipSuccess) { fprintf(stderr, "kernel_launch: hipFuncSetAttribute failed\n"); }
        if (hipOccupancyMaxActiveBlocksPerMultiprocessor(&per_cu, (const void*)mega, 512, LDS_BYTES) != hipSuccess || per_cu < 1) { fprintf(stderr, "kernel_launch: occupancy query says %d\n", per_cu); per_cu = 1; }
        (void)hipGetLastError();
        grid = cus * per_cu;
    }
    if (grid < 0) return;
    Params p{};
    const float** pp = (const float**)&p;
    for (int i = 0; i < 30; ++i) pp[i] = (const float*)d_in[i];
    p.out = (float*)d_out; p.ws = (unsigned char*)d_ws;
#if MK_MULTI
    launch_each<0>(grid, stream, p);
#else
    void* args[] = {&p};
    hipError_t e = hipLaunchCooperativeKernel((const void*)mega, dim3(grid), dim3(512), args, LDS_BYTES, stream);
    if (e != hipSuccess) fprintf(stderr, "kernel_launch: cooperative launch failed: %s (grid %d)\n", hipGetErrorString(e), grid);
#endif
}
```

```cpp
#include <hip/hip_runtime.h>
#include <hip/hip_cooperative_groups.h>
#include <cstdio>
namespace cg = cooperative_groups;
__device__ __forceinline__ int tid_fresh() { int t = (int)threadIdx.x; asm volatile("" : "+v"(t)); return t; }
namespace pg8 {
#define PG8_LAS __attribute__((address_space(3)))
typedef unsigned short bf16_t;
typedef short bf16x8 __attribute__((ext_vector_type(8)));
typedef float f32x4 __attribute__((ext_vector_type(4)));
typedef unsigned u32x4 __attribute__((ext_vector_type(4)));
constexpr int BM = 256, BK = 64, HALF = 128, HTB = HALF * BK * 2  , STAGE_BYTES = 8 * HTB, NXCD = 8, WGM = 8;

__host__ __device__ __forceinline__ int lds_byte(int r, int c) { const int st = (r >> 4) * 2 + (c >> 5), rr = r & 15, cc = c & 31, ob = rr * 64 + cc * 2; return st * 1024 + (ob ^ (((ob >> 9) & 1) << 5)); }
__host__ __device__ __forceinline__ void stage_rc(int b, int& R, int& C) { const int st = b / 1024, sb = b % 1024, swz = sb ^ (((sb >> 9) & 1) << 5); R = (st >> 1) * 16 + swz / 64; C = (st & 1) * 32 + (swz % 64) / 2; }
__host__ __device__ __forceinline__ int perm32(int rho) { const int n = rho >> 4, i = rho & 15; return 8 * (i >> 2) + 4 * n + (i & 3); }

struct Unit { int pm, pn; };
struct Gemm { const bf16_t* A; const bf16_t* Bt; int M, N, K; };

struct StaticOrder {
    int nM, nN, nwg, G, c;
    __host__ __device__ void init(int M, int N, int G_, int c_) { nM = M / BM; nN = N / BM; nwg = nM * nN; G = G_; c = c_; }
    __host__ __device__ bool next(int i, Unit& u) const {
        const long L = (long)i * G + c; if (L >= nwg) return false;
        int wgid = (int)L; { const int q = nwg / NXCD, r = nwg % NXCD, xcd = wgid % NXCD, off = wgid / NXCD; wgid = (xcd < r ? xcd * (q + 1) : r * (q + 1) + (xcd - r) * q) + off; }
        const int nig = WGM * nN, gid = wgid / nig, fm = gid * WGM, gsz = (nM - fm) < WGM ? (nM - fm) : WGM;
        u.pm = fm + ((wgid % nig) % gsz); u.pn = (wgid % nig) / gsz; return true;
    }
    __device__ __forceinline__ void a_ready(const Unit&) const {}
    __device__ __forceinline__ void done(const Unit&) const {}
};
__device__ __forceinline__ unsigned cvt_pk_bf16(float lo, float hi) { unsigned r; asm volatile("v_cvt_pk_bf16_f32 %0, %1, %2" : "=v"(r) : "v"(lo), "v"(hi)); return r; }
typedef float f32x2 __attribute__((ext_vector_type(2)));
template <class Epi, class Sched, bool STAMP = false>
__device__ __forceinline__ void gemm_phase(PG8_LAS unsigned char* lds, const Gemm g, const Sched& S, const Epi& E, unsigned long long* stamps) {
    const int tid = tid_fresh(), wid = __builtin_amdgcn_readfirstlane(tid >> 6), lane = tid & 63, wr = wid >> 2, wc = wid & 3, fr = lane & 15, fq = lane >> 4;
    const int K = g.K, nt = K / BK;
    int ts_lo = 0, ts_hi = 0, nts = 0; const unsigned long long rt_entry = STAMP ? (unsigned long long)wall_clock64() : 0ull;
#define PG8_STAMP() do { if (STAMP && wid == 0 && nts < 64) { const unsigned long long _c = (unsigned long long)clock64(); \
        ts_lo = (lane == nts) ? (int)(unsigned)_c : ts_lo; ts_hi = (lane == nts) ? (int)(unsigned)(_c >> 32) : ts_hi; ++nts; } } while (0)
    PG8_STAMP();
    unsigned voffA[2], voffB[2];
#pragma unroll
    for (int i = 0; i < 2; ++i) { int R, C; stage_rc(tid * 16 + i * 8192, R, C); const int Rb = Epi::PERM ? ((R & ~31) + perm32(R & 31)) : R;
        voffA[i] = (unsigned)(R * K + C) * 2u; voffB[i] = (unsigned)(Rb * K + C) * 2u; }
    const size_t kstep = (size_t)(BK * 2);
    const size_t hstep = (size_t)HALF * K * 2;
    const size_t tstep = 2 * hstep;
    const unsigned ldsw = (unsigned)wid * 1024u;
    const int aoff = lds_byte(wr * 64 + fr, fq * 8), boff = lds_byte(wc * 32 + fr, fq * 8);
#define PG8_SA(b, h) (((b) * 2 + (h)) * HTB)
#define PG8_SB(b, h) ((4 + (b) * 2 + (h)) * HTB)
#define PG8_STAGE(bufoff, gbase, voff) do { _Pragma("unroll") for (int _i = 0; _i < 2; ++_i) \
        __builtin_amdgcn_global_load_lds((const unsigned*)((const char*)(gbase) + (voff)[_i]), (PG8_LAS unsigned*)(lds + (bufoff) + ldsw + _i * 8192), 16, 0, 0); } while (0)
#define PG8_LDA(dst, b, h) do { _Pragma("unroll") for (int m = 0; m < 4; ++m) _Pragma("unroll") for (int k = 0; k < 2; ++k) dst[m][k] = *(const PG8_LAS bf16x8*)(lds + PG8_SA(b, h) + aoff + m * 2048 + k * 1024); } while (0)
#define PG8_LDB(dst, b, h) do { _Pragma("unroll") for (int n = 0; n < 2; ++n) _Pragma("unroll") for (int k = 0; k < 2; ++k) dst[n][k] = *(const PG8_LAS bf16x8*)(lds + PG8_SB(b, h) + boff + n * 2048 + k * 1024); } while (0)
#define PG8_MMA(ai, bj, At, Bt) do { __builtin_amdgcn_s_setprio(1); _Pragma("unroll") for (int m = 0; m < 4; ++m) _Pragma("unroll") for (int n = 0; n < 2; ++n) _Pragma("unroll") for (int k = 0; k < 2; ++k) \
        acc[ai][bj][m][n] = __builtin_amdgcn_mfma_f32_16x16x32_bf16(Bt[n][k], At[m][k], acc[ai][bj][m][n], 0, 0, 0); __builtin_amdgcn_s_setprio(0); } while (0)
#define PG8_WAIT_V(n) asm volatile("s_waitcnt vmcnt(" #n ")" ::: "memory")
#define PG8_WAIT_L(n) asm volatile("s_waitcnt lgkmcnt(" #n ")" ::: "memory")
#define PG8_BAR __builtin_amdgcn_s_barrier()
#define PG8_SCHED __builtin_amdgcn_sched_barrier(0)
    Unit cur, nxt; int ui = 0;
    if (!S.next(0, cur)) return;
    f32x4 acc[2][2][4][2];
#pragma unroll
    for (int a = 0; a < 2; ++a)
#pragma unroll
        for (int b = 0; b < 2; ++b)
#pragma unroll
            for (int m = 0; m < 4; ++m)
#pragma unroll
                for (int n = 0; n < 2; ++n) acc[a][b][m][n] = (f32x4){0.f, 0.f, 0.f, 0.f};
    bf16x8 At[4][2], B0[2][2], B1[2][2];
    const char* cA = (const char*)g.A + (size_t)cur.pm * tstep; const char* cB = (const char*)g.Bt + (size_t)cur.pn * tstep;
    S.a_ready(cur);
    PG8_STAGE(PG8_SB(0, 0), cB, voffB); PG8_STAGE(PG8_SA(0, 0), cA, voffA); PG8_STAGE(PG8_SB(0, 1), cB + hstep, voffB); PG8_STAGE(PG8_SA(0, 1), cA + hstep, voffA);
    if (wr == 1) PG8_BAR;
    PG8_WAIT_V(4); PG8_BAR;
    PG8_STAGE(PG8_SB(1, 0), cB + kstep, voffB); PG8_STAGE(PG8_SA(1, 0), cA + kstep, voffA); PG8_STAGE(PG8_SB(1, 1), cB + hstep + kstep, voffB);
    PG8_WAIT_V(6); PG8_BAR;
    PG8_STAMP();
    for (;;) {
        const bool has_next = S.next(ui + 1, nxt);
        const char* nA = has_next ? (const char*)g.A + (size_t)nxt.pm * tstep : cA; const char* nB = has_next ? (const char*)g.Bt + (size_t)nxt.pn * tstep : cB;
        for (int t = 0; t < nt; t += 2) {
            const bool last = (t == nt - 2);
            const char* a1 = cA + (size_t)(t + 1) * kstep;
            const char* a2 = last ? nA : cA + (size_t)(t + 2) * kstep; const char* b2 = last ? nB : cB + (size_t)(t + 2) * kstep;
            const char* a3 = a2 + kstep; const char* b3 = b2 + kstep;
            if (last && has_next) S.a_ready(nxt);
            PG8_LDB(B0, 0, 0); PG8_SCHED; PG8_LDA(At, 0, 0); PG8_STAGE(PG8_SA(1, 1), a1 + hstep, voffA);
            PG8_WAIT_L(8); PG8_BAR; PG8_WAIT_L(0); PG8_MMA(0, 0, At, B0); PG8_BAR; PG8_SCHED;
            PG8_LDB(B1, 0, 1); PG8_STAGE(PG8_SB(0, 0), b2, voffB);
            PG8_BAR; PG8_WAIT_L(0); PG8_MMA(0, 1, At, B1); PG8_BAR;
            PG8_LDA(At, 0, 1); PG8_STAGE(PG8_SA(0, 0), a2, voffA);
            PG8_BAR; PG8_WAIT_L(0); PG8_MMA(1, 0, At, B0); PG8_BAR; PG8_SCHED;
            PG8_STAGE(PG8_SB(0, 1), b2 + hstep, voffB);
            PG8_WAIT_V(6); PG8_BAR; PG8_MMA(1, 1, At, B1); PG8_BAR;
            PG8_LDB(B0, 1, 0); PG8_SCHED; PG8_LDA(At, 1, 0); PG8_STAGE(PG8_SA(0, 1), a2 + hstep, voffA);
            PG8_WAIT_L(8); PG8_BAR; PG8_WAIT_L(0); PG8_MMA(0, 0, At, B0); PG8_BAR; PG8_SCHED;
            PG8_LDB(B1, 1, 1); PG8_STAGE(PG8_SB(1, 0), b3, voffB);
            PG8_BAR; PG8_WAIT_L(0); PG8_MMA(0, 1, At, B1); PG8_BAR;
            PG8_LDA(At, 1, 1); PG8_STAGE(PG8_SA(1, 0), a3, voffA);
            PG8_BAR; PG8_WAIT_L(0); PG8_MMA(1, 0, At, B0); PG8_BAR; PG8_SCHED;
            PG8_STAGE(PG8_SB(1, 1), b3 + hstep, voffB);
            PG8_WAIT_V(6); PG8_BAR; PG8_MMA(1, 1, At, B1); PG8_BAR;
        }
        PG8_STAMP();
        if constexpr (!Epi::AFTER_DRAIN) { E(acc, cur, wr, wc, fr, fq); S.done(cur); }
        PG8_STAMP();
        if (!has_next) break;
#pragma unroll
        for (int a = 0; a < 2; ++a)
#pragma unroll
            for (int b = 0; b < 2; ++b)
#pragma unroll
                for (int m = 0; m < 4; ++m)
#pragma unroll
                    for (int n = 0; n < 2; ++n) acc[a][b][m][n] = (f32x4){0.f, 0.f, 0.f, 0.f};
        cur = nxt; cA = nA; cB = nB; ++ui;
    }
    PG8_WAIT_V(0);
    if (wr == 0) PG8_BAR;
    PG8_BAR;
    if constexpr (Epi::AFTER_DRAIN) { E.fused(acc, cur, wr, wc, fr, fq, lds, wid, lane); S.done(cur); }
    PG8_STAMP();
    if (STAMP && wid == 0) { stamps[lane] = lane < nts ? (((unsigned long long)(unsigned)ts_hi << 32) | (unsigned)ts_lo) : 0ull;
        if (lane == 62) stamps[62] = rt_entry; if (lane == 63) stamps[63] = (unsigned long long)wall_clock64(); }
#undef PG8_STAMP
#undef PG8_SA
#undef PG8_SB
#undef PG8_STAGE
#undef PG8_LDA
#undef PG8_LDB
#undef PG8_MMA
#undef PG8_WAIT_V
#undef PG8_WAIT_L
#undef PG8_BAR
#undef PG8_SCHED
}
}
using namespace pg8;
#define LAS __attribute__((address_space(3)))
typedef unsigned short u16;
typedef unsigned int u32;
typedef float f32x16 __attribute__((ext_vector_type(16)));
typedef unsigned int u32x2 __attribute__((ext_vector_type(2)));

constexpr int TX = 65536, TCX = 8192, TT = 73728;
constexpr int DFF = 2816, NGU = 5632, NIN = 4864;
constexpr float EPSF = 1e-6f;
constexpr int LDS_BYTES = 160768;
constexpr int NPHASE = 15;

constexpr size_t SZ_WGU = (size_t)NGU * 1024 * 2, SZ_WD = (size_t)1024 * DFF * 2, SZ_WIN = (size_t)NIN * 1024 * 2, SZ_WOUT = (size_t)1024 * 2048 * 2;
constexpr size_t OFF_WGU1 = 0, OFF_WD1 = OFF_WGU1 + SZ_WGU, OFF_WGU2 = OFF_WD1 + SZ_WD, OFF_WD2 = OFF_WGU2 + SZ_WGU, OFF_WIN = OFF_WD2 + SZ_WD, OFF_WOUT = OFF_WIN + SZ_WIN;
constexpr size_t OFF_MOD = OFF_WOUT + SZ_WOUT;
constexpr size_t OFF_XC1 = OFF_MOD + (size_t)33 * 9216 * 4;
constexpr size_t OFF_DT = OFF_XC1 + (size_t)TCX * 1024 * 4;
constexpr size_t SZ_A16 = (size_t)TT * 16 * 4;
constexpr size_t OFF_DTF = OFF_DT + (size_t)TT * 32 * 4, OFF_DTB = OFF_DTF + SZ_A16, OFF_CSF = OFF_DTB + SZ_A16, OFF_CSB = OFF_CSF + SZ_A16;
constexpr size_t OFF_CDEC = OFF_CSB + SZ_A16;
constexpr size_t OFF_BAR = OFF_CDEC + (size_t)32 * 2 * 18 * 16 * 4;
constexpr size_t OFF_BIG = OFF_BAR + 256;
constexpr size_t SZ_H = (size_t)TT * 1024 * 2, SZ_ACT = (size_t)TT * DFF * 2, SZ_ST = (size_t)32 * 2 * 17 * 16 * 8192 * 2;
constexpr size_t OFF_H = OFF_BIG, OFF_ACT = OFF_BIG + SZ_H, OFF_ST = OFF_BIG;
constexpr size_t WS_TOTAL = (size_t)1 << 30;
constexpr size_t OFF_U = WS_TOTAL - (size_t)TX * 1024 * 2, OFF_XBC = OFF_U - (size_t)TT * 1536 * 2, OFF_Y = OFF_XBC - (size_t)TX * 2048 * 2;
static_assert(OFF_BIG % 256 == 0 && OFF_ACT + SZ_ACT <= WS_TOTAL && OFF_Y >= OFF_ST + SZ_ST && OFF_Y >= OFF_H + SZ_H, "workspace map");

struct Params {
    const float *x, *c, *ctx, *c_ctx, *w_mod, *b_mod, *norm_ffn1, *g1, *u1, *d1, *norm_mix, *w_in, *scw, *scb, *dtbf, *dtbb, *alf, *alb, *ssm_d, *ssm_nw, *ccw, *ccb, *lnw, *lnb,
        *w_out, *norm_ffn2, *g2, *u2, *d2, *fnorm;
    float* out; unsigned char* ws; int ph_lo, ph_hi;
};

__device__ __forceinline__ float bf2f(u16 v) { return __uint_as_float(((u32)v) << 16); }
__device__ __forceinline__ u16 f2bf(float f) { u32 u = __float_as_uint(f); u += 0x7FFFu + ((u >> 16) & 1u); return (u16)(u >> 16); }
__device__ __forceinline__ float lo_f(u32 v) { return __uint_as_float(v << 16); }
__device__ __forceinline__ float hi_f(u32 v) { return __uint_as_float(v & 0xffff0000u); }
__device__ __forceinline__ float silu_f(float x) { return x * __builtin_amdgcn_rcpf(1.0f + __expf(-x)); }
__device__ __forceinline__ float sigm_f(float x) { return __builtin_amdgcn_rcpf(1.0f + __expf(-x)); }
__device__ __forceinline__ float wave_sum(float v) {
#pragma unroll
    for (int o = 32; o >= 1; o >>= 1) v += __shfl_xor(v, o);
    return v;
}

struct InOrder : StaticOrder {
    __device__ bool next(int i, Unit& u) const {
        const long L = (long)i * G + c;
        if (L < nwg) return StaticOrder::next(i, u);
        const int e = (int)(L - nwg); if (e >= 192) return false;
        u.pm = 256 + (e & 31); u.pn = e >> 5; return true;
    }
};

struct EpiSwiGLU {
    static constexpr bool PERM = true, AFTER_DRAIN = false;
    bf16_t* O;
    __device__ __forceinline__ void operator()(const f32x4 (&acc)[2][2][4][2], const Unit& u, int wr, int wc, int fr, int fq) const {
        const int row0 = u.pm * BM + wr * 64 + fr, col0 = u.pn * 128 + wc * 32 + 8 * fq;
#pragma unroll
        for (int ai = 0; ai < 2; ++ai)
#pragma unroll
            for (int m = 0; m < 4; ++m) {
                bf16_t* rowp = O + (size_t)(row0 + ai * HALF + m * 16) * DFF + col0;
                const f32x4 g0 = acc[ai][0][m][0], g1 = acc[ai][0][m][1], u0 = acc[ai][1][m][0], u1 = acc[ai][1][m][1];
                u32x4 w;
                w.x = cvt_pk_bf16(silu_f(g0[0]) * u0[0], silu_f(g0[1]) * u0[1]); w.y = cvt_pk_bf16(silu_f(g0[2]) * u0[2], silu_f(g0[3]) * u0[3]);
                w.z = cvt_pk_bf16(silu_f(g1[0]) * u1[0], silu_f(g1[1]) * u1[1]); w.w = cvt_pk_bf16(silu_f(g1[2]) * u1[2], silu_f(g1[3]) * u1[3]);
                *(u32x4*)rowp = w;
            }
    }
};

struct EpiResid {
    static constexpr bool PERM = false, AFTER_DRAIN = false;
    const float* baseX; float* outX; const float* baseC; float* outC; const float* mod; float s;
    __device__ __forceinline__ void operator()(const f32x4 (&acc)[2][2][4][2], const Unit& u, int wr, int wc, int fr, int fq) const {
        const int row0 = u.pm * BM + wr * 64 + fr, col0 = u.pn * BM + wc * 32 + 4 * fq;
        const bool isx = u.pm < 256; const int b = isx ? (u.pm >> 3) : 32;
        const float* bp0 = isx ? baseX + (size_t)row0 * 1024 : baseC + (size_t)(row0 - TX) * 1024;
        float* op0 = isx ? outX + (size_t)row0 * 1024 : outC + (size_t)(row0 - TX) * 1024;
        f32x4 mv[2][2];
#pragma unroll
        for (int bj = 0; bj < 2; ++bj)
#pragma unroll
            for (int n = 0; n < 2; ++n) mv[bj][n] = *(const f32x4*)(mod + (size_t)b * 9216 + col0 + bj * HALF + n * 16) * s;
#pragma unroll
        for (int ai = 0; ai < 2; ++ai)
#pragma unroll
            for (int m = 0; m < 4; ++m) {
                const size_t ro = (size_t)(ai * HALF + m * 16) * 1024 + col0;
                f32x4 bv[2][2];
#pragma unroll
                for (int bj = 0; bj < 2; ++bj)
#pragma unroll
                    for (int n = 0; n < 2; ++n) bv[bj][n] = *(const f32x4*)(bp0 + ro + bj * HALF + n * 16);
#pragma unroll
                for (int bj = 0; bj < 2; ++bj)
#pragma unroll
                    for (int n = 0; n < 2; ++n) *(f32x4*)(op0 + ro + bj * HALF + n * 16) = bv[bj][n] + mv[bj][n] * acc[ai][bj][m][n];
            }
    }
};

struct EpiInProj {
    static constexpr bool PERM = true, AFTER_DRAIN = false;
    bf16_t* XBC; float* DT; bf16_t* Y; bf16_t* U;
    __device__ __forceinline__ void operator()(const f32x4 (&acc)[2][2][4][2], const Unit& u, int wr, int wc, int fr, int fq) const {
        const int row0 = u.pm * BM + wr * 64 + fr, cin = wc * 32 + 8 * fq, pn = u.pn;
        if (pn == 5) {
            if (wc == 0) {
#pragma unroll
                for (int ai = 0; ai < 2; ++ai)
#pragma unroll
                    for (int m = 0; m < 4; ++m) {
                        float* rp = DT + (size_t)(row0 + ai * HALF + m * 16) * 32 + 8 * fq;
                        *(f32x4*)rp = acc[ai][0][m][0]; *(f32x4*)(rp + 4) = acc[ai][0][m][1];
                    }
            }
        } else if (pn <= 10) {
            bf16_t* base; int ld;
            if (pn <= 4) { base = XBC + pn * 256; ld = 1536; } else if (pn == 6) { base = XBC + 1280; ld = 1536; } else { base = Y + (pn - 7) * 256; ld = 2048; }
#pragma unroll
            for (int ai = 0; ai < 2; ++ai)
#pragma unroll
                for (int m = 0; m < 4; ++m) {
                    bf16_t* rowp = base + (size_t)(row0 + ai * HALF + m * 16) * ld + cin;
#pragma unroll
                    for (int bj = 0; bj < 2; ++bj) {
                        f32x4 v0 = acc[ai][bj][m][0], v1 = acc[ai][bj][m][1];
                        if (pn >= 7) {
#pragma unroll
                            for (int j = 0; j < 4; ++j) { v0[j] = silu_f(v0[j]); v1[j] = silu_f(v1[j]); } }
                        u32x4 w; w.x = cvt_pk_bf16(v0[0], v0[1]); w.y = cvt_pk_bf16(v0[2], v0[3]); w.z = cvt_pk_bf16(v1[0], v1[1]); w.w = cvt_pk_bf16(v1[2], v1[3]);
                        *(u32x4*)(rowp + bj * HALF) = w;
                    }
                }
        } else {
            bf16_t* base = U + (pn - 11) * 128 + cin;
#pragma unroll
            for (int ai = 0; ai < 2; ++ai)
#pragma unroll
                for (int m = 0; m < 4; ++m) {
                    bf16_t* rowp = base + (size_t)(row0 + ai * HALF + m * 16) * 1024;
                    const f32x4 a0 = acc[ai][0][m][0], a1 = acc[ai][0][m][1], b0 = acc[ai][1][m][0], b1 = acc[ai][1][m][1];
                    u32x4 w;
                    w.x = cvt_pk_bf16(a0[0] * sigm_f(b0[0]), a0[1] * sigm_f(b0[1])); w.y = cvt_pk_bf16(a0[2] * sigm_f(b0[2]), a0[3] * sigm_f(b0[3]));
                    w.z = cvt_pk_bf16(a1[0] * sigm_f(b1[0]), a1[1] * sigm_f(b1[1])); w.w = cvt_pk_bf16(a1[2] * sigm_f(b1[2]), a1[3] * sigm_f(b1[3]));
                    *(u32x4*)rowp = w;
                }
        }
    }
};

__device__ __forceinline__ void prep_mod_item(const Params& P, LAS unsigned char* lds, int it) {
    const int tid = tid_fresh();
    LAS float* cc = (LAS float*)lds;
    for (int i = tid; i < 33 * 1024; i += 512) { const int r = i >> 10, k = i & 1023; const float v = (r < 32) ? P.c[r * 1024 + k] : P.c_ctx[k]; cc[i] = silu_f(v); }
    __syncthreads();
    const int n0 = it * 64, col = tid & 63, kk = tid >> 6;
    float acc[33];
#pragma unroll
    for (int r = 0; r < 33; ++r) acc[r] = 0.f;
    const float* wp = P.w_mod + (size_t)(kk * 128) * 9216 + n0 + col;
    for (int k4 = 0; k4 < 32; ++k4) {
        const float w0 = wp[(size_t)(k4 * 4 + 0) * 9216], w1 = wp[(size_t)(k4 * 4 + 1) * 9216], w2 = wp[(size_t)(k4 * 4 + 2) * 9216], w3 = wp[(size_t)(k4 * 4 + 3) * 9216];
#pragma unroll
        for (int r = 0; r < 33; ++r) { const f32x4 c4 = *(const LAS f32x4*)(cc + r * 1024 + kk * 128 + k4 * 4); acc[r] += c4[0] * w0 + c4[1] * w1 + c4[2] * w2 + c4[3] * w3; }
    }
    __syncthreads();
    LAS float* red = (LAS float*)lds;
#pragma unroll
    for (int r = 0; r < 33; ++r) red[(kk * 33 + r) * 64 + col] = acc[r];
    __syncthreads();
    float* MOD = (float*)(P.ws + OFF_MOD);
    for (int o = tid; o < 33 * 64; o += 512) { const int r = o >> 6, cl = o & 63; float s = 0.f;
#pragma unroll
        for (int q = 0; q < 8; ++q) s += red[(q * 33 + r) * 64 + cl];
        MOD[(size_t)r * 9216 + n0 + cl] = s + P.b_mod[n0 + cl]; }
    __syncthreads();
}

__device__ __forceinline__ void prep_tile(const Params& P, LAS unsigned char* lds, int t) {
    const int tid = tid_fresh();
    const float* src; int sld, scol0, nvalid = 64, kt, n0, dld; u16* dst;
    if (t < 2816) {
        const int f = t >= 1408; const int tt = t - f * 1408; const int nt = tt >> 4; kt = tt & 15; n0 = nt * 64;
        const int j = n0 >> 8, s0 = n0 & 255;
        src = (s0 < 128) ? (f ? P.g2 : P.g1) : (f ? P.u2 : P.u1); scol0 = 128 * j + (s0 & 127); sld = DFF;
        dst = (u16*)(P.ws + (f ? OFF_WGU2 : OFF_WGU1)); dld = 1024;
    } else if (t < 2816 + 1408) {
        const int t2 = t - 2816; const int f = t2 >= 704; const int tt = t2 - f * 704; const int nt = tt / 44; kt = tt % 44; n0 = nt * 64;
        src = f ? P.d2 : P.d1; scol0 = n0; sld = 1024; dst = (u16*)(P.ws + (f ? OFF_WD2 : OFF_WD1)); dld = DFF;
    } else if (t < 2816 + 1408 + 1216) {
        const int tt = t - 4224; const int nt = tt >> 4; kt = tt & 15; n0 = nt * 64;
        const int pn = n0 >> 8, s0 = n0 & 255;
        if (pn < 4) scol0 = 1024 + n0; else if (pn == 4) scol0 = 2048 + s0; else if (pn == 5) { scol0 = 2560 + (s0 ? 0 : 0); nvalid = s0 ? 0 : 32; }
        else if (pn == 6) scol0 = 2304 + s0; else if (pn <= 10) scol0 = n0 - 1792;
        else { const int j = pn - 11; scol0 = (s0 < 128) ? (2592 + 128 * j + s0) : (2592 + 1024 + 128 * j + (s0 - 128)); }
        src = P.w_in; sld = 4640; dst = (u16*)(P.ws + OFF_WIN); dld = 1024;
    } else {
        const int tt = t - 5440; const int nt = tt >> 5; kt = tt & 31; n0 = nt * 64;
        src = P.w_out; scol0 = n0; sld = 1024; dst = (u16*)(P.ws + OFF_WOUT); dld = 2048;
    }
    LAS float* tile = (LAS float*)lds;
#pragma unroll
    for (int e = 0; e < 8; ++e) { const int idx = tid + 512 * e, kk = idx >> 6, nn = idx & 63;
        tile[kk * 65 + nn] = (nn < nvalid) ? src[(size_t)(kt * 64 + kk) * sld + scol0 + nn] : 0.f; }
    __syncthreads();
    { const int nn = tid >> 3, ks = (tid & 7) * 8; u32x4 w;
      w.x = cvt_pk_bf16(tile[(ks + 0) * 65 + nn], tile[(ks + 1) * 65 + nn]); w.y = cvt_pk_bf16(tile[(ks + 2) * 65 + nn], tile[(ks + 3) * 65 + nn]);
      w.z = cvt_pk_bf16(tile[(ks + 4) * 65 + nn], tile[(ks + 5) * 65 + nn]); w.w = cvt_pk_bf16(tile[(ks + 6) * 65 + nn], tile[(ks + 7) * 65 + nn]);
      *(u32x4*)(dst + (size_t)(n0 + nn) * dld + kt * 64 + ks) = w; }
    __syncthreads();
}

__device__ __forceinline__ void phase_prep(const Params& P, LAS unsigned char* lds) {
    constexpr int NMOD = 144, NTILE = 2816 + 1408 + 1216 + 512;
    for (int it = blockIdx.x; it < NMOD + NTILE; it += gridDim.x) { if (it < NMOD) prep_mod_item(P, lds, it); else prep_tile(P, lds, it - NMOD); }
}

template <int MODE>
__device__ __forceinline__ void phase_norm(const Params& P, const float* srcX, const float* srcC, int nrows, const float* nw, int shIdx, int scIdx, u16* H, float* outF) {
    constexpr int NR = 4;
    const int lane = tid_fresh() & 63, gw = blockIdx.x * 8 + (tid_fresh() >> 6), nwv = gridDim.x * 8;
    const float* MOD = (const float*)(P.ws + OFF_MOD);
    f32x4 w[4];
#pragma unroll
    for (int i = 0; i < 4; ++i) w[i] = *(const f32x4*)(nw + i * 256 + lane * 4);
    for (int row0 = gw * NR; row0 < nrows; row0 += nwv * NR) {
        f32x4 v[NR][4];
        const float* src0 = (row0 < TX) ? srcX + (size_t)row0 * 1024 : srcC + (size_t)(row0 - TX) * 1024;
#pragma unroll
        for (int q = 0; q < NR; ++q) {
#pragma unroll
            for (int i = 0; i < 4; ++i) v[q][i] = *(const f32x4*)(src0 + q * 1024 + i * 256 + lane * 4); }
        const int b = (row0 < TX) ? (row0 >> 11) : 32;
        float rstd[NR];
#pragma unroll
        for (int q = 0; q < NR; ++q) { float ss = 0.f;
#pragma unroll
            for (int i = 0; i < 4; ++i) ss += v[q][i][0] * v[q][i][0] + v[q][i][1] * v[q][i][1] + v[q][i][2] * v[q][i][2] + v[q][i][3] * v[q][i][3];
            rstd[q] = rsqrtf(wave_sum(ss) * (1.0f / 1024.0f) + EPSF); }
#pragma unroll
        for (int i = 0; i < 4; ++i) { const int col = i * 256 + lane * 4;
            if (MODE == 0) {
                const f32x4 sh = *(const f32x4*)(MOD + (size_t)b * 9216 + shIdx * 1024 + col), sc = *(const f32x4*)(MOD + (size_t)b * 9216 + scIdx * 1024 + col);
                const f32x4 ws = w[i] * (sc + 1.0f);
#pragma unroll
                for (int q = 0; q < NR; ++q) { const f32x4 o = v[q][i] * rstd[q] * ws + sh;
                    uint2 pk; pk.x = cvt_pk_bf16(o[0], o[1]); pk.y = cvt_pk_bf16(o[2], o[3]);
                    *(uint2*)(H + (size_t)(row0 + q) * 1024 + col) = pk; }
            } else {
#pragma unroll
                for (int q = 0; q < NR; ++q) *(f32x4*)(outF + (size_t)(row0 + q) * 1024 + col) = v[q][i] * rstd[q] * w[i];
            } }
    }
}

template <int NC>
__device__ __forceinline__ void stage_conv(LAS u16* dst, int ld, const u16* XBC, int row0, int seq0, int seq1, int col0, const float* cw, const float* cb) {
    constexpr int NP = NC / 2, NTG = 512 / NP, TPG = 128 / NTG;
    const int tid = tid_fresh(), cp = tid % NP, tg = tid / NP, ch = col0 + 2 * cp, l0 = tg * TPG;
    float w0[5], w1[5];
#pragma unroll
    for (int k = 0; k < 5; ++k) { w0[k] = cw[k * 1536 + ch]; w1[k] = cw[k * 1536 + ch + 1]; }
    const float b0 = cb[ch], b1 = cb[ch + 1];
    u32 win[5] = {0u, 0u, 0u, 0u, 0u};
    u32 ldv[TPG + 4];
#pragma unroll
    for (int i = 0; i < TPG + 4; ++i) { const int r = row0 + l0 - 2 + i; const int rc = min(max(r, seq0), seq1 - 1); ldv[i] = *(const u32*)(XBC + (size_t)rc * 1536 + ch); }
#pragma unroll
    for (int i = 0; i < TPG + 4; ++i) {
        const int r = row0 + l0 - 2 + i;
        const u32 v = (r >= seq0 && r < seq1) ? ldv[i] : 0u;
        win[0] = win[1]; win[1] = win[2]; win[2] = win[3]; win[3] = win[4]; win[4] = v;
        if (i >= 4) {
            float a0 = b0, a1 = b1;
#pragma unroll
            for (int k = 0; k < 5; ++k) { a0 += w0[k] * lo_f(win[k]); a1 += w1[k] * hi_f(win[k]); }
            *(LAS u32*)(dst + (l0 + i - 4) * ld + 2 * cp) = cvt_pk_bf16(silu_f(a0), silu_f(a1));
        }
    }
}

template <int NC>
__device__ __forceinline__ void stage_conv_t(LAS u16* dst, int ld, const u16* XBC, int row0, int seq0, int seq1, int col0, const float* cw, const float* cb) {
    constexpr int NP = NC / 2, NTG = 512 / NP, TPG = 128 / NTG;
    const int tid = tid_fresh(), cp = tid % NP, tg = tid / NP, ch = col0 + 2 * cp, l0 = tg * TPG;
    float w0[5], w1[5];
#pragma unroll
    for (int k = 0; k < 5; ++k) { w0[k] = cw[k * 1536 + ch]; w1[k] = cw[k * 1536 + ch + 1]; }
    const float b0 = cb[ch], b1 = cb[ch + 1];
    u32 ldv[TPG + 4];
#pragma unroll
    for (int i = 0; i < TPG + 4; ++i) { const int r = row0 + l0 - 2 + i; const int rc = min(max(r, seq0), seq1 - 1); ldv[i] = *(const u32*)(XBC + (size_t)rc * 1536 + ch); }
#pragma unroll
    for (int i = 0; i < TPG + 4; ++i) { const int r = row0 + l0 - 2 + i; if (!(r >= seq0 && r < seq1)) ldv[i] = 0u; }
    float o0[TPG], o1[TPG];
#pragma unroll
    for (int t = 0; t < TPG; ++t) { float a0 = b0, a1 = b1;
#pragma unroll
        for (int k = 0; k < 5; ++k) { a0 += w0[k] * lo_f(ldv[t + k]); a1 += w1[k] * hi_f(ldv[t + k]); }
        o0[t] = silu_f(a0); o1[t] = silu_f(a1); }
#pragma unroll
    for (int q = 0; q < TPG / 8; ++q) {
        u32x4 a, b;
        a.x = cvt_pk_bf16(o0[8 * q + 0], o0[8 * q + 1]); a.y = cvt_pk_bf16(o0[8 * q + 2], o0[8 * q + 3]); a.z = cvt_pk_bf16(o0[8 * q + 4], o0[8 * q + 5]); a.w = cvt_pk_bf16(o0[8 * q + 6], o0[8 * q + 7]);
        b.x = cvt_pk_bf16(o1[8 * q + 0], o1[8 * q + 1]); b.y = cvt_pk_bf16(o1[8 * q + 2], o1[8 * q + 3]); b.z = cvt_pk_bf16(o1[8 * q + 4], o1[8 * q + 5]); b.w = cvt_pk_bf16(o1[8 * q + 6], o1[8 * q + 7]);
        *(LAS u32x4*)(dst + (2 * cp) * ld + l0 + 8 * q) = a; *(LAS u32x4*)(dst + (2 * cp + 1) * ld + l0 + 8 * q) = b;
    }
}

__device__ __forceinline__ void dtprep_item(const Params& P, LAS unsigned char* lds, int tc) {
    const int tid = tid_fresh(), dh = tid & 31, seg = tid >> 5, dir = dh >> 4, h = dh & 15;
    const bool isx = tc < 512; const int b = isx ? (tc >> 4) : ((tc - 512) >> 1); const int cidx = isx ? (tc & 15) : ((tc - 512) & 1);
    const int row0 = tc * 128;
    const int jscan = isx ? (dir ? 17 - cidx : cidx + 2) : (dir ? 1 - cidx : cidx);
    const float bias = dir ? P.dtbb[h] : P.dtbf[h]; const float a = -__expf(dir ? P.alb[h] : P.alf[h]);
    const float* DT = (const float*)(P.ws + OFF_DT);
    float dt[8], cs[8];
#pragma unroll
    for (int i = 0; i < 8; ++i) { const float raw = DT[(size_t)(row0 + seg * 8 + i) * 32 + dh] + bias; dt[i] = (raw > 20.f) ? raw : log1pf(__expf(raw)); }
    float run = 0.f;
    if (dir == 0) {
#pragma unroll
        for (int i = 0; i < 8; ++i) { run += dt[i] * a; cs[i] = run; }
    } else {
#pragma unroll
        for (int i = 7; i >= 0; --i) { run += dt[i] * a; cs[i] = run; }
    }
    LAS float* segsum = (LAS float*)lds;
    segsum[seg * 32 + dh] = run;
    __syncthreads();
    float off = 0.f, tot = 0.f;
#pragma unroll
    for (int s2 = 0; s2 < 16; ++s2) { const float v = segsum[s2 * 32 + dh]; tot += v; if (dir == 0 ? (s2 < seg) : (s2 > seg)) off += v; }
    float* DTO = (float*)(P.ws + (dir ? OFF_DTB : OFF_DTF)); float* CSO = (float*)(P.ws + (dir ? OFF_CSB : OFF_CSF));
#pragma unroll
    for (int i = 0; i < 8; ++i) { const size_t o = (size_t)(row0 + seg * 8 + i) * 16 + h; DTO[o] = dt[i]; CSO[o] = cs[i] + off; }
    if (seg == 0) ((float*)(P.ws + OFF_CDEC))[((b * 2 + dir) * 18 + jscan) * 16 + h] = __expf(tot);
    __syncthreads();
}

typedef float f32x2 __attribute__((ext_vector_type(2)));
__device__ __forceinline__ void uconv_item(const Params& P, LAS unsigned char* lds, int item) {
    const int tid = tid_fresh(); const bool isH = item < 2048; const int e = item & 2047, b = e >> 6, q = (e >> 1) & 31, chalf = e & 1;
    LAS float* in = (LAS float*)lds;
    const u16* Ug = (const u16*)(P.ws + OFF_U); u16* Yg = (u16*)(P.ws + OFF_Y);
    const int choff = (isH ? 0 : 512) + 256 * chalf;
    u32x4 raw[4];
#pragma unroll
    for (int i = 0; i < 4; ++i) { const int idx = tid + 512 * i, tok = idx >> 5, c8 = idx & 31; int grow;
        if (isH) grow = b * 2048 + q * 64 + tok; else grow = b * 2048 + (tok & 31) * 64 + 2 * q + (tok >> 5);
        raw[i] = *(const u32x4*)(Ug + (size_t)grow * 1024 + choff + c8 * 8); }
    const int cp = tid & 127, tq = tid >> 7, ch = choff + 2 * cp;
    f32x2 w[31];
#pragma unroll
    for (int k = 0; k < 31; ++k) w[k] = *(const f32x2*)(P.ccw + k * 1024 + ch);
    const f32x2 bias = *(const f32x2*)(P.ccb + ch);
#pragma unroll
    for (int i = 0; i < 4; ++i) { const int idx = tid + 512 * i, tok = idx >> 5, c8 = idx & 31; const int lrow = isH ? (15 + tok) : ((tok >> 5) * 62 + 15 + (tok & 31));
        const u32x4 v = raw[i];
        *(LAS f32x4*)(in + lrow * 256 + c8 * 8) = (f32x4){lo_f(v.x), hi_f(v.x), lo_f(v.y), hi_f(v.y)};
        *(LAS f32x4*)(in + lrow * 256 + c8 * 8 + 4) = (f32x4){lo_f(v.z), hi_f(v.z), lo_f(v.w), hi_f(v.w)}; }
    { const int npad = isH ? 30 : 60;
      for (int idx = tid; idx < npad * 64; idx += 512) { const int pr = idx >> 6, c4 = idx & 63; int lrow;
          if (isH) lrow = (pr < 15) ? pr : 64 + pr; else { const int line = pr / 30, k = pr % 30; lrow = line * 62 + ((k < 15) ? k : 32 + k); }
          *(LAS f32x4*)(in + lrow * 256 + c4 * 4) = (f32x4){0.f, 0.f, 0.f, 0.f}; } }
    __syncthreads();
    const int base_row = isH ? 16 * tq : (62 * (tq >> 1) + 16 * (tq & 1));
    f32x2 win[46];
#pragma unroll
    for (int i = 0; i < 46; ++i) win[i] = *(const LAS f32x2*)(in + (base_row + i) * 256 + 2 * cp);
    const int g0 = isH ? (b * 2048 + q * 64 + 16 * tq) : (b * 2048 + (16 * (tq & 1)) * 64 + 2 * q + (tq >> 1));
    const int gstep = isH ? 1 : 64;
#pragma unroll
    for (int oo = 0; oo < 16; ++oo) {
        f32x2 a = bias;
#pragma unroll
        for (int k = 0; k < 31; ++k) a = win[oo + k] * w[k] + a;
        *(u32*)(Yg + (size_t)(g0 + oo * gstep) * 2048 + 1024 + ch) = cvt_pk_bf16(a[0], a[1]);
    }
    __syncthreads();
}

__device__ __forceinline__ void phase_p6(const Params& P, LAS unsigned char* lds) {
    for (int it = blockIdx.x; it < 576; it += gridDim.x) dtprep_item(P, lds, it);
}

__device__ __forceinline__ bf16x8 gather8(const LAS u16* p, int stride) {
    bf16x8 r;
#pragma unroll
    for (int j = 0; j < 8; ++j) r[j] = (short)p[j * stride];
    return r;
}
#define MFMA32(a, b, c) __builtin_amdgcn_mfma_f32_32x32x16_bf16((a), (b), (c), 0, 0, 0)

__device__ __forceinline__ void s1_item(const Params& P, LAS unsigned char* lds, int item) {
    const int tid = tid_fresh(), w = tid >> 6, lane = tid & 63, r = lane & 31, hf = lane >> 5;
    const int g = item & 1, tc = (item >> 1) % 18, b = item / 36;
    const bool isx = tc < 16;
    const int seq0 = isx ? b * 2048 : TX + b * 256, seq1 = seq0 + (isx ? 2048 : 256), row0 = seq0 + 128 * (isx ? tc : tc - 16);
    const int jf = isx ? tc + 2 : tc - 16, jb = 17 - tc;
    LAS u16* BT = (LAS u16*)lds;
    LAS u16* XT = (LAS u16*)(lds + 34816);
    LAS float* wfb = (LAS float*)(lds + 34816 + 69632);
    const u16* XBC = (const u16*)(P.ws + OFF_XBC);
    const float *CSF = (const float*)(P.ws + OFF_CSF), *CSB = (const float*)(P.ws + OFF_CSB), *DTF = (const float*)(P.ws + OFF_DTF), *DTB = (const float*)(P.ws + OFF_DTB);
    u16* ST = (u16*)(P.ws + OFF_ST);
    stage_conv_t<128>(BT, 136, XBC, row0, seq0, seq1, 1024 + 128 * g, P.scw, P.scb);
    const int hq = w >> 1, pb = w & 1;
    for (int pass = 0; pass < 2; ++pass) {
        const int h0 = 8 * g + 4 * pass, h = h0 + hq;
        stage_conv_t<256>(XT, 136, XBC, row0, seq0, seq1, 64 * h0, P.scw, P.scb);
#pragma unroll
        for (int e = 0; e < 2; ++e) { const int idx = tid + 512 * e, hh = idx >> 8, dir = (idx >> 7) & 1, l = idx & 127, hx = h0 + hh;
            const float* CS = dir ? CSB : CSF; const float* DTA = dir ? DTB : DTF; const int rend = dir ? row0 : row0 + 127;
            wfb[(hh * 2 + dir) * 128 + l] = __expf(CS[(size_t)rend * 16 + hx] - CS[(size_t)(row0 + l) * 16 + hx]) * DTA[(size_t)(row0 + l) * 16 + hx]; }
        __syncthreads();
        f32x16 acc[2][4];
#pragma unroll
        for (int d = 0; d < 2; ++d)
#pragma unroll
            for (int nb = 0; nb < 4; ++nb)
#pragma unroll
                for (int i = 0; i < 16; ++i) acc[d][nb][i] = 0.f;
#pragma unroll 2
        for (int ks = 0; ks < 8; ++ks) {
            const int lb = 16 * ks + 8 * hf;
            const bf16x8 xr = *(const LAS bf16x8*)(XT + (hq * 64 + 32 * pb + r) * 136 + lb);
            const f32x4 wf0 = *(const LAS f32x4*)(wfb + (hq * 2 + 0) * 128 + lb), wf1 = *(const LAS f32x4*)(wfb + (hq * 2 + 0) * 128 + lb + 4);
            const f32x4 wb0 = *(const LAS f32x4*)(wfb + (hq * 2 + 1) * 128 + lb), wb1 = *(const LAS f32x4*)(wfb + (hq * 2 + 1) * 128 + lb + 4);
            float xv[8];
#pragma unroll
            for (int j = 0; j < 8; ++j) xv[j] = bf2f((u16)xr[j]);
            u32x4 qf, qb;
            qf.x = cvt_pk_bf16(xv[0] * wf0[0], xv[1] * wf0[1]); qf.y = cvt_pk_bf16(xv[2] * wf0[2], xv[3] * wf0[3]); qf.z = cvt_pk_bf16(xv[4] * wf1[0], xv[5] * wf1[1]); qf.w = cvt_pk_bf16(xv[6] * wf1[2], xv[7] * wf1[3]);
            qb.x = cvt_pk_bf16(xv[0] * wb0[0], xv[1] * wb0[1]); qb.y = cvt_pk_bf16(xv[2] * wb0[2], xv[3] * wb0[3]); qb.z = cvt_pk_bf16(xv[4] * wb1[0], xv[5] * wb1[1]); qb.w = cvt_pk_bf16(xv[6] * wb1[2], xv[7] * wb1[3]);
            const bf16x8 xf = __builtin_bit_cast(bf16x8, qf), xb = __builtin_bit_cast(bf16x8, qb);
#pragma unroll
            for (int nb = 0; nb < 4; ++nb) { const bf16x8 bfr = *(const LAS bf16x8*)(BT + (32 * nb + r) * 136 + lb);
                acc[0][nb] = MFMA32(bfr, xf, acc[0][nb]); acc[1][nb] = MFMA32(bfr, xb, acc[1][nb]); }
        }
#pragma unroll
        for (int d = 0; d < 2; ++d) { const int j = d ? jb : jf;
            if (j <= 16) { u16* sp = ST + ((size_t)((b * 2 + d) * 17 + j) * 16 + h) * 8192 + ((pb * 4) * 64 + lane) * 16;
#pragma unroll
                for (int nb = 0; nb < 4; ++nb) { u32x4 q0, q1;
                    q0.x = cvt_pk_bf16(acc[d][nb][0], acc[d][nb][1]); q0.y = cvt_pk_bf16(acc[d][nb][2], acc[d][nb][3]); q0.z = cvt_pk_bf16(acc[d][nb][4], acc[d][nb][5]); q0.w = cvt_pk_bf16(acc[d][nb][6], acc[d][nb][7]);
                    q1.x = cvt_pk_bf16(acc[d][nb][8], acc[d][nb][9]); q1.y = cvt_pk_bf16(acc[d][nb][10], acc[d][nb][11]); q1.z = cvt_pk_bf16(acc[d][nb][12], acc[d][nb][13]); q1.w = cvt_pk_bf16(acc[d][nb][14], acc[d][nb][15]);
                    *(u32x4*)(sp + nb * 1024) = q0; *(u32x4*)(sp + nb * 1024 + 8) = q1; } } }
        __syncthreads();
    }
}

__device__ __forceinline__ void phase_s2(const Params& P) {
    u16* ST = (u16*)(P.ws + OFF_ST); const float* CDEC = (const float*)(P.ws + OFF_CDEC);
    const int nth = gridDim.x * 512;
    for (int v = blockIdx.x * 512 + tid_fresh(); v < 32 * 2 * 16 * 1024; v += nth) {
        const int pn = (v & 1023) * 8, h = (v >> 10) & 15, bd = v >> 14;
        float hs[8];
#pragma unroll
        for (int j = 0; j < 8; ++j) hs[j] = 0.f;
        u16* base = ST + ((size_t)(bd * 17) * 16 + h) * 8192 + pn;
        u32x4 q[17]; float dec[17];
#pragma unroll
        for (int s = 0; s < 17; ++s) { q[s] = *(const u32x4*)(base + (size_t)s * 16 * 8192); dec[s] = CDEC[(bd * 18 + s) * 16 + h]; }
#pragma unroll
        for (int s = 0; s < 17; ++s) {
            const float d = dec[s];
            hs[0] = hs[0] * d + lo_f(q[s].x); hs[1] = hs[1] * d + hi_f(q[s].x); hs[2] = hs[2] * d + lo_f(q[s].y); hs[3] = hs[3] * d + hi_f(q[s].y);
            hs[4] = hs[4] * d + lo_f(q[s].z); hs[5] = hs[5] * d + hi_f(q[s].z); hs[6] = hs[6] * d + lo_f(q[s].w); hs[7] = hs[7] * d + hi_f(q[s].w);
            u32x4 o; o.x = cvt_pk_bf16(hs[0], hs[1]); o.y = cvt_pk_bf16(hs[2], hs[3]); o.z = cvt_pk_bf16(hs[4], hs[5]); o.w = cvt_pk_bf16(hs[6], hs[7]);
            *(u32x4*)(base + (size_t)s * 16 * 8192) = o;
        }
    }
}

__device__ __forceinline__ void s3_item(const Params& P, LAS unsigned char* lds, int item) {
    const int tid = tid_fresh(), w = tid >> 6, lane = tid & 63, r = lane & 31, hf = lane >> 5;
    const int g = item & 1, c = (item >> 1) & 15, b = item >> 5;
    const int seq0 = b * 2048, seq1 = seq0 + 2048, row0 = seq0 + 128 * c;
    LAS u16* Cs = (LAS u16*)lds;
    LAS u16* Gs = (LAS u16*)(lds + 34816);
    LAS u16* XT = (LAS u16*)(lds + 69632);
    LAS u16* Bs = XT;
    LAS float* ar = (LAS float*)(lds + 139264);
    LAS float* ssq = (LAS float*)(lds + 147456);
    const u16* XBC = (const u16*)(P.ws + OFF_XBC); const u16* ST = (const u16*)(P.ws + OFF_ST); u16* Yg = (u16*)(P.ws + OFF_Y);
    const float *CSF = (const float*)(P.ws + OFF_CSF), *CSB = (const float*)(P.ws + OFF_CSB), *DTF = (const float*)(P.ws + OFF_DTF), *DTB = (const float*)(P.ws + OFF_DTB);
    stage_conv<128>(Cs, 136, XBC, row0, seq0, seq1, 1280 + 128 * g, P.scw, P.scb);
    stage_conv<128>(Bs, 136, XBC, row0, seq0, seq1, 1024 + 128 * g, P.scw, P.scb);
    if (tid < 128) ssq[tid] = 0.f;
    __syncthreads();
    {
        const int wr2 = w >> 1, wc2 = w & 1;
        f32x16 g0, g1;
#pragma unroll
        for (int i = 0; i < 16; ++i) { g0[i] = 0.f; g1[i] = 0.f; }
#pragma unroll 2
        for (int ks = 0; ks < 8; ++ks) {
            const bf16x8 a = *(const LAS bf16x8*)(Cs + (32 * wr2 + r) * 136 + 16 * ks + 8 * hf);
            const bf16x8 b0 = *(const LAS bf16x8*)(Bs + (64 * wc2 + r) * 136 + 16 * ks + 8 * hf);
            const bf16x8 b1 = *(const LAS bf16x8*)(Bs + (64 * wc2 + 32 + r) * 136 + 16 * ks + 8 * hf);
            g0 = MFMA32(a, b0, g0); g1 = MFMA32(a, b1, g1);
        }
#pragma unroll
        for (int i = 0; i < 16; ++i) { const int l = 32 * wr2 + (i & 3) + 8 * (i >> 2) + 4 * hf;
            Gs[l * 136 + 64 * wc2 + r] = f2bf(g0[i]); Gs[l * 136 + 64 * wc2 + 32 + r] = f2bf(g1[i]); }
    }
    __syncthreads();
    const int hq = w >> 1, rbh = w & 1;
    for (int pass = 0; pass < 2; ++pass) {
        const int h0 = 8 * g + 4 * pass, h = h0 + hq;
        stage_conv_t<256>(XT, 136, XBC, row0, seq0, seq1, 64 * h0, P.scw, P.scb);
#pragma unroll
        for (int e = 0; e < 4; ++e) { const int idx = tid + 512 * e, hh = idx >> 9, which = (idx >> 7) & 3, l = idx & 127;
            const float* srcp = (which == 0) ? CSF : (which == 1) ? CSB : (which == 2) ? DTF : DTB; ar[(hh * 4 + which) * 128 + l] = srcp[(size_t)(row0 + l) * 16 + h0 + hh]; }
        const u16* stf = ST + ((size_t)((b * 2 + 0) * 17 + (c + 1)) * 16 + h) * 8192 + lane * 16;
        const u16* stb = ST + ((size_t)((b * 2 + 1) * 17 + (16 - c)) * 16 + h) * 8192 + lane * 16;
        u32x4 hfr[2][2][2][2];
#pragma unroll
        for (int cb = 0; cb < 2; ++cb)
#pragma unroll
            for (int nl = 0; nl < 2; ++nl)
#pragma unroll
                for (int sx = 0; sx < 2; ++sx) { const int off = ((cb * 4 + nl) * 64) * 16 + 8 * sx; hfr[0][cb][nl][sx] = *(const u32x4*)(stf + off); hfr[1][cb][nl][sx] = *(const u32x4*)(stb + off); }
        __syncthreads();
        LAS float* A = ar + hq * 512;
        f32x16 acc[2][2];
#pragma unroll
        for (int a = 0; a < 2; ++a)
#pragma unroll
            for (int cb = 0; cb < 2; ++cb)
#pragma unroll
                for (int i = 0; i < 16; ++i) acc[a][cb][i] = 0.f;
        const int l0 = 64 * rbh + r, l1 = l0 + 32;
        const float csf0 = A[l0], csb0 = A[128 + l0], dg0 = A[256 + l0] + A[384 + l0], csf1 = A[l1], csb1 = A[128 + l1], dg1 = A[256 + l1] + A[384 + l1];
        const float ef0 = __expf(csf0), eb0 = __expf(csb0), ef1 = __expf(csf1), eb1 = __expf(csb1), dsk = P.ssm_d[h];
#define S3_OFF(NBH) do { _Pragma("unroll") for (int nl = 0; nl < 2; ++nl) _Pragma("unroll") for (int sx = 0; sx < 2; ++sx) { const int no = 32 * (2 * (NBH) + nl) + 16 * sx + 4 * hf; \
            _Pragma("unroll") for (int rb2 = 0; rb2 < 2; ++rb2) { const int l = rb2 ? l1 : l0; const float ef = rb2 ? ef1 : ef0, eb = rb2 ? eb1 : eb0; \
                const u32x2 clo = *(const LAS u32x2*)(Cs + l * 136 + no), chi = *(const LAS u32x2*)(Cs + l * 136 + no + 8); \
                const float c0 = lo_f(clo.x), c1 = hi_f(clo.x), c2 = lo_f(clo.y), c3 = hi_f(clo.y), c4 = lo_f(chi.x), c5 = hi_f(chi.x), c6 = lo_f(chi.y), c7 = hi_f(chi.y); \
                u32x4 qf, qb; qf.x = cvt_pk_bf16(c0 * ef, c1 * ef); qf.y = cvt_pk_bf16(c2 * ef, c3 * ef); qf.z = cvt_pk_bf16(c4 * ef, c5 * ef); qf.w = cvt_pk_bf16(c6 * ef, c7 * ef); \
                qb.x = cvt_pk_bf16(c0 * eb, c1 * eb); qb.y = cvt_pk_bf16(c2 * eb, c3 * eb); qb.z = cvt_pk_bf16(c4 * eb, c5 * eb); qb.w = cvt_pk_bf16(c6 * eb, c7 * eb); \
                const bf16x8 af = __builtin_bit_cast(bf16x8, qf), ab = __builtin_bit_cast(bf16x8, qb); \
                _Pragma("unroll") for (int cb = 0; cb < 2; ++cb) { acc[rb2][cb] = MFMA32(af, __builtin_bit_cast(bf16x8, hfr[0][cb][nl][sx]), acc[rb2][cb]); \
                    acc[rb2][cb] = MFMA32(ab, __builtin_bit_cast(bf16x8, hfr[1][cb][nl][sx]), acc[rb2][cb]); } } } } while (0)
        S3_OFF(0);
#pragma unroll
        for (int cb = 0; cb < 2; ++cb)
#pragma unroll
            for (int nl = 0; nl < 2; ++nl)
#pragma unroll
                for (int sx = 0; sx < 2; ++sx) { const int off = ((cb * 4 + 2 + nl) * 64) * 16 + 8 * sx; hfr[0][cb][nl][sx] = *(const u32x4*)(stf + off); hfr[1][cb][nl][sx] = *(const u32x4*)(stb + off); }
#pragma unroll 1
        for (int ks = 0; ks < 8; ++ks) {
            const int sb = 16 * ks + 8 * hf;
            const bf16x8 x0 = *(const LAS bf16x8*)(XT + (hq * 64 + r) * 136 + sb), x1 = *(const LAS bf16x8*)(XT + (hq * 64 + 32 + r) * 136 + sb);
            float cfs[8], cbs[8], dfs[8], dbs[8];
#pragma unroll
            for (int q = 0; q < 2; ++q) { const f32x4 t0 = *(const LAS f32x4*)(A + sb + 4 * q), t1 = *(const LAS f32x4*)(A + 128 + sb + 4 * q), t2 = *(const LAS f32x4*)(A + 256 + sb + 4 * q), t3 = *(const LAS f32x4*)(A + 384 + sb + 4 * q);
#pragma unroll
                for (int j = 0; j < 4; ++j) { cfs[4 * q + j] = t0[j]; cbs[4 * q + j] = t1[j]; dfs[4 * q + j] = t2[j]; dbs[4 * q + j] = t3[j]; } }
#pragma unroll
            for (int rb2 = 0; rb2 < 2; ++rb2) { const int l = rb2 ? l1 : l0; const float csf_l = rb2 ? csf1 : csf0, csb_l = rb2 ? csb1 : csb0, dg = rb2 ? dg1 : dg0;
                const bf16x8 gv = *(const LAS bf16x8*)(Gs + l * 136 + sb); float o[8];
#pragma unroll
                for (int j = 0; j < 8; ++j) { const int ss = sb + j; float f;
                    if (ss < l) f = __expf(csf_l - cfs[j]) * dfs[j]; else if (ss > l) f = __expf(csb_l - cbs[j]) * dbs[j]; else f = dg;
                    o[j] = bf2f((u16)gv[j]) * f + ((ss == l) ? dsk : 0.f); }
                u32x4 q; q.x = cvt_pk_bf16(o[0], o[1]); q.y = cvt_pk_bf16(o[2], o[3]); q.z = cvt_pk_bf16(o[4], o[5]); q.w = cvt_pk_bf16(o[6], o[7]);
                const bf16x8 am = __builtin_bit_cast(bf16x8, q);
                acc[rb2][0] = MFMA32(am, x0, acc[rb2][0]); acc[rb2][1] = MFMA32(am, x1, acc[rb2][1]); }
        }
        S3_OFF(1);
#undef S3_OFF
        __syncthreads();
#pragma unroll
        for (int rb2 = 0; rb2 < 2; ++rb2)
#pragma unroll
            for (int cb = 0; cb < 2; ++cb)
#pragma unroll
                for (int i = 0; i < 16; ++i) XT[(64 * rbh + 32 * rb2 + 8 * (i >> 2) + 4 * hf + (i & 3)) * 264 + hq * 64 + 32 * cb + r] = f2bf(acc[rb2][cb][i]);
        __syncthreads();
        {
            const int t2 = tid_fresh();
            u16* yb = Yg + (size_t)row0 * 2048 + 64 * h0 + (t2 & 31) * 8;
            u32x4 zv[8];
#pragma unroll
            for (int e = 0; e < 8; ++e) zv[e] = *(const u32x4*)(yb + (size_t)((t2 >> 5) + 16 * e) * 2048);
#pragma unroll
            for (int e = 0; e < 8; ++e) { const int l = (t2 >> 5) + 16 * e; const u32x4 yv = *(const LAS u32x4*)(XT + l * 264 + (t2 & 31) * 8); const u32x4 z = zv[e];
                float v[8] = {lo_f(yv.x) * lo_f(z.x), hi_f(yv.x) * hi_f(z.x), lo_f(yv.y) * lo_f(z.y), hi_f(yv.y) * hi_f(z.y),
                              lo_f(yv.z) * lo_f(z.z), hi_f(yv.z) * hi_f(z.z), lo_f(yv.w) * lo_f(z.w), hi_f(yv.w) * hi_f(z.w)};
                float sv = 0.f;
#pragma unroll
                for (int j = 0; j < 8; ++j) sv += v[j] * v[j];
#pragma unroll
                for (int o = 16; o >= 1; o >>= 1) sv += __shfl_xor(sv, o);
                if ((t2 & 31) == 0) atomicAdd((float*)(ssq + l), sv);
                u32x4 q; q.x = cvt_pk_bf16(v[0], v[1]); q.y = cvt_pk_bf16(v[2], v[3]); q.z = cvt_pk_bf16(v[4], v[5]); q.w = cvt_pk_bf16(v[6], v[7]);
                *(u32x4*)(yb + (size_t)l * 2048) = q; }
        }
        __syncthreads();
    }
    {
        const int c8 = (tid & 63) * 8;
        const f32x4 w0 = *(const f32x4*)(P.ssm_nw + 512 * g + c8), w1 = *(const f32x4*)(P.ssm_nw + 512 * g + c8 + 4);
        u16* ybase = Yg + (size_t)(row0 + (tid >> 6)) * 2048 + 512 * g + c8;
#pragma unroll
        for (int hb = 0; hb < 2; ++hb) {
            u32x4 qv[8];
#pragma unroll
            for (int i = 0; i < 8; ++i) qv[i] = *(const u32x4*)(ybase + (size_t)(hb * 8 + i) * 8 * 2048);
#pragma unroll
            for (int i = 0; i < 8; ++i) { const int l = (tid >> 6) + 8 * (hb * 8 + i);
                const float rstd = rsqrtf(ssq[l] * (1.0f / 512.0f) + EPSF); const u32x4 q = qv[i];
                u32x4 o; o.x = cvt_pk_bf16(lo_f(q.x) * rstd * w0[0], hi_f(q.x) * rstd * w0[1]); o.y = cvt_pk_bf16(lo_f(q.y) * rstd * w0[2], hi_f(q.y) * rstd * w0[3]);
                o.z = cvt_pk_bf16(lo_f(q.z) * rstd * w1[0], hi_f(q.z) * rstd * w1[1]); o.w = cvt_pk_bf16(lo_f(q.w) * rstd * w1[2], hi_f(q.w) * rstd * w1[3]);
                *(u32x4*)(ybase + (size_t)(hb * 8 + i) * 8 * 2048) = o; }
        }
    }
    __syncthreads();
}

__device__ __forceinline__ void phase_lnb(const Params& P) {
    const int lane = tid_fresh() & 63, gw = blockIdx.x * 8 + (tid_fresh() >> 6), nwv = gridDim.x * 8;
    u16* Yg = (u16*)(P.ws + OFF_Y);
    for (int row = gw; row < TX; row += nwv) {
        u16* p = Yg + (size_t)row * 2048 + 1024 + lane * 8;
        const u32x4 q0 = *(const u32x4*)p, q1 = *(const u32x4*)(p + 512);
        float v[16] = {lo_f(q0.x), hi_f(q0.x), lo_f(q0.y), hi_f(q0.y), lo_f(q0.z), hi_f(q0.z), lo_f(q0.w), hi_f(q0.w), lo_f(q1.x), hi_f(q1.x), lo_f(q1.y), hi_f(q1.y), lo_f(q1.z), hi_f(q1.z), lo_f(q1.w), hi_f(q1.w)};
        float s = 0.f;
#pragma unroll
        for (int j = 0; j < 16; ++j) s += v[j];
        const float mu = wave_sum(s) * (1.0f / 1024.0f);
        float q = 0.f;
#pragma unroll
        for (int j = 0; j < 16; ++j) { v[j] -= mu; q += v[j] * v[j]; }
        const float rstd = rsqrtf(wave_sum(q) * (1.0f / 1024.0f) + EPSF);
        float o[16];
#pragma unroll
        for (int j = 0; j < 16; ++j) { const int col = (j < 8) ? (lane * 8 + j) : (512 + lane * 8 + j - 8); o[j] = silu_f(v[j] * rstd * P.lnw[col] + P.lnb[col]); }
        u32x4 a, bq; a.x = cvt_pk_bf16(o[0], o[1]); a.y = cvt_pk_bf16(o[2], o[3]); a.z = cvt_pk_bf16(o[4], o[5]); a.w = cvt_pk_bf16(o[6], o[7]);
        bq.x = cvt_pk_bf16(o[8], o[9]); bq.y = cvt_pk_bf16(o[10], o[11]); bq.z = cvt_pk_bf16(o[12], o[13]); bq.w = cvt_pk_bf16(o[14], o[15]);
        *(u32x4*)p = a; *(u32x4*)(p + 512) = bq;
    }
}

template <int PH> __device__ __forceinline__ void run_phase(const Params& P, LAS unsigned char* lds) {
    unsigned char* ws = P.ws;
    const float* MOD = (const float*)(ws + OFF_MOD);
    if constexpr (PH == 0) phase_prep(P, lds);
    if constexpr (PH == 1) phase_norm<0>(P, P.x, P.ctx, TT, P.norm_ffn1, 0, 1, (u16*)(ws + OFF_H), nullptr);
    if constexpr (PH == 2) { Gemm gm{(const bf16_t*)(ws + OFF_H), (const bf16_t*)(ws + OFF_WGU1), TT, NGU, 1024}; StaticOrder S; S.init(TT, NGU, (int)gridDim.x, (int)blockIdx.x);
        EpiSwiGLU E{(bf16_t*)(ws + OFF_ACT)}; gemm_phase<EpiSwiGLU, StaticOrder, false>(lds, gm, S, E, nullptr); }
    if constexpr (PH == 3) { Gemm gm{(const bf16_t*)(ws + OFF_ACT), (const bf16_t*)(ws + OFF_WD1), TT, 1024, DFF}; StaticOrder S; S.init(TT, 1024, (int)gridDim.x, (int)blockIdx.x);
        EpiResid E{P.x, P.out, P.ctx, (float*)(ws + OFF_XC1), MOD + 2 * 1024, 0.5f}; gemm_phase<EpiResid, StaticOrder, false>(lds, gm, S, E, nullptr); }
    if constexpr (PH == 4) phase_norm<0>(P, P.out, (const float*)(ws + OFF_XC1), TT, P.norm_mix, 3, 4, (u16*)(ws + OFF_H), nullptr);
    if constexpr (PH == 5) { Gemm gm{(const bf16_t*)(ws + OFF_H), (const bf16_t*)(ws + OFF_WIN), TX, NIN, 1024}; InOrder S; S.init(TX, NIN, (int)gridDim.x, (int)blockIdx.x);
        EpiInProj E{(bf16_t*)(ws + OFF_XBC), (float*)(ws + OFF_DT), (bf16_t*)(ws + OFF_Y), (bf16_t*)(ws + OFF_U)}; gemm_phase<EpiInProj, InOrder, false>(lds, gm, S, E, nullptr); }
    if constexpr (PH == 6) phase_p6(P, lds);
    if constexpr (PH == 7) { for (int it = blockIdx.x; it < 1152; it += gridDim.x) s1_item(P, lds, it); }
    if constexpr (PH == 8) {
        const int mine = (int)(blockIdx.x % 16u); int k = 0; bool done = false;
        for (int it = blockIdx.x; it < 4096; it += gridDim.x, ++k) { if (k == mine) { phase_s2(P); done = true; } uconv_item(P, lds, it); }
        if (!done) phase_s2(P);
    }
    if constexpr (PH == 9) { for (int it = blockIdx.x; it < 1024; it += gridDim.x) s3_item(P, lds, it); phase_lnb(P); }
    if constexpr (PH == 10) { Gemm gm{(const bf16_t*)(ws + OFF_Y), (const bf16_t*)(ws + OFF_WOUT), TX, 1024, 2048}; StaticOrder S; S.init(TX, 1024, (int)gridDim.x, (int)blockIdx.x);
        EpiResid E{P.out, P.out, nullptr, nullptr, MOD + 5 * 1024, 1.0f}; gemm_phase<EpiResid, StaticOrder, false>(lds, gm, S, E, nullptr); }
    if constexpr (PH == 11) phase_norm<0>(P, P.out, nullptr, TX, P.norm_ffn2, 6, 7, (u16*)(ws + OFF_H), nullptr);
    if constexpr (PH == 12) { Gemm gm{(const bf16_t*)(ws + OFF_H), (const bf16_t*)(ws + OFF_WGU2), TX, NGU, 1024}; StaticOrder S; S.init(TX, NGU, (int)gridDim.x, (int)blockIdx.x);
        EpiSwiGLU E{(bf16_t*)(ws + OFF_ACT)}; gemm_phase<EpiSwiGLU, StaticOrder, false>(lds, gm, S, E, nullptr); }
    if constexpr (PH == 13) { Gemm gm{(const bf16_t*)(ws + OFF_ACT), (const bf16_t*)(ws + OFF_WD2), TX, 1024, DFF}; StaticOrder S; S.init(TX, 1024, (int)gridDim.x, (int)blockIdx.x);
        EpiResid E{P.out, P.out, nullptr, nullptr, MOD + 8 * 1024, 0.5f}; gemm_phase<EpiResid, StaticOrder, false>(lds, gm, S, E, nullptr); }
    if constexpr (PH == 14) phase_norm<1>(P, P.out, nullptr, TX, P.fnorm, 0, 0, nullptr, P.out);
}

template <int PH> __global__ void __launch_bounds__(512, 2) k_one(Params P) {
    extern __shared__ __attribute__((aligned(16))) unsigned char shm[];
    run_phase<PH>(P, (LAS unsigned char*)shm);
}

__device__ __forceinline__ void grid_bar(unsigned* ctr, unsigned target) {
    __syncthreads();
    if (tid_fresh() == 0) {
        __builtin_amdgcn_fence(__ATOMIC_RELEASE, "agent");
        __hip_atomic_fetch_add(ctr, 1u, __ATOMIC_RELAXED, __HIP_MEMORY_SCOPE_AGENT);
        unsigned v;
        do { __builtin_amdgcn_s_sleep(1); v = __hip_atomic_load(ctr, __ATOMIC_RELAXED, __HIP_MEMORY_SCOPE_AGENT); asm volatile("" : "+v"(v)); } while (v < target);
        __builtin_amdgcn_fence(__ATOMIC_ACQUIRE, "agent");
    }
    __syncthreads();
}
template <int PH> __device__ __forceinline__ void run_all(const Params& P, LAS unsigned char* lds, cg::grid_group& grid) {
    unsigned* ctr = (unsigned*)(P.ws + OFF_BAR);
    if constexpr (PH == 0) { if (blockIdx.x == 0 && threadIdx.x == 0) __hip_atomic_store(ctr, 0u, __ATOMIC_RELAXED, __HIP_MEMORY_SCOPE_AGENT); }
    run_phase<PH>(P, lds);
    if constexpr (PH + 1 < NPHASE) {
        if constexpr (PH == 0) grid.sync(); else grid_bar(ctr, (unsigned)PH * gridDim.x);
        run_all<PH + 1>(P, lds, grid);
    }
}
__global__ void __launch_bounds__(512, 2) mega(Params P) {
    extern __shared__ __attribute__((aligned(16))) unsigned char shm[];
    cg::grid_group grid = cg::this_grid();
    run_all<0>(P, (LAS unsigned char*)shm, grid);
}

template <int PH> static void launch_each(int grid, hipStream_t stream, const Params& p) {
    static bool attr = false; if (!attr) { (void)hipFuncSetAttribute((const void*)k_one<PH>, hipFuncAttributeMaxDynamicSharedMemorySize, LDS_BYTES); attr = true; }
    hipLaunchKernelGGL(k_one<PH>, dim3(grid), dim3(512), LDS_BYTES, stream, p);
    if constexpr (PH + 1 < NPHASE) launch_each<PH + 1>(grid, stream, p);
}

#ifndef MK_MULTI
#define MK_MULTI 0
#endif
extern "C" void kernel_launch(void* const* d_in, const int* in_sizes, int n_in, void* d_out, int out_size, void* d_ws, size_t ws_size, hipStream_t stream) {
    static int grid = 0;
    if (grid == 0) {
        if (n_in != 30 || ws_size < WS_TOTAL) { fprintf(stderr, "kernel_launch: expected 30 inputs and >= %zu bytes of workspace (got %d, %zu)\n", (size_t)WS_TOTAL, n_in, ws_size); grid = -1; return; }
        int dev = 0, cus = 0, per_cu = 0;
        (void)hipGetDevice(&dev); (void)hipDeviceGetAttribute(&cus, hipDeviceAttributeMultiprocessorCount, dev);
        if (hipFuncSetAttribute((const void*)mega, hipFuncAttributeMaxDynamicSharedMemorySize, LDS_BYTES) != hipSuccess) { fprintf(stderr, "kernel_launch: hipFuncSetAttribute failed\n"); }
        if (hipOccupancyMaxActiveBlocksPerMultiprocessor(&per_cu, (const void*)mega, 512, LDS_BYTES) != hipSuccess || per_cu < 1) { fprintf(stderr, "kernel_launch: occupancy query says %d\n", per_cu); per_cu = 1; }
        (void)hipGetLastError();
        grid = cus * per_cu;
    }
    if (grid < 0) return;
    Params p{};
    const float** pp = (const float**)&p;
    for (int i = 0; i < 30; ++i) pp[i] = (const float*)d_in[i];
    p.out = (float*)d_out; p.ws = (unsigned char*)d_ws;
#if MK_MULTI
    launch_each<0>(grid, stream, p);
#else
    void* args[] = {&p};
    hipError_t e = hipLaunchCooperativeKernel((const void*)mega, dim3(grid), dim3(512), args, LDS_BYTES, stream);
    if (e != hipSuccess) fprintf(stderr, "kernel_launch: cooperative launch failed: %s (grid %d)\n", hipGetErrorString(e), grid);
#endif
}
```

```cpp
#include <hip/hip_runtime.h>
#include <hip/hip_cooperative_groups.h>
#include <cstdio>
namespace cg = cooperative_groups;
__device__ __forceinline__ int tid_fresh() { int t = (int)threadIdx.x; asm volatile("" : "+v"(t)); return t; }
namespace pg8 {
#define PG8_LAS __attribute__((address_space(3)))
typedef unsigned short bf16_t;
typedef short bf16x8 __attribute__((ext_vector_type(8)));
typedef float f32x4 __attribute__((ext_vector_type(4)));
typedef unsigned u32x4 __attribute__((ext_vector_type(4)));
constexpr int BM = 256, BK = 64, HALF = 128, HTB = HALF * BK * 2  , STAGE_BYTES = 8 * HTB, NXCD = 8, WGM = 8;

__host__ __device__ __forceinline__ int lds_byte(int r, int c) { const int st = (r >> 4) * 2 + (c >> 5), rr = r & 15, cc = c & 31, ob = rr * 64 + cc * 2; return st * 1024 + (ob ^ (((ob >> 9) & 1) << 5)); }
__host__ __device__ __forceinline__ void stage_rc(int b, int& R, int& C) { const int st = b / 1024, sb = b % 1024, swz = sb ^ (((sb >> 9) & 1) << 5); R = (st >> 1) * 16 + swz / 64; C = (st & 1) * 32 + (swz % 64) / 2; }
__host__ __device__ __forceinline__ int perm32(int rho) { const int n = rho >> 4, i = rho & 15; return 8 * (i >> 2) + 4 * n + (i & 3); }

struct Unit { int pm, pn; };
struct Gemm { const bf16_t* A; const bf16_t* Bt; int M, N, K; };

struct StaticOrder {
    int nM, nN, nwg, G, c;
    __host__ __device__ void init(int M, int N, int G_, int c_) { nM = M / BM; nN = N / BM; nwg = nM * nN; G = G_; c = c_; }
    __host__ __device__ bool next(int i, Unit& u) const {
        const long L = (long)i * G + c; if (L >= nwg) return false;
        int wgid = (int)L; { const int q = nwg / NXCD, r = nwg % NXCD, xcd = wgid % NXCD, off = wgid / NXCD; wgid = (xcd < r ? xcd * (q + 1) : r * (q + 1) + (xcd - r) * q) + off; }
        const int nig = WGM * nN, gid = wgid / nig, fm = gid * WGM, gsz = (nM - fm) < WGM ? (nM - fm) : WGM;
        u.pm = fm + ((wgid % nig) % gsz); u.pn = (wgid % nig) / gsz; return true;
    }
    __device__ __forceinline__ void a_ready(const Unit&) const {}
    __device__ __forceinline__ void done(const Unit&) const {}
};
__device__ __forceinline__ unsigned cvt_pk_bf16(float lo, float hi) { unsigned r; asm volatile("v_cvt_pk_bf16_f32 %0, %1, %2" : "=v"(r) : "v"(lo), "v"(hi)); return r; }
typedef float f32x2 __attribute__((ext_vector_type(2)));
template <class Epi, class Sched, bool STAMP = false>
__device__ __forceinline__ void gemm_phase(PG8_LAS unsigned char* lds, const Gemm g, const Sched& S, const Epi& E, unsigned long long* stamps) {
    const int tid = tid_fresh(), wid = __builtin_amdgcn_readfirstlane(tid >> 6), lane = tid & 63, wr = wid >> 2, wc = wid & 3, fr = lane & 15, fq = lane >> 4;
    const int K = g.K, nt = K / BK;
    int ts_lo = 0, ts_hi = 0, nts = 0; const unsigned long long rt_entry = STAMP ? (unsigned long long)wall_clock64() : 0ull;
#define PG8_STAMP() do { if (STAMP && wid == 0 && nts < 64) { const unsigned long long _c = (unsigned long long)clock64(); \
        ts_lo = (lane == nts) ? (int)(unsigned)_c : ts_lo; ts_hi = (lane == nts) ? (int)(unsigned)(_c >> 32) : ts_hi; ++nts; } } while (0)
    PG8_STAMP();
    unsigned voffA[2], voffB[2];
#pragma unroll
    for (int i = 0; i < 2; ++i) { int R, C; stage_rc(tid * 16 + i * 8192, R, C); const int Rb = Epi::PERM ? ((R & ~31) + perm32(R & 31)) : R;
        voffA[i] = (unsigned)(R * K + C) * 2u; voffB[i] = (unsigned)(Rb * K + C) * 2u; }
    const size_t kstep = (size_t)(BK * 2);
    const size_t hstep = (size_t)HALF * K * 2;
    const size_t tstep = 2 * hstep;
    const unsigned ldsw = (unsigned)wid * 1024u;
    const int aoff = lds_byte(wr * 64 + fr, fq * 8), boff = lds_byte(wc * 32 + fr, fq * 8);
#define PG8_SA(b, h) (((b) * 2 + (h)) * HTB)
#define PG8_SB(b, h) ((4 + (b) * 2 + (h)) * HTB)
#define PG8_STAGE(bufoff, gbase, voff) do { _Pragma("unroll") for (int _i = 0; _i < 2; ++_i) \
        __builtin_amdgcn_global_load_lds((const unsigned*)((const char*)(gbase) + (voff)[_i]), (PG8_LAS unsigned*)(lds + (bufoff) + ldsw + _i * 8192), 16, 0, 0); } while (0)
#define PG8_LDA(dst, b, h) do { _Pragma("unroll") for (int m = 0; m < 4; ++m) _Pragma("unroll") for (int k = 0; k < 2; ++k) dst[m][k] = *(const PG8_LAS bf16x8*)(lds + PG8_SA(b, h) + aoff + m * 2048 + k * 1024); } while (0)
#define PG8_LDB(dst, b, h) do { _Pragma("unroll") for (int n = 0; n < 2; ++n) _Pragma("unroll") for (int k = 0; k < 2; ++k) dst[n][k] = *(const PG8_LAS bf16x8*)(lds + PG8_SB(b, h) + boff + n * 2048 + k * 1024); } while (0)
#define PG8_MMA(ai, bj, At, Bt) do { __builtin_amdgcn_s_setprio(1); _Pragma("unroll") for (int m = 0; m < 4; ++m) _Pragma("unroll") for (int n = 0; n < 2; ++n) _Pragma("unroll") for (int k = 0; k < 2; ++k) \
        acc[ai][bj][m][n] = __builtin_amdgcn_mfma_f32_16x16x32_bf16(Bt[n][k], At[m][k], acc[ai][bj][m][n], 0, 0, 0); __builtin_amdgcn_s_setprio(0); } while (0)
#define PG8_WAIT_V(n) asm volatile("s_waitcnt vmcnt(" #n ")" ::: "memory")
#define PG8_WAIT_L(n) asm volatile("s_waitcnt lgkmcnt(" #n ")" ::: "memory")
#define PG8_BAR __builtin_amdgcn_s_barrier()
#define PG8_SCHED __builtin_amdgcn_sched_barrier(0)
    Unit cur, nxt; int ui = 0;
    if (!S.next(0, cur)) return;
    f32x4 acc[2][2][4][2];
#pragma unroll
    for (int a = 0; a < 2; ++a)
#pragma unroll
        for (int b = 0; b < 2; ++b)
#pragma unroll
            for (int m = 0; m < 4; ++m)
#pragma unroll
                for (int n = 0; n < 2; ++n) acc[a][b][m][n] = (f32x4){0.f, 0.f, 0.f, 0.f};
    bf16x8 At[4][2], B0[2][2], B1[2][2];
    const char* cA = (const char*)g.A + (size_t)cur.pm * tstep; const char* cB = (const char*)g.Bt + (size_t)cur.pn * tstep;
    S.a_ready(cur);
    PG8_STAGE(PG8_SB(0, 0), cB, voffB); PG8_STAGE(PG8_SA(0, 0), cA, voffA); PG8_STAGE(PG8_SB(0, 1), cB + hstep, voffB); PG8_STAGE(PG8_SA(0, 1), cA + hstep, voffA);
    if (wr == 1) PG8_BAR;
    PG8_WAIT_V(4); PG8_BAR;
    PG8_STAGE(PG8_SB(1, 0), cB + kstep, voffB); PG8_STAGE(PG8_SA(1, 0), cA + kstep, voffA); PG8_STAGE(PG8_SB(1, 1), cB + hstep + kstep, voffB);
    PG8_WAIT_V(6); PG8_BAR;
    PG8_STAMP();
    for (;;) {
        const bool has_next = S.next(ui + 1, nxt);
        const char* nA = has_next ? (const char*)g.A + (size_t)nxt.pm * tstep : cA; const char* nB = has_next ? (const char*)g.Bt + (size_t)nxt.pn * tstep : cB;
        for (int t = 0; t < nt; t += 2) {
            const bool last = (t == nt - 2);
            const char* a1 = cA + (size_t)(t + 1) * kstep;
            const char* a2 = last ? nA : cA + (size_t)(t + 2) * kstep; const char* b2 = last ? nB : cB + (size_t)(t + 2) * kstep;
            const char* a3 = a2 + kstep; const char* b3 = b2 + kstep;
            if (last && has_next) S.a_ready(nxt);
            PG8_LDB(B0, 0, 0); PG8_SCHED; PG8_LDA(At, 0, 0); PG8_STAGE(PG8_SA(1, 1), a1 + hstep, voffA);
            PG8_WAIT_L(8); PG8_BAR; PG8_WAIT_L(0); PG8_MMA(0, 0, At, B0); PG8_BAR; PG8_SCHED;
            PG8_LDB(B1, 0, 1); PG8_STAGE(PG8_SB(0, 0), b2, voffB);
            PG8_BAR; PG8_WAIT_L(0); PG8_MMA(0, 1, At, B1); PG8_BAR;
            PG8_LDA(At, 0, 1); PG8_STAGE(PG8_SA(0, 0), a2, voffA);
            PG8_BAR; PG8_WAIT_L(0); PG8_MMA(1, 0, At, B0); PG8_BAR; PG8_SCHED;
            PG8_STAGE(PG8_SB(0, 1), b2 + hstep, voffB);
            PG8_WAIT_V(6); PG8_BAR; PG8_MMA(1, 1, At, B1); PG8_BAR;
            PG8_LDB(B0, 1, 0); PG8_SCHED; PG8_LDA(At, 1, 0); PG8_STAGE(PG8_SA(0, 1), a2 + hstep, voffA);
            PG8_WAIT_L(8); PG8_BAR; PG8_WAIT_L(0); PG8_MMA(0, 0, At, B0); PG8_BAR; PG8_SCHED;
            PG8_LDB(B1, 1, 1); PG8_STAGE(PG8_SB(1, 0), b3, voffB);
            PG8_BAR; PG8_WAIT_L(0); PG8_MMA(0, 1, At, B1); PG8_BAR;
            PG8_LDA(At, 1, 1); PG8_STAGE(PG8_SA(1, 0), a3, voffA);
            PG8_BAR; PG8_WAIT_L(0); PG8_MMA(1, 0, At, B0); PG8_BAR; PG8_SCHED;
            PG8_STAGE(PG8_SB(1, 1), b3 + hstep, voffB);
            PG8_WAIT_V(6); PG8_BAR; PG8_MMA(1, 1, At, B1); PG8_BAR;
        }
        PG8_STAMP();
        if constexpr (!Epi::AFTER_DRAIN) { E(acc, cur, wr, wc, fr, fq); S.done(cur); }
        PG8_STAMP();
        if (!has_next) break;
#pragma unroll
        for (int a = 0; a < 2; ++a)
#pragma unroll
            for (int b = 0; b < 2; ++b)
#pragma unroll
                for (int m = 0; m < 4; ++m)
#pragma unroll
                    for (int n = 0; n < 2; ++n) acc[a][b][m][n] = (f32x4){0.f, 0.f, 0.f, 0.f};
        cur = nxt; cA = nA; cB = nB; ++ui;
    }
    PG8_WAIT_V(0);
    if (wr == 0) PG8_BAR;
    PG8_BAR;
    if constexpr (Epi::AFTER_DRAIN) { E.fused(acc, cur, wr, wc, fr, fq, lds, wid, lane); S.done(cur); }
    PG8_STAMP();
    if (STAMP && wid == 0) { stamps[lane] = lane < nts ? (((unsigned long long)(unsigned)ts_hi << 32) | (unsigned)ts_lo) : 0ull;
        if (lane == 62) stamps[62] = rt_entry; if (lane == 63) stamps[63] = (unsigned long long)wall_clock64(); }
#undef PG8_STAMP
#undef PG8_SA
#undef PG8_SB
#undef PG8_STAGE
#undef PG8_LDA
#undef PG8_LDB
#undef PG8_MMA
#undef PG8_WAIT_V
#undef PG8_WAIT_L
#undef PG8_BAR
#undef PG8_SCHED
}
}
using namespace pg8;
#define LAS __attribute__((address_space(3)))
typedef unsigned short u16;
typedef unsigned int u32;
typedef float f32x16 __attribute__((ext_vector_type(16)));
typedef unsigned int u32x2 __attribute__((ext_vector_type(2)));

constexpr int TX = 65536, TCX = 8192, TT = 73728;
constexpr int DFF = 2816, NGU = 5632, NIN = 4864;
constexpr float EPSF = 1e-6f;
constexpr int LDS_BYTES = 160768;
constexpr int NPHASE = 15;

constexpr size_t SZ_WGU = (size_t)NGU * 1024 * 2, SZ_WD = (size_t)1024 * DFF * 2, SZ_WIN = (size_t)NIN * 1024 * 2, SZ_WOUT = (size_t)1024 * 2048 * 2;
constexpr size_t OFF_WGU1 = 0, OFF_WD1 = OFF_WGU1 + SZ_WGU, OFF_WGU2 = OFF_WD1 + SZ_WD, OFF_WD2 = OFF_WGU2 + SZ_WGU, OFF_WIN = OFF_WD2 + SZ_WD, OFF_WOUT = OFF_WIN + SZ_WIN;
constexpr size_t OFF_MOD = OFF_WOUT + SZ_WOUT;
constexpr size_t OFF_XC1 = OFF_MOD + (size_t)33 * 9216 * 4;
constexpr size_t OFF_DT = OFF_XC1 + (size_t)TCX * 1024 * 4;
constexpr size_t SZ_A16 = (size_t)TT * 16 * 4;
constexpr size_t OFF_DTF = OFF_DT + (size_t)TT * 32 * 4, OFF_DTB = OFF_DTF + SZ_A16, OFF_CSF = OFF_DTB + SZ_A16, OFF_CSB = OFF_CSF + SZ_A16;
constexpr size_t OFF_CDEC = OFF_CSB + SZ_A16;
constexpr size_t OFF_BAR = OFF_CDEC + (size_t)32 * 2 * 18 * 16 * 4;
constexpr size_t OFF_BIG = OFF_BAR + 256;
constexpr size_t SZ_H = (size_t)TT * 1024 * 2, SZ_ACT = (size_t)TT * DFF * 2, SZ_ST = (size_t)32 * 2 * 17 * 16 * 8192 * 2;
constexpr size_t OFF_H = OFF_BIG, OFF_ACT = OFF_BIG + SZ_H, OFF_ST = OFF_BIG;
constexpr size_t WS_TOTAL = (size_t)1 << 30;
constexpr size_t OFF_U = WS_TOTAL - (size_t)TX * 1024 * 2, OFF_XBC = OFF_U - (size_t)TT * 1536 * 2, OFF_Y = OFF_XBC - (size_t)TX * 2048 * 2;
static_assert(OFF_BIG % 256 == 0 && OFF_ACT + SZ_ACT <= WS_TOTAL && OFF_Y >= OFF_ST + SZ_ST && OFF_Y >= OFF_H + SZ_H, "workspace map");

struct Params {
    const float *x, *c, *ctx, *c_ctx, *w_mod, *b_mod, *norm_ffn1, *g1, *u1, *d1, *norm_mix, *w_in, *scw, *scb, *dtbf, *dtbb, *alf, *alb, *ssm_d, *ssm_nw, *ccw, *ccb, *lnw, *lnb,
        *w_out, *norm_ffn2, *g2, *u2, *d2, *fnorm;
    float* out; unsigned char* ws; int ph_lo, ph_hi;
};

__device__ __forceinline__ float bf2f(u16 v) { return __uint_as_float(((u32)v) << 16); }
__device__ __forceinline__ u16 f2bf(float f) { u32 u = __float_as_uint(f); u += 0x7FFFu + ((u >> 16) & 1u); return (u16)(u >> 16); }
__device__ __forceinline__ float lo_f(u32 v) { return __uint_as_float(v << 16); }
__device__ __forceinline__ float hi_f(u32 v) { return __uint_as_float(v & 0xffff0000u); }
__device__ __forceinline__ float silu_f(float x) { return x * __builtin_amdgcn_rcpf(1.0f + __expf(-x)); }
__device__ __forceinline__ float sigm_f(float x) { return __builtin_amdgcn_rcpf(1.0f + __expf(-x)); }
#define LDS_BARRIER() do { asm volatile("s_waitcnt lgkmcnt(0)" ::: "memory"); __builtin_amdgcn_s_barrier(); asm volatile("" ::: "memory"); } while (0)
__device__ __forceinline__ float wave_sum(float v) {
#pragma unroll
    for (int o = 32; o >= 1; o >>= 1) v += __shfl_xor(v, o);
    return v;
}

typedef float f32x2v __attribute__((ext_vector_type(2)));
__device__ __forceinline__ f32x2v sigm2(f32x2v x) { f32x2v e = x * (-1.4426950408889634f); e[0] = __builtin_amdgcn_exp2f(e[0]); e[1] = __builtin_amdgcn_exp2f(e[1]); e = e + 1.0f;
    f32x2v r; r[0] = __builtin_amdgcn_rcpf(e[0]); r[1] = __builtin_amdgcn_rcpf(e[1]); return r; }
__device__ __forceinline__ unsigned swiglu_pk(float g0, float g1, float u0, float u1) { const f32x2v g = {g0, g1}, u = {u0, u1}; const f32x2v o = (g * sigm2(g)) * u; return cvt_pk_bf16(o[0], o[1]); }
__device__ __forceinline__ unsigned glu_pk(float a0, float a1, float b0, float b1) { const f32x2v a = {a0, a1}, b = {b0, b1}; const f32x2v o = a * sigm2(b); return cvt_pk_bf16(o[0], o[1]); }
struct InOrder : StaticOrder {
    __device__ bool next(int i, Unit& u) const {
        const long L = (long)i * G + c;
        if (L < nwg) return StaticOrder::next(i, u);
        const int e = (int)(L - nwg); if (e >= 192) return false;
        u.pm = 256 + (e & 31); u.pn = e >> 5; return true;
    }
};

struct EpiSwiGLU {
    static constexpr bool PERM = true, AFTER_DRAIN = false;
    bf16_t* O;
    __device__ __forceinline__ void operator()(const f32x4 (&acc)[2][2][4][2], const Unit& u, int wr, int wc, int fr, int fq) const {
        const int row0 = u.pm * BM + wr * 64 + fr, col0 = u.pn * 128 + wc * 32 + 8 * fq;
#pragma unroll
        for (int ai = 0; ai < 2; ++ai)
#pragma unroll
            for (int m = 0; m < 4; ++m) {
                bf16_t* rowp = O + (size_t)(row0 + ai * HALF + m * 16) * DFF + col0;
                const f32x4 g0 = acc[ai][0][m][0], g1 = acc[ai][0][m][1], u0 = acc[ai][1][m][0], u1 = acc[ai][1][m][1];
                u32x4 w;
                w.x = swiglu_pk(g0[0], g0[1], u0[0], u0[1]); w.y = swiglu_pk(g0[2], g0[3], u0[2], u0[3]);
                w.z = swiglu_pk(g1[0], g1[1], u1[0], u1[1]); w.w = swiglu_pk(g1[2], g1[3], u1[2], u1[3]);
                *(u32x4*)rowp = w;
            }
    }
};

struct EpiResid {
    static constexpr bool PERM = false, AFTER_DRAIN = false;
    const float* baseX; float* outX; const float* baseC; float* outC; const float* mod; float s;
    __device__ __forceinline__ void operator()(const f32x4 (&acc)[2][2][4][2], const Unit& u, int wr, int wc, int fr, int fq) const {
        const int row0 = u.pm * BM + wr * 64 + fr, col0 = u.pn * BM + wc * 32 + 4 * fq;
        const bool isx = u.pm < 256; const int b = isx ? (u.pm >> 3) : 32;
        const float* bp0 = isx ? baseX + (size_t)row0 * 1024 : baseC + (size_t)(row0 - TX) * 1024;
        float* op0 = isx ? outX + (size_t)row0 * 1024 : outC + (size_t)(row0 - TX) * 1024;
        f32x4 mv[2][2];
#pragma unroll
        for (int bj = 0; bj < 2; ++bj)
#pragma unroll
            for (int n = 0; n < 2; ++n) mv[bj][n] = *(const f32x4*)(mod + (size_t)b * 9216 + col0 + bj * HALF + n * 16) * s;
#pragma unroll
        for (int ai = 0; ai < 2; ++ai)
#pragma unroll
            for (int m = 0; m < 4; ++m) {
                const size_t ro = (size_t)(ai * HALF + m * 16) * 1024 + col0;
                f32x4 bv[2][2];
#pragma unroll
                for (int bj = 0; bj < 2; ++bj)
#pragma unroll
                    for (int n = 0; n < 2; ++n) bv[bj][n] = *(const f32x4*)(bp0 + ro + bj * HALF + n * 16);
#pragma unroll
                for (int bj = 0; bj < 2; ++bj)
#pragma unroll
                    for (int n = 0; n < 2; ++n) *(f32x4*)(op0 + ro + bj * HALF + n * 16) = bv[bj][n] + mv[bj][n] * acc[ai][bj][m][n];
            }
    }
};

template <int BT, int OT>
struct EpiResidT {
    static constexpr bool PERM = false, AFTER_DRAIN = false;
    const void* baseX; void* outX; const void* baseC; void* outC; const float* mod; float s;
    __device__ __forceinline__ void operator()(const f32x4 (&acc)[2][2][4][2], const Unit& u, int wr, int wc, int fr, int fq) const {
        const int row0 = u.pm * BM + wr * 64 + fr, col0 = u.pn * BM + wc * 32 + 4 * fq;
        const bool isx = u.pm < 256; const int b = isx ? (u.pm >> 3) : 32;
        const size_t eo = (size_t)(isx ? row0 : row0 - TX) * 1024 + col0;
        const char* bp0 = (const char*)(isx ? baseX : baseC) + eo * (BT ? 2 : 4);
        char* op0 = (char*)(isx ? outX : outC) + eo * (OT ? 2 : 4);
        f32x4 mv[2][2];
#pragma unroll
        for (int bj = 0; bj < 2; ++bj)
#pragma unroll
            for (int n = 0; n < 2; ++n) mv[bj][n] = *(const f32x4*)(mod + (size_t)b * 9216 + col0 + bj * HALF + n * 16) * s;
#pragma unroll
        for (int ai = 0; ai < 2; ++ai)
#pragma unroll
            for (int m = 0; m < 4; ++m) {
                const size_t ro = (size_t)(ai * HALF + m * 16) * 1024;
                f32x4 bv[2][2];
#pragma unroll
                for (int bj = 0; bj < 2; ++bj)
#pragma unroll
                    for (int n = 0; n < 2; ++n) { const size_t e = ro + bj * HALF + n * 16;
                        if (BT) { const u32x2 q = *(const u32x2*)(bp0 + e * 2); bv[bj][n] = (f32x4){lo_f(q.x), hi_f(q.x), lo_f(q.y), hi_f(q.y)}; }
                        else bv[bj][n] = *(const f32x4*)(bp0 + e * 4); }
#pragma unroll
                for (int bj = 0; bj < 2; ++bj)
#pragma unroll
                    for (int n = 0; n < 2; ++n) { const size_t e = ro + bj * HALF + n * 16; const f32x4 x = bv[bj][n] + mv[bj][n] * acc[ai][bj][m][n];
                        if (OT) { u32x2 q; q.x = cvt_pk_bf16(x[0], x[1]); q.y = cvt_pk_bf16(x[2], x[3]); *(u32x2*)(op0 + e * 2) = q; }
                        else *(f32x4*)(op0 + e * 4) = x; }
            }
    }
};

struct EpiInProj {
    static constexpr bool PERM = true, AFTER_DRAIN = false;
    bf16_t* XBC; float* DT; bf16_t* Y; bf16_t* U;
    __device__ __forceinline__ void operator()(const f32x4 (&acc)[2][2][4][2], const Unit& u, int wr, int wc, int fr, int fq) const {
        const int row0 = u.pm * BM + wr * 64 + fr, cin = wc * 32 + 8 * fq, pn = u.pn;
        if (pn == 5) {
            if (wc == 0) {
#pragma unroll
                for (int ai = 0; ai < 2; ++ai)
#pragma unroll
                    for (int m = 0; m < 4; ++m) {
                        float* rp = DT + (size_t)(row0 + ai * HALF + m * 16) * 32 + 8 * fq;
                        *(f32x4*)rp = acc[ai][0][m][0]; *(f32x4*)(rp + 4) = acc[ai][0][m][1];
                    }
            }
        } else if (pn <= 10) {
            bf16_t* base; int ld;
            if (pn <= 4) { base = XBC + pn * 256; ld = 1536; } else if (pn == 6) { base = XBC + 1280; ld = 1536; } else { base = Y + (pn - 7) * 256; ld = 2048; }
#pragma unroll
            for (int ai = 0; ai < 2; ++ai)
#pragma unroll
                for (int m = 0; m < 4; ++m) {
                    bf16_t* rowp = base + (size_t)(row0 + ai * HALF + m * 16) * ld + cin;
#pragma unroll
                    for (int bj = 0; bj < 2; ++bj) {
                        f32x4 v0 = acc[ai][bj][m][0], v1 = acc[ai][bj][m][1];
                        if (pn >= 7) {
#pragma unroll
                            for (int j = 0; j < 4; ++j) { v0[j] = silu_f(v0[j]); v1[j] = silu_f(v1[j]); } }
                        u32x4 w; w.x = cvt_pk_bf16(v0[0], v0[1]); w.y = cvt_pk_bf16(v0[2], v0[3]); w.z = cvt_pk_bf16(v1[0], v1[1]); w.w = cvt_pk_bf16(v1[2], v1[3]);
                        *(u32x4*)(rowp + bj * HALF) = w;
                    }
                }
        } else {
            bf16_t* base = U + (pn - 11) * 128 + cin;
#pragma unroll
            for (int ai = 0; ai < 2; ++ai)
#pragma unroll
                for (int m = 0; m < 4; ++m) {
                    bf16_t* rowp = base + (size_t)(row0 + ai * HALF + m * 16) * 1024;
                    const f32x4 a0 = acc[ai][0][m][0], a1 = acc[ai][0][m][1], b0 = acc[ai][1][m][0], b1 = acc[ai][1][m][1];
                    u32x4 w;
                    w.x = glu_pk(a0[0], a0[1], b0[0], b0[1]); w.y = glu_pk(a0[2], a0[3], b0[2], b0[3]);
                    w.z = glu_pk(a1[0], a1[1], b1[0], b1[1]); w.w = glu_pk(a1[2], a1[3], b1[2], b1[3]);
                    *(u32x4*)rowp = w;
                }
        }
    }
};

__device__ __forceinline__ void prep_mod_item(const Params& P, LAS unsigned char* lds, int it) {
    const int tid = tid_fresh();
    LAS float* cc = (LAS float*)lds;
    for (int i = tid; i < 33 * 1024; i += 512) { const int r = i >> 10, k = i & 1023; const float v = (r < 32) ? P.c[r * 1024 + k] : P.c_ctx[k]; cc[i] = silu_f(v); }
    __syncthreads();
    const int n0 = it * 64, col = tid & 63, kk = tid >> 6;
    float acc[33];
#pragma unroll
    for (int r = 0; r < 33; ++r) acc[r] = 0.f;
    const float* wp = P.w_mod + (size_t)(kk * 128) * 9216 + n0 + col;
    float wv[16], wn[16];
#pragma unroll
    for (int i = 0; i < 16; ++i) wv[i] = wp[(size_t)i * 9216];
#pragma unroll 1
    for (int kc = 0; kc < 8; ++kc) {
        if (kc < 7) {
#pragma unroll
            for (int i = 0; i < 16; ++i) wn[i] = wp[(size_t)((kc + 1) * 16 + i) * 9216]; }
#pragma unroll
        for (int q = 0; q < 4; ++q)
#pragma unroll
            for (int r = 0; r < 33; ++r) { const f32x4 c4 = *(const LAS f32x4*)(cc + r * 1024 + kk * 128 + kc * 16 + q * 4);
                acc[r] += c4[0] * wv[4 * q] + c4[1] * wv[4 * q + 1] + c4[2] * wv[4 * q + 2] + c4[3] * wv[4 * q + 3]; }
#pragma unroll
        for (int i = 0; i < 16; ++i) wv[i] = wn[i];
    }
    __syncthreads();
    LAS float* red = (LAS float*)lds;
#pragma unroll
    for (int r = 0; r < 33; ++r) red[(kk * 33 + r) * 64 + col] = acc[r];
    __syncthreads();
    float* MOD = (float*)(P.ws + OFF_MOD);
    for (int o = tid; o < 33 * 64; o += 512) { const int r = o >> 6, cl = o & 63; float s = 0.f;
#pragma unroll
        for (int q = 0; q < 8; ++q) s += red[(q * 33 + r) * 64 + cl];
        MOD[(size_t)r * 9216 + n0 + cl] = s + P.b_mod[n0 + cl]; }
    __syncthreads();
}

struct TileD { const float* src; u16* dst; int sld, nvalid, dld; };
__device__ __forceinline__ TileD prep_decode(const Params& P, int t) {
    const float* src; int sld, scol0, nvalid = 64, kt, n0, dld; u16* dst;
    if (t < 2816) {
        const int f = t >= 1408; const int tt = t - f * 1408; const int nt = tt >> 4; kt = tt & 15; n0 = nt * 64;
        const int j = n0 >> 8, s0 = n0 & 255;
        src = (s0 < 128) ? (f ? P.g2 : P.g1) : (f ? P.u2 : P.u1); scol0 = 128 * j + (s0 & 127); sld = DFF;
        dst = (u16*)(P.ws + (f ? OFF_WGU2 : OFF_WGU1)); dld = 1024;
    } else if (t < 2816 + 1408) {
        const int t2 = t - 2816; const int f = t2 >= 704; const int tt = t2 - f * 704; const int nt = tt / 44; kt = tt % 44; n0 = nt * 64;
        src = f ? P.d2 : P.d1; scol0 = n0; sld = 1024; dst = (u16*)(P.ws + (f ? OFF_WD2 : OFF_WD1)); dld = DFF;
    } else if (t < 2816 + 1408 + 1216) {
        const int tt = t - 4224; const int nt = tt >> 4; kt = tt & 15; n0 = nt * 64;
        const int pn = n0 >> 8, s0 = n0 & 255;
        if (pn < 4) scol0 = 1024 + n0; else if (pn == 4) scol0 = 2048 + s0; else if (pn == 5) { scol0 = 2560; nvalid = s0 ? 0 : 32; }
        else if (pn == 6) scol0 = 2304 + s0; else if (pn <= 10) scol0 = n0 - 1792;
        else { const int j = pn - 11; scol0 = (s0 < 128) ? (2592 + 128 * j + s0) : (2592 + 1024 + 128 * j + (s0 - 128)); }
        src = P.w_in; sld = 4640; dst = (u16*)(P.ws + OFF_WIN); dld = 1024;
    } else {
        const int tt = t - 5440; const int nt = tt >> 5; kt = tt & 31; n0 = nt * 64;
        src = P.w_out; scol0 = n0; sld = 1024; dst = (u16*)(P.ws + OFF_WOUT); dld = 2048;
    }
    TileD d; d.src = src + (size_t)(kt * 64) * sld + scol0; d.dst = dst + (size_t)n0 * dld + kt * 64; d.sld = sld; d.nvalid = nvalid; d.dld = dld; return d;
}
__device__ __forceinline__ void prep_load(const TileD& d, int tid, float (&v)[8]) {
#pragma unroll
    for (int e = 0; e < 8; ++e) { const int idx = tid + 512 * e, kk = idx >> 6, nn = idx & 63; v[e] = (nn < d.nvalid) ? d.src[(size_t)kk * d.sld + nn] : 0.f; }
}
__device__ __forceinline__ void prep_store(const TileD& d, int tid, const float (&v)[8], LAS unsigned char* lds) {
    LAS float* tile = (LAS float*)lds;
#pragma unroll
    for (int e = 0; e < 8; ++e) { const int idx = tid + 512 * e, kk = idx >> 6, nn = idx & 63; tile[kk * 65 + nn] = v[e]; }
    __syncthreads();
    { const int nn = tid >> 3, ks = (tid & 7) * 8; u32x4 w;
      w.x = cvt_pk_bf16(tile[(ks + 0) * 65 + nn], tile[(ks + 1) * 65 + nn]); w.y = cvt_pk_bf16(tile[(ks + 2) * 65 + nn], tile[(ks + 3) * 65 + nn]);
      w.z = cvt_pk_bf16(tile[(ks + 4) * 65 + nn], tile[(ks + 5) * 65 + nn]); w.w = cvt_pk_bf16(tile[(ks + 6) * 65 + nn], tile[(ks + 7) * 65 + nn]);
      *(u32x4*)(d.dst + (size_t)nn * d.dld + ks) = w; }
    __syncthreads();
}

__device__ __forceinline__ void phase_prep(const Params& P, LAS unsigned char* lds) {
    constexpr int NMOD = 144, NTILE = 2816 + 1408 + 1216 + 512;
    const int tid = tid_fresh();
    int it = blockIdx.x;
    if (it < NMOD) { prep_mod_item(P, lds, it); it += gridDim.x; }
    if (it >= NMOD + NTILE) return;
    TileD d = prep_decode(P, it - NMOD); float v[8]; prep_load(d, tid, v);
    for (;;) {
        const int nx = it + gridDim.x; const bool has = nx < NMOD + NTILE;
        TileD dn = d; float vn[8];
        if (has) { dn = prep_decode(P, nx - NMOD); prep_load(dn, tid, vn); }
        prep_store(d, tid, v, lds);
        if (!has) break;
        d = dn; it = nx;
#pragma unroll
        for (int e = 0; e < 8; ++e) v[e] = vn[e];
    }
}

template <int MODE>
__device__ __forceinline__ void phase_norm(const Params& P, const float* srcX, const float* srcC, int nrows, const float* nw, int shIdx, int scIdx, u16* H, float* outF) {
    constexpr int NR = 4;
    const int lane = tid_fresh() & 63, gw = blockIdx.x * 8 + (tid_fresh() >> 6), nwv = gridDim.x * 8;
    const float* MOD = (const float*)(P.ws + OFF_MOD);
    f32x4 w[4];
#pragma unroll
    for (int i = 0; i < 4; ++i) w[i] = *(const f32x4*)(nw + i * 256 + lane * 4);
    f32x4 v[NR][4], vn[NR][4];
    int row0 = gw * NR;
    if (row0 < nrows) { const float* src0 = (row0 < TX) ? srcX + (size_t)row0 * 1024 : srcC + (size_t)(row0 - TX) * 1024;
#pragma unroll
        for (int q = 0; q < NR; ++q)
#pragma unroll
            for (int i = 0; i < 4; ++i) v[q][i] = *(const f32x4*)(src0 + q * 1024 + i * 256 + lane * 4); }
    for (; row0 < nrows; row0 += nwv * NR) {
        const int rown = row0 + nwv * NR;
        if (rown < nrows) { const float* src1 = (rown < TX) ? srcX + (size_t)rown * 1024 : srcC + (size_t)(rown - TX) * 1024;
#pragma unroll
            for (int q = 0; q < NR; ++q)
#pragma unroll
                for (int i = 0; i < 4; ++i) vn[q][i] = *(const f32x4*)(src1 + q * 1024 + i * 256 + lane * 4); }
        const int b = (row0 < TX) ? (row0 >> 11) : 32;
        float rstd[NR];
#pragma unroll
        for (int q = 0; q < NR; ++q) { float ss = 0.f;
#pragma unroll
            for (int i = 0; i < 4; ++i) ss += v[q][i][0] * v[q][i][0] + v[q][i][1] * v[q][i][1] + v[q][i][2] * v[q][i][2] + v[q][i][3] * v[q][i][3];
            rstd[q] = rsqrtf(wave_sum(ss) * (1.0f / 1024.0f) + EPSF); }
#pragma unroll
        for (int i = 0; i < 4; ++i) { const int col = i * 256 + lane * 4;
            if (MODE == 0) {
                const f32x4 sh = *(const f32x4*)(MOD + (size_t)b * 9216 + shIdx * 1024 + col), sc = *(const f32x4*)(MOD + (size_t)b * 9216 + scIdx * 1024 + col);
                const f32x4 ws = w[i] * (sc + 1.0f);
#pragma unroll
                for (int q = 0; q < NR; ++q) { const f32x4 o = v[q][i] * rstd[q] * ws + sh;
                    uint2 pk; pk.x = cvt_pk_bf16(o[0], o[1]); pk.y = cvt_pk_bf16(o[2], o[3]);
                    *(uint2*)(H + (size_t)(row0 + q) * 1024 + col) = pk; }
            } else {
#pragma unroll
                for (int q = 0; q < NR; ++q) *(f32x4*)(outF + (size_t)(row0 + q) * 1024 + col) = v[q][i] * rstd[q] * w[i];
            } }
#pragma unroll
        for (int q = 0; q < NR; ++q)
#pragma unroll
            for (int i = 0; i < 4; ++i) v[q][i] = vn[q][i];
    }
}

template <int MODE>
__device__ __forceinline__ void phase_norm_b(const Params& P, const u16* srcX, const u16* srcC, int nrows, const float* nw, int shIdx, int scIdx, u16* H, float* outF) {
    constexpr int NR = 4;
    const int lane = tid_fresh() & 63, gw = blockIdx.x * 8 + (tid_fresh() >> 6), nwv = gridDim.x * 8;
    const float* MOD = (const float*)(P.ws + OFF_MOD);
    f32x4 w[4];
#pragma unroll
    for (int i = 0; i < 4; ++i) w[i] = *(const f32x4*)(nw + (i >> 1) * 512 + lane * 8 + (i & 1) * 4);
    for (int row0 = gw * NR; row0 < nrows; row0 += nwv * NR) {
        const u16* src0 = (row0 < TX) ? srcX + (size_t)row0 * 1024 : srcC + (size_t)(row0 - TX) * 1024;
        u32x4 raw[NR][2];
#pragma unroll
        for (int q = 0; q < NR; ++q) { raw[q][0] = *(const u32x4*)(src0 + q * 1024 + lane * 8); raw[q][1] = *(const u32x4*)(src0 + q * 1024 + 512 + lane * 8); }
        const int b = (row0 < TX) ? (row0 >> 11) : 32;
        f32x4 sh[4], ws[4];
#pragma unroll
        for (int i = 0; i < 4; ++i) { const int col = (i >> 1) * 512 + lane * 8 + (i & 1) * 4;
            if (MODE == 0) { sh[i] = *(const f32x4*)(MOD + (size_t)b * 9216 + shIdx * 1024 + col); ws[i] = w[i] * (*(const f32x4*)(MOD + (size_t)b * 9216 + scIdx * 1024 + col) + 1.0f); }
            else { sh[i] = (f32x4){0.f, 0.f, 0.f, 0.f}; ws[i] = w[i]; } }
#pragma unroll
        for (int q = 0; q < NR; ++q) {
            f32x4 v[4];
            v[0] = (f32x4){lo_f(raw[q][0].x), hi_f(raw[q][0].x), lo_f(raw[q][0].y), hi_f(raw[q][0].y)}; v[1] = (f32x4){lo_f(raw[q][0].z), hi_f(raw[q][0].z), lo_f(raw[q][0].w), hi_f(raw[q][0].w)};
            v[2] = (f32x4){lo_f(raw[q][1].x), hi_f(raw[q][1].x), lo_f(raw[q][1].y), hi_f(raw[q][1].y)}; v[3] = (f32x4){lo_f(raw[q][1].z), hi_f(raw[q][1].z), lo_f(raw[q][1].w), hi_f(raw[q][1].w)};
            float ss = 0.f;
#pragma unroll
            for (int i = 0; i < 4; ++i) ss += v[i][0] * v[i][0] + v[i][1] * v[i][1] + v[i][2] * v[i][2] + v[i][3] * v[i][3];
            const float rstd = rsqrtf(wave_sum(ss) * (1.0f / 1024.0f) + EPSF);
            if (MODE == 1) {
                float* op = outF + (size_t)(row0 + q) * 1024 + lane * 8;
                *(f32x4*)op = v[0] * rstd * ws[0]; *(f32x4*)(op + 4) = v[1] * rstd * ws[1]; *(f32x4*)(op + 512) = v[2] * rstd * ws[2]; *(f32x4*)(op + 516) = v[3] * rstd * ws[3];
                continue; }
            u32x4 o0, o1; f32x4 t;
            t = v[0] * rstd * ws[0] + sh[0]; o0.x = cvt_pk_bf16(t[0], t[1]); o0.y = cvt_pk_bf16(t[2], t[3]);
            t = v[1] * rstd * ws[1] + sh[1]; o0.z = cvt_pk_bf16(t[0], t[1]); o0.w = cvt_pk_bf16(t[2], t[3]);
            t = v[2] * rstd * ws[2] + sh[2]; o1.x = cvt_pk_bf16(t[0], t[1]); o1.y = cvt_pk_bf16(t[2], t[3]);
            t = v[3] * rstd * ws[3] + sh[3]; o1.z = cvt_pk_bf16(t[0], t[1]); o1.w = cvt_pk_bf16(t[2], t[3]);
            *(u32x4*)(H + (size_t)(row0 + q) * 1024 + lane * 8) = o0; *(u32x4*)(H + (size_t)(row0 + q) * 1024 + 512 + lane * 8) = o1;
        }
    }
}

typedef float f32x2 __attribute__((ext_vector_type(2)));
template <int NC> struct ConvLd { u32 v[128 / (512 / (NC / 2)) + 4]; };
template <int NC>
__device__ __forceinline__ void stage_conv_load(ConvLd<NC>& L, const u16* XBC, int row0, int col0) {
    constexpr int NP = NC / 2, NTG = 512 / NP, TPG = 128 / NTG;
    const int tid = tid_fresh(), cp = tid % NP, tg = tid / NP, ch = col0 + 2 * cp, l0 = tg * TPG;
    const u16* p = XBC + (ptrdiff_t)(row0 + l0 - 2) * 1536 + ch;
#pragma unroll
    for (int i = 0; i < TPG + 4; ++i) L.v[i] = *(const u32*)(p + (size_t)i * 1536);
}
template <int NC, bool TR>
__device__ __forceinline__ void stage_conv_compute(const ConvLd<NC>& L, LAS u16* dst, int ld, int row0, int seq0, int seq1, int col0, const float* cw, const float* cb) {
    constexpr int NP = NC / 2, NTG = 512 / NP, TPG = 128 / NTG;
    const int tid = tid_fresh(), cp = tid % NP, tg = tid / NP, ch = col0 + 2 * cp, l0 = tg * TPG;
    f32x2 w[5];
#pragma unroll
    for (int k = 0; k < 5; ++k) w[k] = *(const f32x2*)(cw + k * 1536 + ch);
    const f32x2 bias = *(const f32x2*)(cb + ch);
    const int rlo = row0 + l0 - 2;
    const bool z0 = rlo < seq0, z1 = rlo + 1 < seq0, z2 = rlo + TPG + 2 >= seq1, z3 = rlo + TPG + 3 >= seq1;
#pragma unroll
    for (int q = 0; q < TPG / 8; ++q) {
        f32x2 in[12];
#pragma unroll
        for (int i = 0; i < 12; ++i) { const int gi = 8 * q + i; u32 v = L.v[gi];
            if (gi == 0) v = z0 ? 0u : v; if (gi == 1) v = z1 ? 0u : v; if (gi == TPG + 2) v = z2 ? 0u : v; if (gi == TPG + 3) v = z3 ? 0u : v;
            in[i][0] = lo_f(v); in[i][1] = hi_f(v); }
        float o0[8], o1[8];
        f32x2 acc8[8];
#pragma unroll
        for (int t = 0; t < 8; ++t) acc8[t] = bias;
#pragma unroll
        for (int k = 0; k < 5; ++k)
#pragma unroll
            for (int t = 0; t < 8; ++t) acc8[t] = in[t + k] * w[k] + acc8[t];
        f32x2 e8[8];
#pragma unroll
        for (int t = 0; t < 8; ++t) { e8[t] = acc8[t] * (-1.4426950408889634f); }
#pragma unroll
        for (int t = 0; t < 8; ++t) { e8[t][0] = __builtin_amdgcn_exp2f(e8[t][0]); e8[t][1] = __builtin_amdgcn_exp2f(e8[t][1]); }
#pragma unroll
        for (int t = 0; t < 8; ++t) { e8[t] = e8[t] + 1.0f; }
#pragma unroll
        for (int t = 0; t < 8; ++t) { e8[t][0] = __builtin_amdgcn_rcpf(e8[t][0]); e8[t][1] = __builtin_amdgcn_rcpf(e8[t][1]); }
#pragma unroll
        for (int t = 0; t < 8; ++t) { const f32x2 o = acc8[t] * e8[t]; o0[t] = o[0]; o1[t] = o[1];
            if (!TR) *(LAS u32*)(dst + (l0 + 8 * q + t) * ld + 2 * cp) = cvt_pk_bf16(o[0], o[1]); }
        if (TR) {
            u32x4 a, b;
            a.x = cvt_pk_bf16(o0[0], o0[1]); a.y = cvt_pk_bf16(o0[2], o0[3]); a.z = cvt_pk_bf16(o0[4], o0[5]); a.w = cvt_pk_bf16(o0[6], o0[7]);
            b.x = cvt_pk_bf16(o1[0], o1[1]); b.y = cvt_pk_bf16(o1[2], o1[3]); b.z = cvt_pk_bf16(o1[4], o1[5]); b.w = cvt_pk_bf16(o1[6], o1[7]);
            *(LAS u32x4*)(dst + (2 * cp) * ld + l0 + 8 * q) = a; *(LAS u32x4*)(dst + (2 * cp + 1) * ld + l0 + 8 * q) = b;
        }
    }
}
template <int NC, bool TR>
__device__ __forceinline__ void stage_conv_impl(LAS u16* dst, int ld, const u16* XBC, int row0, int seq0, int seq1, int col0, const float* cw, const float* cb) {
    ConvLd<NC> L; stage_conv_load<NC>(L, XBC, row0, col0); stage_conv_compute<NC, TR>(L, dst, ld, row0, seq0, seq1, col0, cw, cb);
}
template <int NC> __device__ __forceinline__ void stage_conv(LAS u16* dst, int ld, const u16* XBC, int row0, int seq0, int seq1, int col0, const float* cw, const float* cb) {
    stage_conv_impl<NC, false>(dst, ld, XBC, row0, seq0, seq1, col0, cw, cb); }
template <int NC> __device__ __forceinline__ void stage_conv_t(LAS u16* dst, int ld, const u16* XBC, int row0, int seq0, int seq1, int col0, const float* cw, const float* cb) {
    stage_conv_impl<NC, true>(dst, ld, XBC, row0, seq0, seq1, col0, cw, cb); }

__device__ __forceinline__ void dtprep_item(const Params& P, LAS unsigned char* lds, int tc) {
    const int tid = tid_fresh(), dh = tid & 31, seg = tid >> 5, dir = dh >> 4, h = dh & 15;
    const bool isx = tc < 512; const int b = isx ? (tc >> 4) : ((tc - 512) >> 1); const int cidx = isx ? (tc & 15) : ((tc - 512) & 1);
    const int row0 = tc * 128;
    const int jscan = isx ? (dir ? 17 - cidx : cidx + 2) : (dir ? 1 - cidx : cidx);
    const float bias = dir ? P.dtbb[h] : P.dtbf[h]; const float a = -__expf(dir ? P.alb[h] : P.alf[h]);
    const float* DT = (const float*)(P.ws + OFF_DT);
    float dt[8], cs[8];
#pragma unroll
    for (int i = 0; i < 8; ++i) { const float raw = DT[(size_t)(row0 + seg * 8 + i) * 32 + dh] + bias; dt[i] = (raw > 20.f) ? raw : log1pf(__expf(raw)); }
    float run = 0.f;
    if (dir == 0) {
#pragma unroll
        for (int i = 0; i < 8; ++i) { run += dt[i] * a; cs[i] = run; }
    } else {
#pragma unroll
        for (int i = 7; i >= 0; --i) { run += dt[i] * a; cs[i] = run; }
    }
    LAS float* segsum = (LAS float*)lds;
    segsum[seg * 32 + dh] = run;
    __syncthreads();
    float off = 0.f, tot = 0.f;
#pragma unroll
    for (int s2 = 0; s2 < 16; ++s2) { const float v = segsum[s2 * 32 + dh]; tot += v; if (dir == 0 ? (s2 < seg) : (s2 > seg)) off += v; }
    float* DTO = (float*)(P.ws + (dir ? OFF_DTB : OFF_DTF)); float* CSO = (float*)(P.ws + (dir ? OFF_CSB : OFF_CSF));
#pragma unroll
    for (int i = 0; i < 8; ++i) { const size_t o = (size_t)(row0 + seg * 8 + i) * 16 + h; DTO[o] = dt[i]; CSO[o] = cs[i] + off; }
    if (seg == 0) ((float*)(P.ws + OFF_CDEC))[((b * 2 + dir) * 18 + jscan) * 16 + h] = __expf(tot);
    __syncthreads();
}

__device__ __forceinline__ void uconv_load(const Params& P, int item, u32x4 (&raw)[4]) {
    const int tid = tid_fresh(); const bool isH = item < 2048; const int e = item & 2047, b = e >> 6, q = (e >> 1) & 31, chalf = e & 1;
    const u16* Ug = (const u16*)(P.ws + OFF_U); const int choff = (isH ? 0 : 512) + 256 * chalf;
#pragma unroll
    for (int i = 0; i < 4; ++i) { const int idx = tid + 512 * i, tok = idx >> 5, c8 = idx & 31; int grow;
        if (isH) grow = b * 2048 + q * 64 + tok; else grow = b * 2048 + (tok & 31) * 64 + 2 * q + (tok >> 5);
        raw[i] = *(const u32x4*)(Ug + (size_t)grow * 1024 + choff + c8 * 8); }
}
__device__ __forceinline__ void uconv_item(const Params& P, LAS unsigned char* lds, int item, const u32x4 (&raw)[4], int nx, u32x4 (&rawn)[4]) {
    const int tid = tid_fresh(); const bool isH = item < 2048; const int e = item & 2047, b = e >> 6, q = (e >> 1) & 31, chalf = e & 1;
    LAS float* in = (LAS float*)lds;
    u16* Yg = (u16*)(P.ws + OFF_Y);
    const int choff = (isH ? 0 : 512) + 256 * chalf;
    const int cp = tid & 127, tq = tid >> 7, ch = choff + 2 * cp;
    f32x2 w[31];
#pragma unroll
    for (int k = 0; k < 31; ++k) w[k] = *(const f32x2*)(P.ccw + k * 1024 + ch);
    const f32x2 bias = *(const f32x2*)(P.ccb + ch);
    if (nx < 4096) uconv_load(P, nx, rawn);
#pragma unroll
    for (int i = 0; i < 4; ++i) { const int idx = tid + 512 * i, tok = idx >> 5, c8 = idx & 31; const int lrow = isH ? (15 + tok) : ((tok >> 5) * 62 + 15 + (tok & 31));
        const u32x4 v = raw[i];
        *(LAS f32x4*)(in + lrow * 256 + c8 * 8) = (f32x4){lo_f(v.x), hi_f(v.x), lo_f(v.y), hi_f(v.y)};
        *(LAS f32x4*)(in + lrow * 256 + c8 * 8 + 4) = (f32x4){lo_f(v.z), hi_f(v.z), lo_f(v.w), hi_f(v.w)}; }
    { const int npad = isH ? 30 : 60;
      for (int idx = tid; idx < npad * 64; idx += 512) { const int pr = idx >> 6, c4 = idx & 63; int lrow;
          if (isH) lrow = (pr < 15) ? pr : 64 + pr; else { const int line = pr / 30, k = pr % 30; lrow = line * 62 + ((k < 15) ? k : 32 + k); }
          *(LAS f32x4*)(in + lrow * 256 + c4 * 4) = (f32x4){0.f, 0.f, 0.f, 0.f}; } }
    LDS_BARRIER();
    const int base_row = isH ? 16 * tq : (62 * (tq >> 1) + 16 * (tq & 1));
    f32x2 win[46];
#pragma unroll
    for (int i = 0; i < 46; ++i) win[i] = *(const LAS f32x2*)(in + (base_row + i) * 256 + 2 * cp);
    const int g0 = isH ? (b * 2048 + q * 64 + 16 * tq) : (b * 2048 + (16 * (tq & 1)) * 64 + 2 * q + (tq >> 1));
    const int gstep = isH ? 1 : 64;
#pragma unroll
    for (int og = 0; og < 16; og += 8) {
        f32x2 a[8];
#pragma unroll
        for (int j = 0; j < 8; ++j) a[j] = bias;
#pragma unroll
        for (int k = 0; k < 31; ++k)
#pragma unroll
            for (int j = 0; j < 8; ++j) a[j] = win[og + j + k] * w[k] + a[j];
#pragma unroll
        for (int j = 0; j < 8; ++j) *(u32*)(Yg + (size_t)(g0 + (og + j) * gstep) * 2048 + 1024 + ch) = cvt_pk_bf16(a[j][0], a[j][1]);
    }
    LDS_BARRIER();
}

__device__ __forceinline__ void phase_p6(const Params& P, LAS unsigned char* lds) {
    for (int it = blockIdx.x; it < 576; it += gridDim.x) dtprep_item(P, lds, it);
}

__device__ __forceinline__ bf16x8 gather8(const LAS u16* p, int stride) {
    bf16x8 r;
#pragma unroll
    for (int j = 0; j < 8; ++j) r[j] = (short)p[j * stride];
    return r;
}
#define MFMA32(a, b, c) __builtin_amdgcn_mfma_f32_32x32x16_bf16((a), (b), (c), 0, 0, 0)

__device__ __forceinline__ void s1_item(const Params& P, LAS unsigned char* lds, int item) {
    const int tid = tid_fresh(), w = tid >> 6, lane = tid & 63, r = lane & 31, hf = lane >> 5;
    const int g = item & 1, tc = (item >> 1) % 18, b = item / 36;
    const bool isx = tc < 16;
    const int seq0 = isx ? b * 2048 : TX + b * 256, seq1 = seq0 + (isx ? 2048 : 256), row0 = seq0 + 128 * (isx ? tc : tc - 16);
    const int jf = isx ? tc + 2 : tc - 16, jb = 17 - tc;
    LAS u16* BT = (LAS u16*)lds;
    LAS u16* XT = (LAS u16*)(lds + 34816);
    LAS float* wfb = (LAS float*)(lds + 34816 + 69632);
    const u16* XBC = (const u16*)(P.ws + OFF_XBC);
    const float *CSF = (const float*)(P.ws + OFF_CSF), *CSB = (const float*)(P.ws + OFF_CSB), *DTF = (const float*)(P.ws + OFF_DTF), *DTB = (const float*)(P.ws + OFF_DTB);
    u16* ST = (u16*)(P.ws + OFF_ST);
    LAS float* dtl = (LAS float*)(lds + 108544);
    LAS float* csl = dtl + 2048;
    LAS float* segs = csl + 2048;
    {
        const int dh = tid & 15, seg = tid >> 4, dir = dh >> 3, hx = 8 * g + (dh & 7);
        const float bias = dir ? P.dtbb[hx] : P.dtbf[hx]; const float a = -__expf(dir ? P.alb[hx] : P.alf[hx]);
        const float* DT = (const float*)(P.ws + OFF_DT);
        float dt[4], cs[4];
#pragma unroll
        for (int i = 0; i < 4; ++i) { const float raw = DT[(size_t)(row0 + seg * 4 + i) * 32 + dir * 16 + hx] + bias; dt[i] = (raw > 20.f) ? raw : log1pf(__expf(raw)); }
        float run = 0.f;
        if (dir == 0) {
#pragma unroll
            for (int i = 0; i < 4; ++i) { run += dt[i] * a; cs[i] = run; }
        } else {
#pragma unroll
            for (int i = 3; i >= 0; --i) { run += dt[i] * a; cs[i] = run; }
        }
        segs[seg * 16 + dh] = run;
        LDS_BARRIER();
        float off = 0.f, tot = 0.f;
#pragma unroll
        for (int s2 = 0; s2 < 32; ++s2) { const float v = segs[s2 * 16 + dh]; tot += v; if (dir == 0 ? (s2 < seg) : (s2 > seg)) off += v; }
        float* DTO = (float*)(P.ws + (dir ? OFF_DTB : OFF_DTF)); float* CSO = (float*)(P.ws + (dir ? OFF_CSB : OFF_CSF));
#pragma unroll
        for (int i = 0; i < 4; ++i) { const int l = seg * 4 + i; const size_t o = (size_t)(row0 + l) * 16 + hx; const float c = cs[i] + off;
            DTO[o] = dt[i]; CSO[o] = c; dtl[dh * 128 + l] = dt[i]; csl[dh * 128 + l] = c; }
        if (seg == 0) ((float*)(P.ws + OFF_CDEC))[((b * 2 + dir) * 18 + (dir ? jb : jf)) * 16 + hx] = __expf(tot);
    }
    stage_conv_t<128>(BT, 136, XBC, row0, seq0, seq1, 1024 + 128 * g, P.scw, P.scb);
    LDS_BARRIER();
    const int hq = w >> 1, pb = w & 1;
    for (int pass = 0; pass < 2; ++pass) {
        const int h0 = 8 * g + 4 * pass, h = h0 + hq;
        stage_conv_t<256>(XT, 136, XBC, row0, seq0, seq1, 64 * h0, P.scw, P.scb);
#pragma unroll
        for (int e = 0; e < 2; ++e) { const int idx = tid + 512 * e, hh = idx >> 8, dir = (idx >> 7) & 1, l = idx & 127, dq = dir * 8 + 4 * pass + hh;
            wfb[(hh * 2 + dir) * 128 + l] = __expf(csl[dq * 128 + (dir ? 0 : 127)] - csl[dq * 128 + l]) * dtl[dq * 128 + l]; }
        __syncthreads();
        f32x16 acc[2][4];
#pragma unroll
        for (int d = 0; d < 2; ++d)
#pragma unroll
            for (int nb = 0; nb < 4; ++nb)
#pragma unroll
                for (int i = 0; i < 16; ++i) acc[d][nb][i] = 0.f;
#pragma unroll 2
        for (int ks = 0; ks < 8; ++ks) {
            const int lb = 16 * ks + 8 * hf;
            const bf16x8 xr = *(const LAS bf16x8*)(XT + (hq * 64 + 32 * pb + r) * 136 + lb);
            const f32x4 wf0 = *(const LAS f32x4*)(wfb + (hq * 2 + 0) * 128 + lb), wf1 = *(const LAS f32x4*)(wfb + (hq * 2 + 0) * 128 + lb + 4);
            const f32x4 wb0 = *(const LAS f32x4*)(wfb + (hq * 2 + 1) * 128 + lb), wb1 = *(const LAS f32x4*)(wfb + (hq * 2 + 1) * 128 + lb + 4);
            float xv[8];
#pragma unroll
            for (int j = 0; j < 8; ++j) xv[j] = bf2f((u16)xr[j]);
            u32x4 qf, qb;
            qf.x = cvt_pk_bf16(xv[0] * wf0[0], xv[1] * wf0[1]); qf.y = cvt_pk_bf16(xv[2] * wf0[2], xv[3] * wf0[3]); qf.z = cvt_pk_bf16(xv[4] * wf1[0], xv[5] * wf1[1]); qf.w = cvt_pk_bf16(xv[6] * wf1[2], xv[7] * wf1[3]);
            qb.x = cvt_pk_bf16(xv[0] * wb0[0], xv[1] * wb0[1]); qb.y = cvt_pk_bf16(xv[2] * wb0[2], xv[3] * wb0[3]); qb.z = cvt_pk_bf16(xv[4] * wb1[0], xv[5] * wb1[1]); qb.w = cvt_pk_bf16(xv[6] * wb1[2], xv[7] * wb1[3]);
            const bf16x8 xf = __builtin_bit_cast(bf16x8, qf), xb = __builtin_bit_cast(bf16x8, qb);
#pragma unroll
            for (int nb = 0; nb < 4; ++nb) { const bf16x8 bfr = *(const LAS bf16x8*)(BT + (32 * nb + r) * 136 + lb);
                acc[0][nb] = MFMA32(bfr, xf, acc[0][nb]); acc[1][nb] = MFMA32(bfr, xb, acc[1][nb]); }
        }
#pragma unroll
        for (int d = 0; d < 2; ++d) { const int j = d ? jb : jf;
            if (j <= 16) { u16* sp = ST + ((size_t)((b * 2 + d) * 17 + j) * 16 + h) * 8192 + ((pb * 4) * 64 + lane) * 16;
#pragma unroll
                for (int nb = 0; nb < 4; ++nb) { u32x4 q0, q1;
                    q0.x = cvt_pk_bf16(acc[d][nb][0], acc[d][nb][1]); q0.y = cvt_pk_bf16(acc[d][nb][2], acc[d][nb][3]); q0.z = cvt_pk_bf16(acc[d][nb][4], acc[d][nb][5]); q0.w = cvt_pk_bf16(acc[d][nb][6], acc[d][nb][7]);
                    q1.x = cvt_pk_bf16(acc[d][nb][8], acc[d][nb][9]); q1.y = cvt_pk_bf16(acc[d][nb][10], acc[d][nb][11]); q1.z = cvt_pk_bf16(acc[d][nb][12], acc[d][nb][13]); q1.w = cvt_pk_bf16(acc[d][nb][14], acc[d][nb][15]);
                    *(u32x4*)(sp + nb * 1024) = q0; *(u32x4*)(sp + nb * 1024 + 8) = q1; } } }
        LDS_BARRIER();
    }
}

__device__ __forceinline__ void phase_s2(const Params& P) {
    u16* ST = (u16*)(P.ws + OFF_ST); const float* CDEC = (const float*)(P.ws + OFF_CDEC);
    const int nth = gridDim.x * 512;
    for (int v = blockIdx.x * 512 + tid_fresh(); v < 32 * 2 * 16 * 1024; v += nth) {
        const int pn = (v & 1023) * 8, h = (v >> 10) & 15, bd = v >> 14;
        float hs[8];
#pragma unroll
        for (int j = 0; j < 8; ++j) hs[j] = 0.f;
        u16* base = ST + ((size_t)(bd * 17) * 16 + h) * 8192 + pn;
        u32x4 q[17]; float dec[17];
#pragma unroll
        for (int s = 0; s < 17; ++s) { q[s] = *(const u32x4*)(base + (size_t)s * 16 * 8192); dec[s] = CDEC[(bd * 18 + s) * 16 + h]; }
#pragma unroll
        for (int s = 0; s < 17; ++s) {
            const float d = dec[s];
            hs[0] = hs[0] * d + lo_f(q[s].x); hs[1] = hs[1] * d + hi_f(q[s].x); hs[2] = hs[2] * d + lo_f(q[s].y); hs[3] = hs[3] * d + hi_f(q[s].y);
            hs[4] = hs[4] * d + lo_f(q[s].z); hs[5] = hs[5] * d + hi_f(q[s].z); hs[6] = hs[6] * d + lo_f(q[s].w); hs[7] = hs[7] * d + hi_f(q[s].w);
            u32x4 o; o.x = cvt_pk_bf16(hs[0], hs[1]); o.y = cvt_pk_bf16(hs[2], hs[3]); o.z = cvt_pk_bf16(hs[4], hs[5]); o.w = cvt_pk_bf16(hs[6], hs[7]);
            *(u32x4*)(base + (size_t)s * 16 * 8192) = o;
        }
    }
}

__device__ __forceinline__ void s3_item(const Params& P, LAS unsigned char* lds, int item) {
    const int tid = tid_fresh(), w = tid >> 6, lane = tid & 63, r = lane & 31, hf = lane >> 5;
    const int g = item & 1, c = (item >> 1) & 15, b = item >> 5;
    const int seq0 = b * 2048, seq1 = seq0 + 2048, row0 = seq0 + 128 * c;
    LAS u16* Cs = (LAS u16*)lds;
    LAS u16* Gs = (LAS u16*)(lds + 34816);
    LAS u16* XT = (LAS u16*)(lds + 69632);
    LAS u16* Bs = XT;
    LAS float* ar = (LAS float*)(lds + 139264);
    LAS float* ssq = (LAS float*)(lds + 147456);
    const u16* XBC = (const u16*)(P.ws + OFF_XBC); const u16* ST = (const u16*)(P.ws + OFF_ST); u16* Yg = (u16*)(P.ws + OFF_Y);
    const float *CSF = (const float*)(P.ws + OFF_CSF), *CSB = (const float*)(P.ws + OFF_CSB), *DTF = (const float*)(P.ws + OFF_DTF), *DTB = (const float*)(P.ws + OFF_DTB);
    ConvLd<256> LX;
    stage_conv<128>(Cs, 136, XBC, row0, seq0, seq1, 1280 + 128 * g, P.scw, P.scb);
    stage_conv<128>(Bs, 136, XBC, row0, seq0, seq1, 1024 + 128 * g, P.scw, P.scb);
    if (tid < 128) ssq[tid] = 0.f;
    LDS_BARRIER();
    {
        const int wr2 = w >> 1, wc2 = w & 1;
        f32x16 g0, g1;
#pragma unroll
        for (int i = 0; i < 16; ++i) { g0[i] = 0.f; g1[i] = 0.f; }
#pragma unroll 2
        for (int ks = 0; ks < 8; ++ks) {
            const bf16x8 a = *(const LAS bf16x8*)(Cs + (32 * wr2 + r) * 136 + 16 * ks + 8 * hf);
            const bf16x8 b0 = *(const LAS bf16x8*)(Bs + (64 * wc2 + r) * 136 + 16 * ks + 8 * hf);
            const bf16x8 b1 = *(const LAS bf16x8*)(Bs + (64 * wc2 + 32 + r) * 136 + 16 * ks + 8 * hf);
            g0 = MFMA32(a, b0, g0); g1 = MFMA32(a, b1, g1);
        }
#pragma unroll
        for (int i = 0; i < 16; ++i) { const int l = 32 * wr2 + (i & 3) + 8 * (i >> 2) + 4 * hf;
            Gs[l * 136 + 64 * wc2 + r] = f2bf(g0[i]); Gs[l * 136 + 64 * wc2 + 32 + r] = f2bf(g1[i]); }
    }
    LDS_BARRIER();
    const int hq = __builtin_amdgcn_readfirstlane(w >> 1), rbh = __builtin_amdgcn_readfirstlane(w & 1);
#pragma unroll
    for (int pass = 0; pass < 2; ++pass) {
        const int h0 = 8 * g + 4 * pass, h = h0 + hq;
        if (pass == 0) stage_conv_load<256>(LX, XBC, row0, 64 * h0);
        float av[4];
#pragma unroll
        for (int e = 0; e < 4; ++e) { const int idx = tid + 512 * e, hh = idx >> 9, which = (idx >> 7) & 3, l = idx & 127;
            const float* srcp = (which == 0) ? CSF : (which == 1) ? CSB : (which == 2) ? DTF : DTB; av[e] = srcp[(size_t)(row0 + l) * 16 + h0 + hh]; }
        const u16* stf = ST + ((size_t)((b * 2 + 0) * 17 + (c + 1)) * 16 + h) * 8192 + lane * 16;
        const u16* stb = ST + ((size_t)((b * 2 + 1) * 17 + (16 - c)) * 16 + h) * 8192 + lane * 16;
        u32x4 hfr[2][2][2][2];
#pragma unroll
        for (int cb = 0; cb < 2; ++cb)
#pragma unroll
            for (int nl = 0; nl < 2; ++nl)
#pragma unroll
                for (int sx = 0; sx < 2; ++sx) { const int off = ((cb * 4 + nl) * 64) * 16 + 8 * sx; hfr[0][cb][nl][sx] = *(const u32x4*)(stf + off); hfr[1][cb][nl][sx] = *(const u32x4*)(stb + off); }
        stage_conv_compute<256, true>(LX, XT, 136, row0, seq0, seq1, 64 * h0, P.scw, P.scb);
#pragma unroll
        for (int e = 0; e < 4; ++e) { const int idx = tid + 512 * e, which = (idx >> 7) & 3; ar[idx] = av[e] * ((which < 2) ? 1.4426950408889634f : 1.0f); }
        LDS_BARRIER();
        LAS float* A = ar + hq * 512;
        f32x16 acc[2][2];
#pragma unroll
        for (int a = 0; a < 2; ++a)
#pragma unroll
            for (int cb = 0; cb < 2; ++cb)
#pragma unroll
                for (int i = 0; i < 16; ++i) acc[a][cb][i] = 0.f;
        const int l0 = 64 * rbh + r, l1 = l0 + 32;
        const float csf0 = A[l0], csb0 = A[128 + l0], dg0 = A[256 + l0] + A[384 + l0], csf1 = A[l1], csb1 = A[128 + l1], dg1 = A[256 + l1] + A[384 + l1];
        const float ef0 = __builtin_amdgcn_exp2f(csf0), eb0 = __builtin_amdgcn_exp2f(csb0), ef1 = __builtin_amdgcn_exp2f(csf1), eb1 = __builtin_amdgcn_exp2f(csb1), dsk = P.ssm_d[h];
#define S3_OFF(NBH) do { _Pragma("unroll") for (int nl = 0; nl < 2; ++nl) _Pragma("unroll") for (int sx = 0; sx < 2; ++sx) { const int no = 32 * (2 * (NBH) + nl) + 16 * sx + 4 * hf; \
            _Pragma("unroll") for (int rb2 = 0; rb2 < 2; ++rb2) { const int l = rb2 ? l1 : l0; const float ef = rb2 ? ef1 : ef0, eb = rb2 ? eb1 : eb0; \
                const u32x2 clo = *(const LAS u32x2*)(Cs + l * 136 + no), chi = *(const LAS u32x2*)(Cs + l * 136 + no + 8); \
                const float c0 = lo_f(clo.x), c1 = hi_f(clo.x), c2 = lo_f(clo.y), c3 = hi_f(clo.y), c4 = lo_f(chi.x), c5 = hi_f(chi.x), c6 = lo_f(chi.y), c7 = hi_f(chi.y); \
                u32x4 qf, qb; qf.x = cvt_pk_bf16(c0 * ef, c1 * ef); qf.y = cvt_pk_bf16(c2 * ef, c3 * ef); qf.z = cvt_pk_bf16(c4 * ef, c5 * ef); qf.w = cvt_pk_bf16(c6 * ef, c7 * ef); \
                qb.x = cvt_pk_bf16(c0 * eb, c1 * eb); qb.y = cvt_pk_bf16(c2 * eb, c3 * eb); qb.z = cvt_pk_bf16(c4 * eb, c5 * eb); qb.w = cvt_pk_bf16(c6 * eb, c7 * eb); \
                const bf16x8 af = __builtin_bit_cast(bf16x8, qf), ab = __builtin_bit_cast(bf16x8, qb); \
                _Pragma("unroll") for (int cb = 0; cb < 2; ++cb) { acc[rb2][cb] = MFMA32(af, __builtin_bit_cast(bf16x8, hfr[0][cb][nl][sx]), acc[rb2][cb]); \
                    acc[rb2][cb] = MFMA32(ab, __builtin_bit_cast(bf16x8, hfr[1][cb][nl][sx]), acc[rb2][cb]); } } } } while (0)
        S3_OFF(0);
#pragma unroll
        for (int cb = 0; cb < 2; ++cb)
#pragma unroll
            for (int nl = 0; nl < 2; ++nl)
#pragma unroll
                for (int sx = 0; sx < 2; ++sx) { const int off = ((cb * 4 + 2 + nl) * 64) * 16 + 8 * sx; hfr[0][cb][nl][sx] = *(const u32x4*)(stf + off); hfr[1][cb][nl][sx] = *(const u32x4*)(stb + off); }
#pragma unroll 1
        for (int ks = 0; ks < 8; ++ks) {
            const int sb = 16 * ks + 8 * hf;
            const bf16x8 x0 = *(const LAS bf16x8*)(XT + (hq * 64 + r) * 136 + sb), x1 = *(const LAS bf16x8*)(XT + (hq * 64 + 32 + r) * 136 + sb);
#pragma unroll
            for (int rb2 = 0; rb2 < 2; ++rb2) { const int l = rb2 ? l1 : l0; const float csf_l = rb2 ? csf1 : csf0, csb_l = rb2 ? csb1 : csb0;
                const int RB = 2 * rbh + rb2;
                const bf16x8 gv = *(const LAS bf16x8*)(Gs + l * 136 + sb); float o[8];
                if (ks < 2 * RB) {
                    const f32x4 c0 = *(const LAS f32x4*)(A + sb), c1 = *(const LAS f32x4*)(A + sb + 4), d0 = *(const LAS f32x4*)(A + 256 + sb), d1 = *(const LAS f32x4*)(A + 256 + sb + 4);
#pragma unroll
                    for (int j = 0; j < 4; ++j) { o[j] = bf2f((u16)gv[j]) * (__builtin_amdgcn_exp2f(csf_l - c0[j]) * d0[j]); o[4 + j] = bf2f((u16)gv[4 + j]) * (__builtin_amdgcn_exp2f(csf_l - c1[j]) * d1[j]); }
                } else if (ks > 2 * RB + 1) {
                    const f32x4 c0 = *(const LAS f32x4*)(A + 128 + sb), c1 = *(const LAS f32x4*)(A + 128 + sb + 4), d0 = *(const LAS f32x4*)(A + 384 + sb), d1 = *(const LAS f32x4*)(A + 384 + sb + 4);
#pragma unroll
                    for (int j = 0; j < 4; ++j) { o[j] = bf2f((u16)gv[j]) * (__builtin_amdgcn_exp2f(csb_l - c0[j]) * d0[j]); o[4 + j] = bf2f((u16)gv[4 + j]) * (__builtin_amdgcn_exp2f(csb_l - c1[j]) * d1[j]); }
                } else {
                    float cfs[8], cbs[8], dfs[8], dbs[8];
#pragma unroll
                    for (int q = 0; q < 2; ++q) { const f32x4 t0 = *(const LAS f32x4*)(A + sb + 4 * q), t1 = *(const LAS f32x4*)(A + 128 + sb + 4 * q), t2 = *(const LAS f32x4*)(A + 256 + sb + 4 * q), t3 = *(const LAS f32x4*)(A + 384 + sb + 4 * q);
#pragma unroll
                        for (int j = 0; j < 4; ++j) { cfs[4 * q + j] = t0[j]; cbs[4 * q + j] = t1[j]; dfs[4 * q + j] = t2[j]; dbs[4 * q + j] = t3[j]; } }
#pragma unroll
                    for (int j = 0; j < 8; ++j) { const int ss = sb + j; const bool le = ss <= l, eq = ss == l;
                        const float arg = le ? (csf_l - cfs[j]) : (csb_l - cbs[j]), sc = le ? dfs[j] : dbs[j];
                        const float f = __builtin_amdgcn_exp2f(arg) * sc + (eq ? dbs[j] : 0.f);
                        o[j] = bf2f((u16)gv[j]) * f + (eq ? dsk : 0.f); }
                }
                u32x4 q; q.x = cvt_pk_bf16(o[0], o[1]); q.y = cvt_pk_bf16(o[2], o[3]); q.z = cvt_pk_bf16(o[4], o[5]); q.w = cvt_pk_bf16(o[6], o[7]);
                const bf16x8 am = __builtin_bit_cast(bf16x8, q);
                acc[rb2][0] = MFMA32(am, x0, acc[rb2][0]); acc[rb2][1] = MFMA32(am, x1, acc[rb2][1]); }
        }
        S3_OFF(1);
#undef S3_OFF
        if (pass == 0) stage_conv_load<256>(LX, XBC, row0, 64 * (8 * g + 4));
        u32x4 zv[8];
        { const int t5 = tid_fresh(); const u16* zb = Yg + (size_t)row0 * 2048 + 64 * h0 + (t5 & 31) * 8;
#pragma unroll
          for (int e = 0; e < 8; ++e) zv[e] = *(const u32x4*)(zb + (size_t)((t5 >> 5) + 16 * e) * 2048); }
        LDS_BARRIER();
#pragma unroll
        for (int rb2 = 0; rb2 < 2; ++rb2)
#pragma unroll
            for (int cb = 0; cb < 2; ++cb)
#pragma unroll
                for (int i = 0; i < 16; ++i) XT[(64 * rbh + 32 * rb2 + 8 * (i >> 2) + 4 * hf + (i & 3)) * 264 + hq * 64 + 32 * cb + r] = f2bf(acc[rb2][cb][i]);
        LDS_BARRIER();
        {
            const int t2 = tid_fresh();
            u16* yb = Yg + (size_t)row0 * 2048 + 64 * h0 + (t2 & 31) * 8;
#pragma unroll
            for (int e = 0; e < 8; ++e) { const int l = (t2 >> 5) + 16 * e; const u32x4 yv = *(const LAS u32x4*)(XT + l * 264 + (t2 & 31) * 8); const u32x4 z = zv[e];
                float v[8] = {lo_f(yv.x) * lo_f(z.x), hi_f(yv.x) * hi_f(z.x), lo_f(yv.y) * lo_f(z.y), hi_f(yv.y) * hi_f(z.y),
                              lo_f(yv.z) * lo_f(z.z), hi_f(yv.z) * hi_f(z.z), lo_f(yv.w) * lo_f(z.w), hi_f(yv.w) * hi_f(z.w)};
                float sv = 0.f;
#pragma unroll
                for (int j = 0; j < 8; ++j) sv += v[j] * v[j];
#pragma unroll
                for (int o = 16; o >= 1; o >>= 1) sv += __shfl_xor(sv, o);
                if ((t2 & 31) == 0) atomicAdd((float*)(ssq + l), sv);
                u32x4 q; q.x = cvt_pk_bf16(v[0], v[1]); q.y = cvt_pk_bf16(v[2], v[3]); q.z = cvt_pk_bf16(v[4], v[5]); q.w = cvt_pk_bf16(v[6], v[7]);
                *(u32x4*)(yb + (size_t)l * 2048) = q; }
        }
        if (pass == 1) { __syncthreads(); } else { LDS_BARRIER(); }
    }
    {
        const int t4 = tid_fresh();
        const int c8 = (t4 & 63) * 8;
        const f32x4 w0 = *(const f32x4*)(P.ssm_nw + 512 * g + c8), w1 = *(const f32x4*)(P.ssm_nw + 512 * g + c8 + 4);
        u16* ybase = Yg + (size_t)(row0 + (t4 >> 6)) * 2048 + 512 * g + c8;
#pragma unroll
        for (int hb = 0; hb < 2; ++hb) {
            u32x4 qv[8];
#pragma unroll
            for (int i = 0; i < 8; ++i) qv[i] = *(const u32x4*)(ybase + (size_t)(hb * 8 + i) * 8 * 2048);
#pragma unroll
            for (int i = 0; i < 8; ++i) { const int l = (t4 >> 6) + 8 * (hb * 8 + i);
                const float rstd = rsqrtf(ssq[l] * (1.0f / 512.0f) + EPSF); const u32x4 q = qv[i];
                u32x4 o; o.x = cvt_pk_bf16(lo_f(q.x) * rstd * w0[0], hi_f(q.x) * rstd * w0[1]); o.y = cvt_pk_bf16(lo_f(q.y) * rstd * w0[2], hi_f(q.y) * rstd * w0[3]);
                o.z = cvt_pk_bf16(lo_f(q.z) * rstd * w1[0], hi_f(q.z) * rstd * w1[1]); o.w = cvt_pk_bf16(lo_f(q.w) * rstd * w1[2], hi_f(q.w) * rstd * w1[3]);
                *(u32x4*)(ybase + (size_t)(hb * 8 + i) * 8 * 2048) = o; }
        }
    }
    LDS_BARRIER();
}

__device__ __forceinline__ void phase_lnb(const Params& P) {
    constexpr int NR = 4;
    const int lane = tid_fresh() & 63, gw = blockIdx.x * 8 + (tid_fresh() >> 6), nwv = gridDim.x * 8;
    u16* Yg = (u16*)(P.ws + OFF_Y);
    f32x4 lw[4], lb[4];
#pragma unroll
    for (int i = 0; i < 4; ++i) { const int col = (i >> 1) * 512 + lane * 8 + (i & 1) * 4; lw[i] = *(const f32x4*)(P.lnw + col); lb[i] = *(const f32x4*)(P.lnb + col); }
    for (int row0 = gw * NR; row0 < TX; row0 += nwv * NR) {
        u32x4 raw[NR][2];
#pragma unroll
        for (int q = 0; q < NR; ++q) { const u16* p = Yg + (size_t)(row0 + q) * 2048 + 1024 + lane * 8; raw[q][0] = *(const u32x4*)p; raw[q][1] = *(const u32x4*)(p + 512); }
#pragma unroll
        for (int q = 0; q < NR; ++q) {
            f32x4 v[4];
            v[0] = (f32x4){lo_f(raw[q][0].x), hi_f(raw[q][0].x), lo_f(raw[q][0].y), hi_f(raw[q][0].y)}; v[1] = (f32x4){lo_f(raw[q][0].z), hi_f(raw[q][0].z), lo_f(raw[q][0].w), hi_f(raw[q][0].w)};
            v[2] = (f32x4){lo_f(raw[q][1].x), hi_f(raw[q][1].x), lo_f(raw[q][1].y), hi_f(raw[q][1].y)}; v[3] = (f32x4){lo_f(raw[q][1].z), hi_f(raw[q][1].z), lo_f(raw[q][1].w), hi_f(raw[q][1].w)};
            float s = 0.f;
#pragma unroll
            for (int i = 0; i < 4; ++i) s += (v[i][0] + v[i][1]) + (v[i][2] + v[i][3]);
            const float mu = wave_sum(s) * (1.0f / 1024.0f);
            float qq = 0.f;
#pragma unroll
            for (int i = 0; i < 4; ++i) { v[i] = v[i] - mu; qq += v[i][0] * v[i][0] + v[i][1] * v[i][1] + v[i][2] * v[i][2] + v[i][3] * v[i][3]; }
            const float rstd = rsqrtf(wave_sum(qq) * (1.0f / 1024.0f) + EPSF);
            u32x4 o[2];
#pragma unroll
            for (int i = 0; i < 4; ++i) { const f32x4 t = v[i] * rstd * lw[i] + lb[i];
                const u32 a = cvt_pk_bf16(silu_f(t[0]), silu_f(t[1])), b = cvt_pk_bf16(silu_f(t[2]), silu_f(t[3]));
                if ((i & 1) == 0) { o[i >> 1].x = a; o[i >> 1].y = b; } else { o[i >> 1].z = a; o[i >> 1].w = b; } }
            u16* p = Yg + (size_t)(row0 + q) * 2048 + 1024 + lane * 8;
            *(u32x4*)p = o[0]; *(u32x4*)(p + 512) = o[1];
        }
    }
}

template <int PH> __device__ __forceinline__ void run_phase(const Params& P, LAS unsigned char* lds) {
    unsigned char* ws = P.ws;
    const float* MOD = (const float*)(ws + OFF_MOD);
    if constexpr (PH == 0) phase_prep(P, lds);
    if constexpr (PH == 1) phase_norm<0>(P, P.x, P.ctx, TT, P.norm_ffn1, 0, 1, (u16*)(ws + OFF_H), nullptr);
    if constexpr (PH == 2) { Gemm gm{(const bf16_t*)(ws + OFF_H), (const bf16_t*)(ws + OFF_WGU1), TT, NGU, 1024}; StaticOrder S; S.init(TT, NGU, (int)gridDim.x, (int)blockIdx.x);
        EpiSwiGLU E{(bf16_t*)(ws + OFF_ACT)}; gemm_phase<EpiSwiGLU, StaticOrder, false>(lds, gm, S, E, nullptr); }
    if constexpr (PH == 3) { Gemm gm{(const bf16_t*)(ws + OFF_ACT), (const bf16_t*)(ws + OFF_WD1), TT, 1024, DFF}; StaticOrder S; S.init(TT, 1024, (int)gridDim.x, (int)blockIdx.x);
        EpiResidT<0, 1> E{P.x, P.out, P.ctx, ws + OFF_XC1, MOD + 2 * 1024, 0.5f}; gemm_phase<EpiResidT<0, 1>, StaticOrder, false>(lds, gm, S, E, nullptr); }
    if constexpr (PH == 4) phase_norm_b<0>(P, (const u16*)P.out, (const u16*)(ws + OFF_XC1), TT, P.norm_mix, 3, 4, (u16*)(ws + OFF_H), nullptr);
    if constexpr (PH == 5) { Gemm gm{(const bf16_t*)(ws + OFF_H), (const bf16_t*)(ws + OFF_WIN), TX, NIN, 1024}; InOrder S; S.init(TX, NIN, (int)gridDim.x, (int)blockIdx.x);
        EpiInProj E{(bf16_t*)(ws + OFF_XBC), (float*)(ws + OFF_DT), (bf16_t*)(ws + OFF_Y), (bf16_t*)(ws + OFF_U)}; gemm_phase<EpiInProj, InOrder, false>(lds, gm, S, E, nullptr); }
    if constexpr (PH == 6) phase_p6(P, lds);
    if constexpr (PH == 7) { for (int it = blockIdx.x; it < 1152; it += gridDim.x) s1_item(P, lds, it); }
    if constexpr (PH == 8) {
        const int mine = (int)(blockIdx.x % 16u); int k = 0; bool done = false;
        u32x4 raw[4], rawn[4];
        if ((int)blockIdx.x < 4096) uconv_load(P, blockIdx.x, raw);
        for (int it = blockIdx.x; it < 4096; it += gridDim.x, ++k) { if (k == mine) { phase_s2(P); done = true; }
            uconv_item(P, lds, it, raw, it + (int)gridDim.x, rawn);
#pragma unroll
            for (int i = 0; i < 4; ++i) raw[i] = rawn[i]; }
        if (!done) phase_s2(P);
    }
    if constexpr (PH == 9) { for (int it = blockIdx.x; it < 1024; it += gridDim.x) s3_item(P, lds, it); phase_lnb(P); }
    if constexpr (PH == 10) { Gemm gm{(const bf16_t*)(ws + OFF_Y), (const bf16_t*)(ws + OFF_WOUT), TX, 1024, 2048}; StaticOrder S; S.init(TX, 1024, (int)gridDim.x, (int)blockIdx.x);
        EpiResidT<1, 1> E{P.out, ws + OFF_XBC, P.out, ws + OFF_XBC, MOD + 5 * 1024, 1.0f}; gemm_phase<EpiResidT<1, 1>, StaticOrder, false>(lds, gm, S, E, nullptr); }
    if constexpr (PH == 11) phase_norm_b<0>(P, (const u16*)(ws + OFF_XBC), (const u16*)(ws + OFF_XBC), TX, P.norm_ffn2, 6, 7, (u16*)(ws + OFF_H), nullptr);
    if constexpr (PH == 12) { Gemm gm{(const bf16_t*)(ws + OFF_H), (const bf16_t*)(ws + OFF_WGU2), TX, NGU, 1024}; StaticOrder S; S.init(TX, NGU, (int)gridDim.x, (int)blockIdx.x);
        EpiSwiGLU E{(bf16_t*)(ws + OFF_ACT)}; gemm_phase<EpiSwiGLU, StaticOrder, false>(lds, gm, S, E, nullptr); }
    if constexpr (PH == 13) { Gemm gm{(const bf16_t*)(ws + OFF_ACT), (const bf16_t*)(ws + OFF_WD2), TX, 1024, DFF}; StaticOrder S; S.init(TX, 1024, (int)gridDim.x, (int)blockIdx.x);
        EpiResidT<1, 1> E{ws + OFF_XBC, ws + OFF_U, ws + OFF_XBC, ws + OFF_U, MOD + 8 * 1024, 0.5f}; gemm_phase<EpiResidT<1, 1>, StaticOrder, false>(lds, gm, S, E, nullptr); }
    if constexpr (PH == 14) phase_norm_b<1>(P, (const u16*)(ws + OFF_U), (const u16*)(ws + OFF_U), TX, P.fnorm, 0, 0, nullptr, P.out);
}

template <int PH> __global__ void __launch_bounds__(512, 2) k_one(Params P) {
    extern __shared__ __attribute__((aligned(16))) unsigned char shm[];
    run_phase<PH>(P, (LAS unsigned char*)shm);
}

__device__ __forceinline__ void grid_bar(unsigned* ctr, unsigned target) {
    __syncthreads();
    if (tid_fresh() == 0) {
        __builtin_amdgcn_fence(__ATOMIC_RELEASE, "agent");
        __hip_atomic_fetch_add(ctr, 1u, __ATOMIC_RELAXED, __HIP_MEMORY_SCOPE_AGENT);
        unsigned v;
        do { __builtin_amdgcn_s_sleep(1); v = __hip_atomic_load(ctr, __ATOMIC_RELAXED, __HIP_MEMORY_SCOPE_AGENT); asm volatile("" : "+v"(v)); } while (v < target);
        __builtin_amdgcn_fence(__ATOMIC_ACQUIRE, "agent");
    }
    __syncthreads();
}
constexpr bool phase_empty(int ph) { return ph == 6; }
template <int PH, int NB> __device__ __forceinline__ void run_all(const Params& P, LAS unsigned char* lds, cg::grid_group& grid) {
    unsigned* ctr = (unsigned*)(P.ws + OFF_BAR);
    if constexpr (PH == 0) { if (blockIdx.x == 0 && threadIdx.x == 0) __hip_atomic_store(ctr, 0u, __ATOMIC_RELAXED, __HIP_MEMORY_SCOPE_AGENT); }
    if constexpr (phase_empty(PH)) { if constexpr (PH + 1 < NPHASE) run_all<PH + 1, NB>(P, lds, grid); }
    else {
        run_phase<PH>(P, lds);
        constexpr int NXT = (PH + 1 < NPHASE && phase_empty(PH + 1)) ? PH + 2 : PH + 1;
        if constexpr (NXT < NPHASE) {
            if constexpr (PH == 0) grid.sync(); else grid_bar(ctr, (unsigned)NB * gridDim.x);
            run_all<NXT, (PH == 0 ? NB : NB + 1)>(P, lds, grid);
        }
    }
}
__global__ void __launch_bounds__(512, 2) mega(Params P) {
    extern __shared__ __attribute__((aligned(16))) unsigned char shm[];
    cg::grid_group grid = cg::this_grid();
    run_all<0, 1>(P, (LAS unsigned char*)shm, grid);
}

template <int PH> static void launch_each(int grid, hipStream_t stream, const Params& p) {
    static bool attr = false; if (!attr) { (void)hipFuncSetAttribute((const void*)k_one<PH>, hipFuncAttributeMaxDynamicSharedMemorySize, LDS_BYTES); attr = true; }
    hipLaunchKernelGGL(k_one<PH>, dim3(grid), dim3(512), LDS_BYTES, stream, p);
    if constexpr (PH + 1 < NPHASE) launch_each<PH + 1>(grid, stream, p);
}

#ifndef MK_MULTI
#define MK_MULTI 0
#endif
extern "C" void kernel_launch(void* const* d_in, const int* in_sizes, int n_in, void* d_out, int out_size, void* d_ws, size_t ws_size, hipStream_t stream) {
    static int grid = 0;
    if (grid == 0) {
        if (n_in != 30 || ws_size < WS_TOTAL) { fprintf(stderr, "kernel_launch: expected 30 inputs and >= %zu bytes of workspace (got %d, %zu)\n", (size_t)WS_TOTAL, n_in, ws_size); grid = -1; return; }
        int dev = 0, cus = 0, per_cu = 0;
        (void)hipGetDevice(&dev); (void)hipDeviceGetAttribute(&cus, hipDeviceAttributeMultiprocessorCount, dev);
        if (hipFuncSetAttribute((const void*)mega, hipFuncAttributeMaxDynamicSharedMemorySize, LDS_BYTES) != hipSuccess) { fprintf(stderr, "kernel_launch: hipFuncSetAttribute failed\n"); }
        if (hipOccupancyMaxActiveBlocksPerMultiprocessor(&per_cu, (const void*)mega, 512, LDS_BYTES) != hipSuccess || per_cu < 1) { fprintf(stderr, "kernel_launch: occupancy query says %d\n", per_cu); per_cu = 1; }
        (void)hipGetLastError();
        grid = cus * per_cu;
    }
    if (grid < 0) return;
    Params p{};
    const float** pp = (const float**)&p;
    for (int i = 0; i < 30; ++i) pp[i] = (const float*)d_in[i];
    p.out = (float*)d_out; p.ws = (unsigned char*)d_ws;
#if MK_MULTI
    launch_each<0>(grid, stream, p);
#else
    void* args[] = {&p};
    hipError_t e = hipLaunchCooperativeKernel((const void*)mega, dim3(grid), dim3(512), args, LDS_BYTES, stream);
    if (e != hipSuccess) fprintf(stderr, "kernel_launch: cooperative launch failed: %s (grid %d)\n", hipGetErrorString(e), grid);
#endif
}
```

```cpp
#include <hip/hip_runtime.h>
#include <hip/hip_cooperative_groups.h>
#include <cstdio>
namespace cg = cooperative_groups;
__device__ __forceinline__ int tid_fresh() { int t = (int)threadIdx.x; asm volatile("" : "+v"(t)); return t; }
namespace pg8 {
#define PG8_LAS __attribute__((address_space(3)))
typedef unsigned short bf16_t;
typedef short bf16x8 __attribute__((ext_vector_type(8)));
typedef float f32x4 __attribute__((ext_vector_type(4)));
typedef unsigned u32x4 __attribute__((ext_vector_type(4)));
constexpr int BM = 256, BK = 64, HALF = 128, HTB = HALF * BK * 2  , STAGE_BYTES = 8 * HTB, NXCD = 8, WGM = 8;

__host__ __device__ __forceinline__ int lds_byte(int r, int c) { const int st = (r >> 4) * 2 + (c >> 5), rr = r & 15, cc = c & 31, ob = rr * 64 + cc * 2; return st * 1024 + (ob ^ (((ob >> 9) & 1) << 5)); }
__host__ __device__ __forceinline__ void stage_rc(int b, int& R, int& C) { const int st = b / 1024, sb = b % 1024, swz = sb ^ (((sb >> 9) & 1) << 5); R = (st >> 1) * 16 + swz / 64; C = (st & 1) * 32 + (swz % 64) / 2; }
__host__ __device__ __forceinline__ int perm32(int rho) { const int n = rho >> 4, i = rho & 15; return 8 * (i >> 2) + 4 * n + (i & 3); }

struct Unit { int pm, pn; };
struct Gemm { const bf16_t* A; const bf16_t* Bt; int M, N, K; };

struct StaticOrder {
    int nM, nN, nwg, G, c;
    __host__ __device__ void init(int M, int N, int G_, int c_) { nM = M / BM; nN = N / BM; nwg = nM * nN; G = G_; c = c_; }
    __host__ __device__ bool next(int i, Unit& u) const {
        const long L = (long)i * G + c; if (L >= nwg) return false;
        int wgid = (int)L; { const int q = nwg / NXCD, r = nwg % NXCD, xcd = wgid % NXCD, off = wgid / NXCD; wgid = (xcd < r ? xcd * (q + 1) : r * (q + 1) + (xcd - r) * q) + off; }
        const int nig = WGM * nN, gid = wgid / nig, fm = gid * WGM, gsz = (nM - fm) < WGM ? (nM - fm) : WGM;
        u.pm = fm + ((wgid % nig) % gsz); u.pn = (wgid % nig) / gsz; return true;
    }
    __device__ __forceinline__ void a_ready(const Unit&) const {}
    __device__ __forceinline__ void done(const Unit&) const {}
};
__device__ __forceinline__ unsigned cvt_pk_bf16(float lo, float hi) { unsigned r; asm volatile("v_cvt_pk_bf16_f32 %0, %1, %2" : "=v"(r) : "v"(lo), "v"(hi)); return r; }
typedef float f32x2 __attribute__((ext_vector_type(2)));
template <class Epi, class Sched, bool STAMP = false>
__device__ __forceinline__ void gemm_phase(PG8_LAS unsigned char* lds, const Gemm g, const Sched& S, const Epi& E, unsigned long long* stamps) {
    const int tid = tid_fresh(), wid = __builtin_amdgcn_readfirstlane(tid >> 6), lane = tid & 63, wr = wid >> 2, wc = wid & 3, fr = lane & 15, fq = lane >> 4;
    const int K = g.K, nt = K / BK;
    int ts_lo = 0, ts_hi = 0, nts = 0; const unsigned long long rt_entry = STAMP ? (unsigned long long)wall_clock64() : 0ull;
#define PG8_STAMP() do { if (STAMP && wid == 0 && nts < 64) { const unsigned long long _c = (unsigned long long)clock64(); \
        ts_lo = (lane == nts) ? (int)(unsigned)_c : ts_lo; ts_hi = (lane == nts) ? (int)(unsigned)(_c >> 32) : ts_hi; ++nts; } } while (0)
    PG8_STAMP();
    unsigned voffA[2], voffB[2];
#pragma unroll
    for (int i = 0; i < 2; ++i) { int R, C; stage_rc(tid * 16 + i * 8192, R, C); const int Rb = Epi::PERM ? ((R & ~31) + perm32(R & 31)) : R;
        voffA[i] = (unsigned)(R * K + C) * 2u; voffB[i] = (unsigned)(Rb * K + C) * 2u; }
    const size_t kstep = (size_t)(BK * 2);
    const size_t hstep = (size_t)HALF * K * 2;
    const size_t tstep = 2 * hstep;
    const unsigned ldsw = (unsigned)wid * 1024u;
    const int aoff = lds_byte(wr * 64 + fr, fq * 8), boff = lds_byte(wc * 32 + fr, fq * 8);
#define PG8_SA(b, h) (((b) * 2 + (h)) * HTB)
#define PG8_SB(b, h) ((4 + (b) * 2 + (h)) * HTB)
#define PG8_STAGE(bufoff, gbase, voff) do { _Pragma("unroll") for (int _i = 0; _i < 2; ++_i) \
        __builtin_amdgcn_global_load_lds((const unsigned*)((const char*)(gbase) + (voff)[_i]), (PG8_LAS unsigned*)(lds + (bufoff) + ldsw + _i * 8192), 16, 0, 0); } while (0)
#define PG8_LDA(dst, b, h) do { _Pragma("unroll") for (int m = 0; m < 4; ++m) _Pragma("unroll") for (int k = 0; k < 2; ++k) dst[m][k] = *(const PG8_LAS bf16x8*)(lds + PG8_SA(b, h) + aoff + m * 2048 + k * 1024); } while (0)
#define PG8_LDB(dst, b, h) do { _Pragma("unroll") for (int n = 0; n < 2; ++n) _Pragma("unroll") for (int k = 0; k < 2; ++k) dst[n][k] = *(const PG8_LAS bf16x8*)(lds + PG8_SB(b, h) + boff + n * 2048 + k * 1024); } while (0)
#define PG8_MMA(ai, bj, At, Bt) do { __builtin_amdgcn_s_setprio(1); _Pragma("unroll") for (int m = 0; m < 4; ++m) _Pragma("unroll") for (int n = 0; n < 2; ++n) _Pragma("unroll") for (int k = 0; k < 2; ++k) \
        acc[ai][bj][m][n] = __builtin_amdgcn_mfma_f32_16x16x32_bf16(Bt[n][k], At[m][k], acc[ai][bj][m][n], 0, 0, 0); __builtin_amdgcn_s_setprio(0); } while (0)
#define PG8_WAIT_V(n) asm volatile("s_waitcnt vmcnt(" #n ")" ::: "memory")
#define PG8_WAIT_L(n) asm volatile("s_waitcnt lgkmcnt(" #n ")" ::: "memory")
#define PG8_BAR __builtin_amdgcn_s_barrier()
#define PG8_SCHED __builtin_amdgcn_sched_barrier(0)
    Unit cur, nxt; int ui = 0;
    if (!S.next(0, cur)) return;
    f32x4 acc[2][2][4][2];
#pragma unroll
    for (int a = 0; a < 2; ++a)
#pragma unroll
        for (int b = 0; b < 2; ++b)
#pragma unroll
            for (int m = 0; m < 4; ++m)
#pragma unroll
                for (int n = 0; n < 2; ++n) acc[a][b][m][n] = (f32x4){0.f, 0.f, 0.f, 0.f};
    bf16x8 At[4][2], B0[2][2], B1[2][2];
    const char* cA = (const char*)g.A + (size_t)cur.pm * tstep; const char* cB = (const char*)g.Bt + (size_t)cur.pn * tstep;
    S.a_ready(cur);
    PG8_STAGE(PG8_SB(0, 0), cB, voffB); PG8_STAGE(PG8_SA(0, 0), cA, voffA); PG8_STAGE(PG8_SB(0, 1), cB + hstep, voffB); PG8_STAGE(PG8_SA(0, 1), cA + hstep, voffA);
    if (wr == 1) PG8_BAR;
    PG8_WAIT_V(4); PG8_BAR;
    PG8_STAGE(PG8_SB(1, 0), cB + kstep, voffB); PG8_STAGE(PG8_SA(1, 0), cA + kstep, voffA); PG8_STAGE(PG8_SB(1, 1), cB + hstep + kstep, voffB);
    PG8_WAIT_V(6); PG8_BAR;
    PG8_STAMP();
    for (;;) {
        const bool has_next = S.next(ui + 1, nxt);
        const char* nA = has_next ? (const char*)g.A + (size_t)nxt.pm * tstep : cA; const char* nB = has_next ? (const char*)g.Bt + (size_t)nxt.pn * tstep : cB;
        for (int t = 0; t < nt; t += 2) {
            const bool last = (t == nt - 2);
            const char* a1 = cA + (size_t)(t + 1) * kstep;
            const char* a2 = last ? nA : cA + (size_t)(t + 2) * kstep; const char* b2 = last ? nB : cB + (size_t)(t + 2) * kstep;
            const char* a3 = a2 + kstep; const char* b3 = b2 + kstep;
            if (last && has_next) S.a_ready(nxt);
            PG8_LDB(B0, 0, 0); PG8_SCHED; PG8_LDA(At, 0, 0); PG8_STAGE(PG8_SA(1, 1), a1 + hstep, voffA);
            PG8_WAIT_L(8); PG8_BAR; PG8_WAIT_L(0); PG8_MMA(0, 0, At, B0); PG8_BAR; PG8_SCHED;
            PG8_LDB(B1, 0, 1); PG8_STAGE(PG8_SB(0, 0), b2, voffB);
            PG8_BAR; PG8_WAIT_L(0); PG8_MMA(0, 1, At, B1); PG8_BAR;
            PG8_LDA(At, 0, 1); PG8_STAGE(PG8_SA(0, 0), a2, voffA);
            PG8_BAR; PG8_WAIT_L(0); PG8_MMA(1, 0, At, B0); PG8_BAR; PG8_SCHED;
            PG8_STAGE(PG8_SB(0, 1), b2 + hstep, voffB);
            PG8_WAIT_V(6); PG8_BAR; PG8_MMA(1, 1, At, B1); PG8_BAR;
            PG8_LDB(B0, 1, 0); PG8_SCHED; PG8_LDA(At, 1, 0); PG8_STAGE(PG8_SA(0, 1), a2 + hstep, voffA);
            PG8_WAIT_L(8); PG8_BAR; PG8_WAIT_L(0); PG8_MMA(0, 0, At, B0); PG8_BAR; PG8_SCHED;
            PG8_LDB(B1, 1, 1); PG8_STAGE(PG8_SB(1, 0), b3, voffB);
            PG8_BAR; PG8_WAIT_L(0); PG8_MMA(0, 1, At, B1); PG8_BAR;
            PG8_LDA(At, 1, 1); PG8_STAGE(PG8_SA(1, 0), a3, voffA);
            PG8_BAR; PG8_WAIT_L(0); PG8_MMA(1, 0, At, B0); PG8_BAR; PG8_SCHED;
            PG8_STAGE(PG8_SB(1, 1), b3 + hstep, voffB);
            PG8_WAIT_V(6); PG8_BAR; PG8_MMA(1, 1, At, B1); PG8_BAR;
        }
        PG8_STAMP();
        if constexpr (!Epi::AFTER_DRAIN) { E(acc, cur, wr, wc, fr, fq); S.done(cur); }
        PG8_STAMP();
        if (!has_next) break;
#pragma unroll
        for (int a = 0; a < 2; ++a)
#pragma unroll
            for (int b = 0; b < 2; ++b)
#pragma unroll
                for (int m = 0; m < 4; ++m)
#pragma unroll
                    for (int n = 0; n < 2; ++n) acc[a][b][m][n] = (f32x4){0.f, 0.f, 0.f, 0.f};
        cur = nxt; cA = nA; cB = nB; ++ui;
    }
    PG8_WAIT_V(0);
    if (wr == 0) PG8_BAR;
    PG8_BAR;
    if constexpr (Epi::AFTER_DRAIN) { E.fused(acc, cur, wr, wc, fr, fq, lds, wid, lane); S.done(cur); }
    PG8_STAMP();
    if (STAMP && wid == 0) { stamps[lane] = lane < nts ? (((unsigned long long)(unsigned)ts_hi << 32) | (unsigned)ts_lo) : 0ull;
        if (lane == 62) stamps[62] = rt_entry; if (lane == 63) stamps[63] = (unsigned long long)wall_clock64(); }
#undef PG8_STAMP
#undef PG8_SA
#undef PG8_SB
#undef PG8_STAGE
#undef PG8_LDA
#undef PG8_LDB
#undef PG8_MMA
#undef PG8_WAIT_V
#undef PG8_WAIT_L
#undef PG8_BAR
#undef PG8_SCHED
}
}
using namespace pg8;
#define LAS __attribute__((address_space(3)))
typedef unsigned short u16;
typedef unsigned int u32;
typedef float f32x16 __attribute__((ext_vector_type(16)));
typedef unsigned int u32x2 __attribute__((ext_vector_type(2)));

constexpr int TX = 65536, TCX = 8192, TT = 73728;
constexpr int DFF = 2816, NGU = 5632, NIN = 4864;
constexpr float EPSF = 1e-6f;
constexpr int LDS_BYTES = 160768;
constexpr int NPHASE = 15;

constexpr size_t SZ_WGU = (size_t)NGU * 1024 * 2, SZ_WD = (size_t)1024 * DFF * 2, SZ_WIN = (size_t)NIN * 1024 * 2, SZ_WOUT = (size_t)1024 * 2048 * 2;
constexpr size_t OFF_WGU1 = 0, OFF_WD1 = OFF_WGU1 + SZ_WGU, OFF_WGU2 = OFF_WD1 + SZ_WD, OFF_WD2 = OFF_WGU2 + SZ_WGU, OFF_WIN = OFF_WD2 + SZ_WD, OFF_WOUT = OFF_WIN + SZ_WIN;
constexpr size_t OFF_MOD = OFF_WOUT + SZ_WOUT;
constexpr size_t OFF_XC1 = OFF_MOD + (size_t)33 * 9216 * 4;
constexpr size_t OFF_DT = OFF_XC1 + (size_t)TCX * 1024 * 4;
constexpr size_t SZ_A16 = (size_t)TT * 16 * 4;
constexpr size_t OFF_DTF = OFF_DT + (size_t)TT * 32 * 4, OFF_DTB = OFF_DTF + SZ_A16, OFF_CSF = OFF_DTB + SZ_A16, OFF_CSB = OFF_CSF + SZ_A16;
constexpr size_t OFF_CDEC = OFF_CSB + SZ_A16;
constexpr size_t OFF_BAR = OFF_CDEC + (size_t)32 * 2 * 18 * 16 * 4;
constexpr size_t OFF_BIG = OFF_BAR + 256;
constexpr size_t SZ_H = (size_t)TT * 1024 * 2, SZ_ACT = (size_t)TT * DFF * 2, SZ_ST = (size_t)32 * 2 * 17 * 16 * 8192 * 2;
constexpr size_t OFF_H = OFF_BIG, OFF_ACT = OFF_BIG + SZ_H, OFF_ST = OFF_BIG;
constexpr size_t WS_TOTAL = (size_t)1 << 30;
constexpr size_t OFF_U = WS_TOTAL - (size_t)TX * 1024 * 2, OFF_XBC = OFF_U - (size_t)TT * 1536 * 2, OFF_Y = OFF_XBC - (size_t)TX * 2048 * 2;
static_assert(OFF_BIG % 256 == 0 && OFF_ACT + SZ_ACT <= WS_TOTAL && OFF_Y >= OFF_ST + SZ_ST && OFF_Y >= OFF_H + SZ_H, "workspace map");

struct Params {
    const float *x, *c, *ctx, *c_ctx, *w_mod, *b_mod, *norm_ffn1, *g1, *u1, *d1, *norm_mix, *w_in, *scw, *scb, *dtbf, *dtbb, *alf, *alb, *ssm_d, *ssm_nw, *ccw, *ccb, *lnw, *lnb,
        *w_out, *norm_ffn2, *g2, *u2, *d2, *fnorm;
    float* out; unsigned char* ws; int ph_lo, ph_hi;
};

__device__ __forceinline__ float bf2f(u16 v) { return __uint_as_float(((u32)v) << 16); }
__device__ __forceinline__ u16 f2bf(float f) { u32 u = __float_as_uint(f); u += 0x7FFFu + ((u >> 16) & 1u); return (u16)(u >> 16); }
__device__ __forceinline__ float lo_f(u32 v) { return __uint_as_float(v << 16); }
__device__ __forceinline__ float hi_f(u32 v) { return __uint_as_float(v & 0xffff0000u); }
__device__ __forceinline__ float silu_f(float x) { return x * __builtin_amdgcn_rcpf(1.0f + __expf(-x)); }
__device__ __forceinline__ float sigm_f(float x) { return __builtin_amdgcn_rcpf(1.0f + __expf(-x)); }
#define LDS_BARRIER() do { asm volatile("s_waitcnt lgkmcnt(0)" ::: "memory"); __builtin_amdgcn_s_barrier(); asm volatile("" ::: "memory"); } while (0)
__device__ __forceinline__ float wave_sum(float v) {
#pragma unroll
    for (int o = 32; o >= 1; o >>= 1) v += __shfl_xor(v, o);
    return v;
}

typedef float f32x2v __attribute__((ext_vector_type(2)));
__device__ __forceinline__ f32x2v sigm2(f32x2v x) { f32x2v e = x * (-1.4426950408889634f); e[0] = __builtin_amdgcn_exp2f(e[0]); e[1] = __builtin_amdgcn_exp2f(e[1]); e = e + 1.0f;
    f32x2v r; r[0] = __builtin_amdgcn_rcpf(e[0]); r[1] = __builtin_amdgcn_rcpf(e[1]); return r; }
__device__ __forceinline__ unsigned swiglu_pk(float g0, float g1, float u0, float u1) { const f32x2v g = {g0, g1}, u = {u0, u1}; const f32x2v o = (g * sigm2(g)) * u; return cvt_pk_bf16(o[0], o[1]); }
__device__ __forceinline__ unsigned glu_pk(float a0, float a1, float b0, float b1) { const f32x2v a = {a0, a1}, b = {b0, b1}; const f32x2v o = a * sigm2(b); return cvt_pk_bf16(o[0], o[1]); }
struct InOrder : StaticOrder {
    __device__ bool next(int i, Unit& u) const {
        const long L = (long)i * G + c;
        if (L < nwg) return StaticOrder::next(i, u);
        const int e = (int)(L - nwg); if (e >= 192) return false;
        u.pm = 256 + (e & 31); u.pn = e >> 5; return true;
    }
};

struct EpiSwiGLU {
    static constexpr bool PERM = true, AFTER_DRAIN = false;
    bf16_t* O;
    __device__ __forceinline__ void operator()(const f32x4 (&acc)[2][2][4][2], const Unit& u, int wr, int wc, int fr, int fq) const {
        const int row0 = u.pm * BM + wr * 64 + fr, col0 = u.pn * 128 + wc * 32 + 8 * fq;
#pragma unroll
        for (int ai = 0; ai < 2; ++ai)
#pragma unroll
            for (int m = 0; m < 4; ++m) {
                bf16_t* rowp = O + (size_t)(row0 + ai * HALF + m * 16) * DFF + col0;
                const f32x4 g0 = acc[ai][0][m][0], g1 = acc[ai][0][m][1], u0 = acc[ai][1][m][0], u1 = acc[ai][1][m][1];
                u32x4 w;
                w.x = swiglu_pk(g0[0], g0[1], u0[0], u0[1]); w.y = swiglu_pk(g0[2], g0[3], u0[2], u0[3]);
                w.z = swiglu_pk(g1[0], g1[1], u1[0], u1[1]); w.w = swiglu_pk(g1[2], g1[3], u1[2], u1[3]);
                *(u32x4*)rowp = w;
            }
    }
};

struct EpiResid {
    static constexpr bool PERM = false, AFTER_DRAIN = false;
    const float* baseX; float* outX; const float* baseC; float* outC; const float* mod; float s;
    __device__ __forceinline__ void operator()(const f32x4 (&acc)[2][2][4][2], const Unit& u, int wr, int wc, int fr, int fq) const {
        const int row0 = u.pm * BM + wr * 64 + fr, col0 = u.pn * BM + wc * 32 + 4 * fq;
        const bool isx = u.pm < 256; const int b = isx ? (u.pm >> 3) : 32;
        const float* bp0 = isx ? baseX + (size_t)row0 * 1024 : baseC + (size_t)(row0 - TX) * 1024;
        float* op0 = isx ? outX + (size_t)row0 * 1024 : outC + (size_t)(row0 - TX) * 1024;
        f32x4 mv[2][2];
#pragma unroll
        for (int bj = 0; bj < 2; ++bj)
#pragma unroll
            for (int n = 0; n < 2; ++n) mv[bj][n] = *(const f32x4*)(mod + (size_t)b * 9216 + col0 + bj * HALF + n * 16) * s;
#pragma unroll
        for (int ai = 0; ai < 2; ++ai)
#pragma unroll
            for (int m = 0; m < 4; ++m) {
                const size_t ro = (size_t)(ai * HALF + m * 16) * 1024 + col0;
                f32x4 bv[2][2];
#pragma unroll
                for (int bj = 0; bj < 2; ++bj)
#pragma unroll
                    for (int n = 0; n < 2; ++n) bv[bj][n] = *(const f32x4*)(bp0 + ro + bj * HALF + n * 16);
#pragma unroll
                for (int bj = 0; bj < 2; ++bj)
#pragma unroll
                    for (int n = 0; n < 2; ++n) *(f32x4*)(op0 + ro + bj * HALF + n * 16) = bv[bj][n] + mv[bj][n] * acc[ai][bj][m][n];
            }
    }
};

template <int BT, int OT>
struct EpiResidT {
    static constexpr bool PERM = false, AFTER_DRAIN = false;
    const void* baseX; void* outX; const void* baseC; void* outC; const float* mod; float s;
    __device__ __forceinline__ void operator()(const f32x4 (&acc)[2][2][4][2], const Unit& u, int wr, int wc, int fr, int fq) const {
        const int row0 = u.pm * BM + wr * 64 + fr, col0 = u.pn * BM + wc * 32 + 4 * fq;
        const bool isx = u.pm < 256; const int b = isx ? (u.pm >> 3) : 32;
        const size_t eo = (size_t)(isx ? row0 : row0 - TX) * 1024 + col0;
        const char* bp0 = (const char*)(isx ? baseX : baseC) + eo * (BT ? 2 : 4);
        char* op0 = (char*)(isx ? outX : outC) + eo * (OT ? 2 : 4);
        f32x4 mv[2][2];
#pragma unroll
        for (int bj = 0; bj < 2; ++bj)
#pragma unroll
            for (int n = 0; n < 2; ++n) mv[bj][n] = *(const f32x4*)(mod + (size_t)b * 9216 + col0 + bj * HALF + n * 16) * s;
#pragma unroll
        for (int ai = 0; ai < 2; ++ai)
#pragma unroll
            for (int m = 0; m < 4; ++m) {
                const size_t ro = (size_t)(ai * HALF + m * 16) * 1024;
                f32x4 bv[2][2];
#pragma unroll
                for (int bj = 0; bj < 2; ++bj)
#pragma unroll
                    for (int n = 0; n < 2; ++n) { const size_t e = ro + bj * HALF + n * 16;
                        if (BT) { const u32x2 q = *(const u32x2*)(bp0 + e * 2); bv[bj][n] = (f32x4){lo_f(q.x), hi_f(q.x), lo_f(q.y), hi_f(q.y)}; }
                        else bv[bj][n] = *(const f32x4*)(bp0 + e * 4); }
#pragma unroll
                for (int bj = 0; bj < 2; ++bj)
#pragma unroll
                    for (int n = 0; n < 2; ++n) { const size_t e = ro + bj * HALF + n * 16; const f32x4 x = bv[bj][n] + mv[bj][n] * acc[ai][bj][m][n];
                        if (OT) { u32x2 q; q.x = cvt_pk_bf16(x[0], x[1]); q.y = cvt_pk_bf16(x[2], x[3]); *(u32x2*)(op0 + e * 2) = q; }
                        else *(f32x4*)(op0 + e * 4) = x; }
            }
    }
};

struct EpiInProj {
    static constexpr bool PERM = true, AFTER_DRAIN = false;
    bf16_t* XBC; float* DT; bf16_t* Y; bf16_t* U;
    __device__ __forceinline__ void operator()(const f32x4 (&acc)[2][2][4][2], const Unit& u, int wr, int wc, int fr, int fq) const {
        const int row0 = u.pm * BM + wr * 64 + fr, cin = wc * 32 + 8 * fq, pn = u.pn;
        if (pn == 5) {
            if (wc == 0) {
#pragma unroll
                for (int ai = 0; ai < 2; ++ai)
#pragma unroll
                    for (int m = 0; m < 4; ++m) {
                        float* rp = DT + (size_t)(row0 + ai * HALF + m * 16) * 32 + 8 * fq;
                        *(f32x4*)rp = acc[ai][0][m][0]; *(f32x4*)(rp + 4) = acc[ai][0][m][1];
                    }
            }
        } else if (pn <= 10) {
            bf16_t* base; int ld;
            if (pn <= 4) { base = XBC + pn * 256; ld = 1536; } else if (pn == 6) { base = XBC + 1280; ld = 1536; } else { base = Y + (pn - 7) * 256; ld = 2048; }
#pragma unroll
            for (int ai = 0; ai < 2; ++ai)
#pragma unroll
                for (int m = 0; m < 4; ++m) {
                    bf16_t* rowp = base + (size_t)(row0 + ai * HALF + m * 16) * ld + cin;
#pragma unroll
                    for (int bj = 0; bj < 2; ++bj) {
                        f32x4 v0 = acc[ai][bj][m][0], v1 = acc[ai][bj][m][1];
                        if (pn >= 7) {
#pragma unroll
                            for (int j = 0; j < 4; ++j) { v0[j] = silu_f(v0[j]); v1[j] = silu_f(v1[j]); } }
                        u32x4 w; w.x = cvt_pk_bf16(v0[0], v0[1]); w.y = cvt_pk_bf16(v0[2], v0[3]); w.z = cvt_pk_bf16(v1[0], v1[1]); w.w = cvt_pk_bf16(v1[2], v1[3]);
                        *(u32x4*)(rowp + bj * HALF) = w;
                    }
                }
        } else {
            bf16_t* base = U + (pn - 11) * 128 + cin;
#pragma unroll
            for (int ai = 0; ai < 2; ++ai)
#pragma unroll
                for (int m = 0; m < 4; ++m) {
                    bf16_t* rowp = base + (size_t)(row0 + ai * HALF + m * 16) * 1024;
                    const f32x4 a0 = acc[ai][0][m][0], a1 = acc[ai][0][m][1], b0 = acc[ai][1][m][0], b1 = acc[ai][1][m][1];
                    u32x4 w;
                    w.x = glu_pk(a0[0], a0[1], b0[0], b0[1]); w.y = glu_pk(a0[2], a0[3], b0[2], b0[3]);
                    w.z = glu_pk(a1[0], a1[1], b1[0], b1[1]); w.w = glu_pk(a1[2], a1[3], b1[2], b1[3]);
                    *(u32x4*)rowp = w;
                }
        }
    }
};

__device__ __forceinline__ void prep_mod_item(const Params& P, LAS unsigned char* lds, int it) {
    const int tid = tid_fresh();
    LAS float* cc = (LAS float*)lds;
    for (int i = tid; i < 33 * 1024; i += 512) { const int r = i >> 10, k = i & 1023; const float v = (r < 32) ? P.c[r * 1024 + k] : P.c_ctx[k]; cc[i] = silu_f(v); }
    __syncthreads();
    const int n0 = it * 64, col = tid & 63, kk = tid >> 6;
    float acc[33];
#pragma unroll
    for (int r = 0; r < 33; ++r) acc[r] = 0.f;
    const float* wp = P.w_mod + (size_t)(kk * 128) * 9216 + n0 + col;
    float wv[16], wn[16];
#pragma unroll
    for (int i = 0; i < 16; ++i) wv[i] = wp[(size_t)i * 9216];
#pragma unroll 1
    for (int kc = 0; kc < 8; ++kc) {
        if (kc < 7) {
#pragma unroll
            for (int i = 0; i < 16; ++i) wn[i] = wp[(size_t)((kc + 1) * 16 + i) * 9216]; }
#pragma unroll
        for (int q = 0; q < 4; ++q)
#pragma unroll
            for (int r = 0; r < 33; ++r) { const f32x4 c4 = *(const LAS f32x4*)(cc + r * 1024 + kk * 128 + kc * 16 + q * 4);
                acc[r] += c4[0] * wv[4 * q] + c4[1] * wv[4 * q + 1] + c4[2] * wv[4 * q + 2] + c4[3] * wv[4 * q + 3]; }
#pragma unroll
        for (int i = 0; i < 16; ++i) wv[i] = wn[i];
    }
    __syncthreads();
    LAS float* red = (LAS float*)lds;
#pragma unroll
    for (int r = 0; r < 33; ++r) red[(kk * 33 + r) * 64 + col] = acc[r];
    __syncthreads();
    float* MOD = (float*)(P.ws + OFF_MOD);
    for (int o = tid; o < 33 * 64; o += 512) { const int r = o >> 6, cl = o & 63; float s = 0.f;
#pragma unroll
        for (int q = 0; q < 8; ++q) s += red[(q * 33 + r) * 64 + cl];
        MOD[(size_t)r * 9216 + n0 + cl] = s + P.b_mod[n0 + cl]; }
    __syncthreads();
}

struct TileD { const float* src; u16* dst; int sld, nvalid, dld; };
__device__ __forceinline__ TileD prep_decode(const Params& P, int t) {
    const float* src; int sld, scol0, nvalid = 64, kt, n0, dld; u16* dst;
    if (t < 2816) {
        const int f = t >= 1408; const int tt = t - f * 1408; const int nt = tt >> 4; kt = tt & 15; n0 = nt * 64;
        const int j = n0 >> 8, s0 = n0 & 255;
        src = (s0 < 128) ? (f ? P.g2 : P.g1) : (f ? P.u2 : P.u1); scol0 = 128 * j + (s0 & 127); sld = DFF;
        dst = (u16*)(P.ws + (f ? OFF_WGU2 : OFF_WGU1)); dld = 1024;
    } else if (t < 2816 + 1408) {
        const int t2 = t - 2816; const int f = t2 >= 704; const int tt = t2 - f * 704; const int nt = tt / 44; kt = tt % 44; n0 = nt * 64;
        src = f ? P.d2 : P.d1; scol0 = n0; sld = 1024; dst = (u16*)(P.ws + (f ? OFF_WD2 : OFF_WD1)); dld = DFF;
    } else if (t < 2816 + 1408 + 1216) {
        const int tt = t - 4224; const int nt = tt >> 4; kt = tt & 15; n0 = nt * 64;
        const int pn = n0 >> 8, s0 = n0 & 255;
        if (pn < 4) scol0 = 1024 + n0; else if (pn == 4) scol0 = 2048 + s0; else if (pn == 5) { scol0 = 2560; nvalid = s0 ? 0 : 32; }
        else if (pn == 6) scol0 = 2304 + s0; else if (pn <= 10) scol0 = n0 - 1792;
        else { const int j = pn - 11; scol0 = (s0 < 128) ? (2592 + 128 * j + s0) : (2592 + 1024 + 128 * j + (s0 - 128)); }
        src = P.w_in; sld = 4640; dst = (u16*)(P.ws + OFF_WIN); dld = 1024;
    } else {
        const int tt = t - 5440; const int nt = tt >> 5; kt = tt & 31; n0 = nt * 64;
        src = P.w_out; scol0 = n0; sld = 1024; dst = (u16*)(P.ws + OFF_WOUT); dld = 2048;
    }
    TileD d; d.src = src + (size_t)(kt * 64) * sld + scol0; d.dst = dst + (size_t)n0 * dld + kt * 64; d.sld = sld; d.nvalid = nvalid; d.dld = dld; return d;
}
__device__ __forceinline__ void prep_load(const TileD& d, int tid, float (&v)[8]) {
#pragma unroll
    for (int e = 0; e < 8; ++e) { const int idx = tid + 512 * e, kk = idx >> 6, nn = idx & 63; v[e] = (nn < d.nvalid) ? d.src[(size_t)kk * d.sld + nn] : 0.f; }
}
__device__ __forceinline__ void prep_store(const TileD& d, int tid, const float (&v)[8], LAS unsigned char* lds) {
    LAS float* tile = (LAS float*)lds;
#pragma unroll
    for (int e = 0; e < 8; ++e) { const int idx = tid + 512 * e, kk = idx >> 6, nn = idx & 63; tile[kk * 65 + nn] = v[e]; }
    __syncthreads();
    { const int nn = tid >> 3, ks = (tid & 7) * 8; u32x4 w;
      w.x = cvt_pk_bf16(tile[(ks + 0) * 65 + nn], tile[(ks + 1) * 65 + nn]); w.y = cvt_pk_bf16(tile[(ks + 2) * 65 + nn], tile[(ks + 3) * 65 + nn]);
      w.z = cvt_pk_bf16(tile[(ks + 4) * 65 + nn], tile[(ks + 5) * 65 + nn]); w.w = cvt_pk_bf16(tile[(ks + 6) * 65 + nn], tile[(ks + 7) * 65 + nn]);
      *(u32x4*)(d.dst + (size_t)nn * d.dld + ks) = w; }
    __syncthreads();
}

__device__ __forceinline__ void phase_prep(const Params& P, LAS unsigned char* lds) {
    constexpr int NMOD = 144, NTILE = 2816 + 1408 + 1216 + 512;
    const int tid = tid_fresh();
    int it = blockIdx.x;
    if (it < NMOD) { prep_mod_item(P, lds, it); it += gridDim.x; }
    if (it >= NMOD + NTILE) return;
    TileD d = prep_decode(P, it - NMOD); float v[8]; prep_load(d, tid, v);
    for (;;) {
        const int nx = it + gridDim.x; const bool has = nx < NMOD + NTILE;
        TileD dn = d; float vn[8];
        if (has) { dn = prep_decode(P, nx - NMOD); prep_load(dn, tid, vn); }
        prep_store(d, tid, v, lds);
        if (!has) break;
        d = dn; it = nx;
#pragma unroll
        for (int e = 0; e < 8; ++e) v[e] = vn[e];
    }
}

template <int MODE>
__device__ __forceinline__ void phase_norm(const Params& P, const float* srcX, const float* srcC, int nrows, const float* nw, int shIdx, int scIdx, u16* H, float* outF) {
    constexpr int NR = 4;
    const int lane = tid_fresh() & 63, gw = blockIdx.x * 8 + (tid_fresh() >> 6), nwv = gridDim.x * 8;
    const float* MOD = (const float*)(P.ws + OFF_MOD);
    f32x4 w[4];
#pragma unroll
    for (int i = 0; i < 4; ++i) w[i] = *(const f32x4*)(nw + i * 256 + lane * 4);
    f32x4 v[NR][4], vn[NR][4];
    int row0 = gw * NR;
    if (row0 < nrows) { const float* src0 = (row0 < TX) ? srcX + (size_t)row0 * 1024 : srcC + (size_t)(row0 - TX) * 1024;
#pragma unroll
        for (int q = 0; q < NR; ++q)
#pragma unroll
            for (int i = 0; i < 4; ++i) v[q][i] = *(const f32x4*)(src0 + q * 1024 + i * 256 + lane * 4); }
    for (; row0 < nrows; row0 += nwv * NR) {
        const int rown = row0 + nwv * NR;
        if (rown < nrows) { const float* src1 = (rown < TX) ? srcX + (size_t)rown * 1024 : srcC + (size_t)(rown - TX) * 1024;
#pragma unroll
            for (int q = 0; q < NR; ++q)
#pragma unroll
                for (int i = 0; i < 4; ++i) vn[q][i] = *(const f32x4*)(src1 + q * 1024 + i * 256 + lane * 4); }
        const int b = (row0 < TX) ? (row0 >> 11) : 32;
        float rstd[NR];
#pragma unroll
        for (int q = 0; q < NR; ++q) { float ss = 0.f;
#pragma unroll
            for (int i = 0; i < 4; ++i) ss += v[q][i][0] * v[q][i][0] + v[q][i][1] * v[q][i][1] + v[q][i][2] * v[q][i][2] + v[q][i][3] * v[q][i][3];
            rstd[q] = rsqrtf(wave_sum(ss) * (1.0f / 1024.0f) + EPSF); }
#pragma unroll
        for (int i = 0; i < 4; ++i) { const int col = i * 256 + lane * 4;
            if (MODE == 0) {
                const f32x4 sh = *(const f32x4*)(MOD + (size_t)b * 9216 + shIdx * 1024 + col), sc = *(const f32x4*)(MOD + (size_t)b * 9216 + scIdx * 1024 + col);
                const f32x4 ws = w[i] * (sc + 1.0f);
#pragma unroll
                for (int q = 0; q < NR; ++q) { const f32x4 o = v[q][i] * rstd[q] * ws + sh;
                    uint2 pk; pk.x = cvt_pk_bf16(o[0], o[1]); pk.y = cvt_pk_bf16(o[2], o[3]);
                    *(uint2*)(H + (size_t)(row0 + q) * 1024 + col) = pk; }
            } else {
#pragma unroll
                for (int q = 0; q < NR; ++q) *(f32x4*)(outF + (size_t)(row0 + q) * 1024 + col) = v[q][i] * rstd[q] * w[i];
            } }
#pragma unroll
        for (int q = 0; q < NR; ++q)
#pragma unroll
            for (int i = 0; i < 4; ++i) v[q][i] = vn[q][i];
    }
}

template <int MODE>
__device__ __forceinline__ void phase_norm_b(const Params& P, const u16* srcX, const u16* srcC, int nrows, const float* nw, int shIdx, int scIdx, u16* H, float* outF) {
    constexpr int NR = 4;
    const int lane = tid_fresh() & 63, gw = blockIdx.x * 8 + (tid_fresh() >> 6), nwv = gridDim.x * 8;
    const float* MOD = (const float*)(P.ws + OFF_MOD);
    f32x4 w[4];
#pragma unroll
    for (int i = 0; i < 4; ++i) w[i] = *(const f32x4*)(nw + (i >> 1) * 512 + lane * 8 + (i & 1) * 4);
    for (int row0 = gw * NR; row0 < nrows; row0 += nwv * NR) {
        const u16* src0 = (row0 < TX) ? srcX + (size_t)row0 * 1024 : srcC + (size_t)(row0 - TX) * 1024;
        u32x4 raw[NR][2];
#pragma unroll
        for (int q = 0; q < NR; ++q) { raw[q][0] = *(const u32x4*)(src0 + q * 1024 + lane * 8); raw[q][1] = *(const u32x4*)(src0 + q * 1024 + 512 + lane * 8); }
        const int b = (row0 < TX) ? (row0 >> 11) : 32;
        f32x4 sh[4], ws[4];
#pragma unroll
        for (int i = 0; i < 4; ++i) { const int col = (i >> 1) * 512 + lane * 8 + (i & 1) * 4;
            if (MODE == 0) { sh[i] = *(const f32x4*)(MOD + (size_t)b * 9216 + shIdx * 1024 + col); ws[i] = w[i] * (*(const f32x4*)(MOD + (size_t)b * 9216 + scIdx * 1024 + col) + 1.0f); }
            else { sh[i] = (f32x4){0.f, 0.f, 0.f, 0.f}; ws[i] = w[i]; } }
#pragma unroll
        for (int q = 0; q < NR; ++q) {
            f32x4 v[4];
            v[0] = (f32x4){lo_f(raw[q][0].x), hi_f(raw[q][0].x), lo_f(raw[q][0].y), hi_f(raw[q][0].y)}; v[1] = (f32x4){lo_f(raw[q][0].z), hi_f(raw[q][0].z), lo_f(raw[q][0].w), hi_f(raw[q][0].w)};
            v[2] = (f32x4){lo_f(raw[q][1].x), hi_f(raw[q][1].x), lo_f(raw[q][1].y), hi_f(raw[q][1].y)}; v[3] = (f32x4){lo_f(raw[q][1].z), hi_f(raw[q][1].z), lo_f(raw[q][1].w), hi_f(raw[q][1].w)};
            float ss = 0.f;
#pragma unroll
            for (int i = 0; i < 4; ++i) ss += v[i][0] * v[i][0] + v[i][1] * v[i][1] + v[i][2] * v[i][2] + v[i][3] * v[i][3];
            const float rstd = rsqrtf(wave_sum(ss) * (1.0f / 1024.0f) + EPSF);
            if (MODE == 1) {
                float* op = outF + (size_t)(row0 + q) * 1024 + lane * 8;
                *(f32x4*)op = v[0] * rstd * ws[0]; *(f32x4*)(op + 4) = v[1] * rstd * ws[1]; *(f32x4*)(op + 512) = v[2] * rstd * ws[2]; *(f32x4*)(op + 516) = v[3] * rstd * ws[3];
                continue; }
            u32x4 o0, o1; f32x4 t;
            t = v[0] * rstd * ws[0] + sh[0]; o0.x = cvt_pk_bf16(t[0], t[1]); o0.y = cvt_pk_bf16(t[2], t[3]);
            t = v[1] * rstd * ws[1] + sh[1]; o0.z = cvt_pk_bf16(t[0], t[1]); o0.w = cvt_pk_bf16(t[2], t[3]);
            t = v[2] * rstd * ws[2] + sh[2]; o1.x = cvt_pk_bf16(t[0], t[1]); o1.y = cvt_pk_bf16(t[2], t[3]);
            t = v[3] * rstd * ws[3] + sh[3]; o1.z = cvt_pk_bf16(t[0], t[1]); o1.w = cvt_pk_bf16(t[2], t[3]);
            *(u32x4*)(H + (size_t)(row0 + q) * 1024 + lane * 8) = o0; *(u32x4*)(H + (size_t)(row0 + q) * 1024 + 512 + lane * 8) = o1;
        }
    }
}

typedef float f32x2 __attribute__((ext_vector_type(2)));
template <int NC> struct ConvLd { u32 v[128 / (512 / (NC / 2)) + 4]; };
template <int NC>
__device__ __forceinline__ void stage_conv_load(ConvLd<NC>& L, const u16* XBC, int row0, int col0) {
    constexpr int NP = NC / 2, NTG = 512 / NP, TPG = 128 / NTG;
    const int tid = tid_fresh(), cp = tid % NP, tg = tid / NP, ch = col0 + 2 * cp, l0 = tg * TPG;
    const u16* p = XBC + (ptrdiff_t)(row0 + l0 - 2) * 1536 + ch;
#pragma unroll
    for (int i = 0; i < TPG + 4; ++i) L.v[i] = *(const u32*)(p + (size_t)i * 1536);
}
template <int NC, bool TR>
__device__ __forceinline__ void stage_conv_compute(const ConvLd<NC>& L, LAS u16* dst, int ld, int row0, int seq0, int seq1, int col0, const float* cw, const float* cb) {
    constexpr int NP = NC / 2, NTG = 512 / NP, TPG = 128 / NTG;
    const int tid = tid_fresh(), cp = tid % NP, tg = tid / NP, ch = col0 + 2 * cp, l0 = tg * TPG;
    f32x2 w[5];
#pragma unroll
    for (int k = 0; k < 5; ++k) w[k] = *(const f32x2*)(cw + k * 1536 + ch);
    const f32x2 bias = *(const f32x2*)(cb + ch);
    const int rlo = row0 + l0 - 2;
    const bool z0 = rlo < seq0, z1 = rlo + 1 < seq0, z2 = rlo + TPG + 2 >= seq1, z3 = rlo + TPG + 3 >= seq1;
#pragma unroll
    for (int q = 0; q < TPG / 8; ++q) {
        f32x2 in[12];
#pragma unroll
        for (int i = 0; i < 12; ++i) { const int gi = 8 * q + i; u32 v = L.v[gi];
            if (gi == 0) v = z0 ? 0u : v; if (gi == 1) v = z1 ? 0u : v; if (gi == TPG + 2) v = z2 ? 0u : v; if (gi == TPG + 3) v = z3 ? 0u : v;
            in[i][0] = lo_f(v); in[i][1] = hi_f(v); }
        float o0[8], o1[8];
        f32x2 acc8[8];
#pragma unroll
        for (int t = 0; t < 8; ++t) acc8[t] = bias;
#pragma unroll
        for (int k = 0; k < 5; ++k)
#pragma unroll
            for (int t = 0; t < 8; ++t) acc8[t] = in[t + k] * w[k] + acc8[t];
        f32x2 e8[8];
#pragma unroll
        for (int t = 0; t < 8; ++t) { e8[t] = acc8[t] * (-1.4426950408889634f); }
#pragma unroll
        for (int t = 0; t < 8; ++t) { e8[t][0] = __builtin_amdgcn_exp2f(e8[t][0]); e8[t][1] = __builtin_amdgcn_exp2f(e8[t][1]); }
#pragma unroll
        for (int t = 0; t < 8; ++t) { e8[t] = e8[t] + 1.0f; }
#pragma unroll
        for (int t = 0; t < 8; ++t) { e8[t][0] = __builtin_amdgcn_rcpf(e8[t][0]); e8[t][1] = __builtin_amdgcn_rcpf(e8[t][1]); }
#pragma unroll
        for (int t = 0; t < 8; ++t) { const f32x2 o = acc8[t] * e8[t]; o0[t] = o[0]; o1[t] = o[1];
            if (!TR) *(LAS u32*)(dst + (l0 + 8 * q + t) * ld + 2 * cp) = cvt_pk_bf16(o[0], o[1]); }
        if (TR) {
            u32x4 a, b;
            a.x = cvt_pk_bf16(o0[0], o0[1]); a.y = cvt_pk_bf16(o0[2], o0[3]); a.z = cvt_pk_bf16(o0[4], o0[5]); a.w = cvt_pk_bf16(o0[6], o0[7]);
            b.x = cvt_pk_bf16(o1[0], o1[1]); b.y = cvt_pk_bf16(o1[2], o1[3]); b.z = cvt_pk_bf16(o1[4], o1[5]); b.w = cvt_pk_bf16(o1[6], o1[7]);
            *(LAS u32x4*)(dst + (2 * cp) * ld + l0 + 8 * q) = a; *(LAS u32x4*)(dst + (2 * cp + 1) * ld + l0 + 8 * q) = b;
        }
    }
}
template <int NC, bool TR>
__device__ __forceinline__ void stage_conv_impl(LAS u16* dst, int ld, const u16* XBC, int row0, int seq0, int seq1, int col0, const float* cw, const float* cb) {
    ConvLd<NC> L; stage_conv_load<NC>(L, XBC, row0, col0); stage_conv_compute<NC, TR>(L, dst, ld, row0, seq0, seq1, col0, cw, cb);
}
template <int NC> __device__ __forceinline__ void stage_conv(LAS u16* dst, int ld, const u16* XBC, int row0, int seq0, int seq1, int col0, const float* cw, const float* cb) {
    stage_conv_impl<NC, false>(dst, ld, XBC, row0, seq0, seq1, col0, cw, cb); }
template <int NC> __device__ __forceinline__ void stage_conv_t(LAS u16* dst, int ld, const u16* XBC, int row0, int seq0, int seq1, int col0, const float* cw, const float* cb) {
    stage_conv_impl<NC, true>(dst, ld, XBC, row0, seq0, seq1, col0, cw, cb); }

__device__ __forceinline__ void dtprep_item(const Params& P, LAS unsigned char* lds, int tc) {
    const int tid = tid_fresh(), dh = tid & 31, seg = tid >> 5, dir = dh >> 4, h = dh & 15;
    const bool isx = tc < 512; const int b = isx ? (tc >> 4) : ((tc - 512) >> 1); const int cidx = isx ? (tc & 15) : ((tc - 512) & 1);
    const int row0 = tc * 128;
    const int jscan = isx ? (dir ? 17 - cidx : cidx + 2) : (dir ? 1 - cidx : cidx);
    const float bias = dir ? P.dtbb[h] : P.dtbf[h]; const float a = -__expf(dir ? P.alb[h] : P.alf[h]);
    const float* DT = (const float*)(P.ws + OFF_DT);
    float dt[8], cs[8];
#pragma unroll
    for (int i = 0; i < 8; ++i) { const float raw = DT[(size_t)(row0 + seg * 8 + i) * 32 + dh] + bias; dt[i] = (raw > 20.f) ? raw : log1pf(__expf(raw)); }
    float run = 0.f;
    if (dir == 0) {
#pragma unroll
        for (int i = 0; i < 8; ++i) { run += dt[i] * a; cs[i] = run; }
    } else {
#pragma unroll
        for (int i = 7; i >= 0; --i) { run += dt[i] * a; cs[i] = run; }
    }
    LAS float* segsum = (LAS float*)lds;
    segsum[seg * 32 + dh] = run;
    __syncthreads();
    float off = 0.f, tot = 0.f;
#pragma unroll
    for (int s2 = 0; s2 < 16; ++s2) { const float v = segsum[s2 * 32 + dh]; tot += v; if (dir == 0 ? (s2 < seg) : (s2 > seg)) off += v; }
    float* DTO = (float*)(P.ws + (dir ? OFF_DTB : OFF_DTF)); float* CSO = (float*)(P.ws + (dir ? OFF_CSB : OFF_CSF));
#pragma unroll
    for (int i = 0; i < 8; ++i) { const size_t o = (size_t)(row0 + seg * 8 + i) * 16 + h; DTO[o] = dt[i]; CSO[o] = cs[i] + off; }
    if (seg == 0) ((float*)(P.ws + OFF_CDEC))[((b * 2 + dir) * 18 + jscan) * 16 + h] = __expf(tot);
    __syncthreads();
}

__device__ __forceinline__ void uconv_load(const Params& P, int item, u32x4 (&raw)[4]) {
    const int tid = tid_fresh(); const bool isH = item < 2048; const int e = item & 2047, b = e >> 6, q = (e >> 1) & 31, chalf = e & 1;
    const u16* Ug = (const u16*)(P.ws + OFF_U); const int choff = (isH ? 0 : 512) + 256 * chalf;
#pragma unroll
    for (int i = 0; i < 4; ++i) { const int idx = tid + 512 * i, tok = idx >> 5, c8 = idx & 31; int grow;
        if (isH) grow = b * 2048 + q * 64 + tok; else grow = b * 2048 + (tok & 31) * 64 + 2 * q + (tok >> 5);
        raw[i] = *(const u32x4*)(Ug + (size_t)grow * 1024 + choff + c8 * 8); }
}
__device__ __forceinline__ void uconv_item(const Params& P, LAS unsigned char* lds, int item, const u32x4 (&raw)[4], int nx, u32x4 (&rawn)[4]) {
    const int tid = tid_fresh(); const bool isH = item < 2048; const int e = item & 2047, b = e >> 6, q = (e >> 1) & 31, chalf = e & 1;
    LAS float* in = (LAS float*)lds;
    u16* Yg = (u16*)(P.ws + OFF_Y);
    const int choff = (isH ? 0 : 512) + 256 * chalf;
    const int cp = tid & 127, tq = tid >> 7, ch = choff + 2 * cp;
    f32x2 w[31];
#pragma unroll
    for (int k = 0; k < 31; ++k) w[k] = *(const f32x2*)(P.ccw + k * 1024 + ch);
    const f32x2 bias = *(const f32x2*)(P.ccb + ch);
    if (nx < 4096) uconv_load(P, nx, rawn);
#pragma unroll
    for (int i = 0; i < 4; ++i) { const int idx = tid + 512 * i, tok = idx >> 5, c8 = idx & 31; const int lrow = isH ? (15 + tok) : ((tok >> 5) * 62 + 15 + (tok & 31));
        const u32x4 v = raw[i];
        *(LAS f32x4*)(in + lrow * 256 + c8 * 8) = (f32x4){lo_f(v.x), hi_f(v.x), lo_f(v.y), hi_f(v.y)};
        *(LAS f32x4*)(in + lrow * 256 + c8 * 8 + 4) = (f32x4){lo_f(v.z), hi_f(v.z), lo_f(v.w), hi_f(v.w)}; }
    { const int npad = isH ? 30 : 60;
      for (int idx = tid; idx < npad * 64; idx += 512) { const int pr = idx >> 6, c4 = idx & 63; int lrow;
          if (isH) lrow = (pr < 15) ? pr : 64 + pr; else { const int line = pr / 30, k = pr % 30; lrow = line * 62 + ((k < 15) ? k : 32 + k); }
          *(LAS f32x4*)(in + lrow * 256 + c4 * 4) = (f32x4){0.f, 0.f, 0.f, 0.f}; } }
    LDS_BARRIER();
    const int base_row = isH ? 16 * tq : (62 * (tq >> 1) + 16 * (tq & 1));
    f32x2 win[46];
#pragma unroll
    for (int i = 0; i < 46; ++i) win[i] = *(const LAS f32x2*)(in + (base_row + i) * 256 + 2 * cp);
    const int g0 = isH ? (b * 2048 + q * 64 + 16 * tq) : (b * 2048 + (16 * (tq & 1)) * 64 + 2 * q + (tq >> 1));
    const int gstep = isH ? 1 : 64;
#pragma unroll
    for (int og = 0; og < 16; og += 8) {
        f32x2 a[8];
#pragma unroll
        for (int j = 0; j < 8; ++j) a[j] = bias;
#pragma unroll
        for (int k = 0; k < 31; ++k)
#pragma unroll
            for (int j = 0; j < 8; ++j) a[j] = win[og + j + k] * w[k] + a[j];
#pragma unroll
        for (int j = 0; j < 8; ++j) *(u32*)(Yg + (size_t)(g0 + (og + j) * gstep) * 2048 + 1024 + ch) = cvt_pk_bf16(a[j][0], a[j][1]);
    }
    LDS_BARRIER();
}

__device__ __forceinline__ void phase_p6(const Params& P, LAS unsigned char* lds) {
    for (int it = blockIdx.x; it < 576; it += gridDim.x) dtprep_item(P, lds, it);
}

__device__ __forceinline__ bf16x8 gather8(const LAS u16* p, int stride) {
    bf16x8 r;
#pragma unroll
    for (int j = 0; j < 8; ++j) r[j] = (short)p[j * stride];
    return r;
}
#define MFMA32(a, b, c) __builtin_amdgcn_mfma_f32_32x32x16_bf16((a), (b), (c), 0, 0, 0)

__device__ __forceinline__ void s1_item(const Params& P, LAS unsigned char* lds, int item) {
    const int tid = tid_fresh(), w = tid >> 6, lane = tid & 63, r = lane & 31, hf = lane >> 5;
    const int g = item & 1, tc = (item >> 1) % 18, b = item / 36;
    const bool isx = tc < 16;
    const int seq0 = isx ? b * 2048 : TX + b * 256, seq1 = seq0 + (isx ? 2048 : 256), row0 = seq0 + 128 * (isx ? tc : tc - 16);
    const int jf = isx ? tc + 2 : tc - 16, jb = 17 - tc;
    LAS u16* BT = (LAS u16*)lds;
    LAS u16* XT = (LAS u16*)(lds + 34816);
    LAS float* wfb = (LAS float*)(lds + 34816 + 69632);
    const u16* XBC = (const u16*)(P.ws + OFF_XBC);
    const float *CSF = (const float*)(P.ws + OFF_CSF), *CSB = (const float*)(P.ws + OFF_CSB), *DTF = (const float*)(P.ws + OFF_DTF), *DTB = (const float*)(P.ws + OFF_DTB);
    u16* ST = (u16*)(P.ws + OFF_ST);
    LAS float* dtl = (LAS float*)(lds + 108544);
    LAS float* csl = dtl + 2048;
    LAS float* segs = csl + 2048;
    {
        const int dh = tid & 15, seg = tid >> 4, dir = dh >> 3, hx = 8 * g + (dh & 7);
        const float bias = dir ? P.dtbb[hx] : P.dtbf[hx]; const float a = -__expf(dir ? P.alb[hx] : P.alf[hx]);
        const float* DT = (const float*)(P.ws + OFF_DT);
        float dt[4], cs[4];
#pragma unroll
        for (int i = 0; i < 4; ++i) { const float raw = DT[(size_t)(row0 + seg * 4 + i) * 32 + dir * 16 + hx] + bias; dt[i] = (raw > 20.f) ? raw : log1pf(__expf(raw)); }
        float run = 0.f;
        if (dir == 0) {
#pragma unroll
            for (int i = 0; i < 4; ++i) { run += dt[i] * a; cs[i] = run; }
        } else {
#pragma unroll
            for (int i = 3; i >= 0; --i) { run += dt[i] * a; cs[i] = run; }
        }
        segs[seg * 16 + dh] = run;
        LDS_BARRIER();
        float off = 0.f, tot = 0.f;
#pragma unroll
        for (int s2 = 0; s2 < 32; ++s2) { const float v = segs[s2 * 16 + dh]; tot += v; if (dir == 0 ? (s2 < seg) : (s2 > seg)) off += v; }
        float* DTO = (float*)(P.ws + (dir ? OFF_DTB : OFF_DTF)); float* CSO = (float*)(P.ws + (dir ? OFF_CSB : OFF_CSF));
#pragma unroll
        for (int i = 0; i < 4; ++i) { const int l = seg * 4 + i; const size_t o = (size_t)(row0 + l) * 16 + hx; const float c = cs[i] + off;
            DTO[o] = dt[i]; CSO[o] = c; dtl[dh * 128 + l] = dt[i]; csl[dh * 128 + l] = c; }
        if (seg == 0) ((float*)(P.ws + OFF_CDEC))[((b * 2 + dir) * 18 + (dir ? jb : jf)) * 16 + hx] = __expf(tot);
    }
    stage_conv_t<128>(BT, 136, XBC, row0, seq0, seq1, 1024 + 128 * g, P.scw, P.scb);
    LDS_BARRIER();
    const int hq = w >> 1, pb = w & 1;
    for (int pass = 0; pass < 2; ++pass) {
        const int h0 = 8 * g + 4 * pass, h = h0 + hq;
        stage_conv_t<256>(XT, 136, XBC, row0, seq0, seq1, 64 * h0, P.scw, P.scb);
#pragma unroll
        for (int e = 0; e < 2; ++e) { const int idx = tid + 512 * e, hh = idx >> 8, dir = (idx >> 7) & 1, l = idx & 127, dq = dir * 8 + 4 * pass + hh;
            wfb[(hh * 2 + dir) * 128 + l] = __expf(csl[dq * 128 + (dir ? 0 : 127)] - csl[dq * 128 + l]) * dtl[dq * 128 + l]; }
        __syncthreads();
        f32x16 acc[2][4];
#pragma unroll
        for (int d = 0; d < 2; ++d)
#pragma unroll
            for (int nb = 0; nb < 4; ++nb)
#pragma unroll
                for (int i = 0; i < 16; ++i) acc[d][nb][i] = 0.f;
#pragma unroll 2
        for (int ks = 0; ks < 8; ++ks) {
            const int lb = 16 * ks + 8 * hf;
            const bf16x8 xr = *(const LAS bf16x8*)(XT + (hq * 64 + 32 * pb + r) * 136 + lb);
            const f32x4 wf0 = *(const LAS f32x4*)(wfb + (hq * 2 + 0) * 128 + lb), wf1 = *(const LAS f32x4*)(wfb + (hq * 2 + 0) * 128 + lb + 4);
            const f32x4 wb0 = *(const LAS f32x4*)(wfb + (hq * 2 + 1) * 128 + lb), wb1 = *(const LAS f32x4*)(wfb + (hq * 2 + 1) * 128 + lb + 4);
            float xv[8];
#pragma unroll
            for (int j = 0; j < 8; ++j) xv[j] = bf2f((u16)xr[j]);
            u32x4 qf, qb;
            qf.x = cvt_pk_bf16(xv[0] * wf0[0], xv[1] * wf0[1]); qf.y = cvt_pk_bf16(xv[2] * wf0[2], xv[3] * wf0[3]); qf.z = cvt_pk_bf16(xv[4] * wf1[0], xv[5] * wf1[1]); qf.w = cvt_pk_bf16(xv[6] * wf1[2], xv[7] * wf1[3]);
            qb.x = cvt_pk_bf16(xv[0] * wb0[0], xv[1] * wb0[1]); qb.y = cvt_pk_bf16(xv[2] * wb0[2], xv[3] * wb0[3]); qb.z = cvt_pk_bf16(xv[4] * wb1[0], xv[5] * wb1[1]); qb.w = cvt_pk_bf16(xv[6] * wb1[2], xv[7] * wb1[3]);
            const bf16x8 xf = __builtin_bit_cast(bf16x8, qf), xb = __builtin_bit_cast(bf16x8, qb);
#pragma unroll
            for (int nb = 0; nb < 4; ++nb) { const bf16x8 bfr = *(const LAS bf16x8*)(BT + (32 * nb + r) * 136 + lb);
                acc[0][nb] = MFMA32(bfr, xf, acc[0][nb]); acc[1][nb] = MFMA32(bfr, xb, acc[1][nb]); }
        }
#pragma unroll
        for (int d = 0; d < 2; ++d) { const int j = d ? jb : jf;
            if (j <= 16) { u16* sp = ST + ((size_t)((b * 2 + d) * 17 + j) * 16 + h) * 8192 + ((pb * 4) * 64 + lane) * 16;
#pragma unroll
                for (int nb = 0; nb < 4; ++nb) { u32x4 q0, q1;
                    q0.x = cvt_pk_bf16(acc[d][nb][0], acc[d][nb][1]); q0.y = cvt_pk_bf16(acc[d][nb][2], acc[d][nb][3]); q0.z = cvt_pk_bf16(acc[d][nb][4], acc[d][nb][5]); q0.w = cvt_pk_bf16(acc[d][nb][6], acc[d][nb][7]);
                    q1.x = cvt_pk_bf16(acc[d][nb][8], acc[d][nb][9]); q1.y = cvt_pk_bf16(acc[d][nb][10], acc[d][nb][11]); q1.z = cvt_pk_bf16(acc[d][nb][12], acc[d][nb][13]); q1.w = cvt_pk_bf16(acc[d][nb][14], acc[d][nb][15]);
                    *(u32x4*)(sp + nb * 1024) = q0; *(u32x4*)(sp + nb * 1024 + 8) = q1; } } }
        LDS_BARRIER();
    }
}

__device__ __forceinline__ void phase_s2(const Params& P) {
    u16* ST = (u16*)(P.ws + OFF_ST); const float* CDEC = (const float*)(P.ws + OFF_CDEC);
    const int nth = gridDim.x * 512;
    for (int v = blockIdx.x * 512 + tid_fresh(); v < 32 * 2 * 16 * 1024; v += nth) {
        const int pn = (v & 1023) * 8, h = (v >> 10) & 15, bd = v >> 14;
        float hs[8];
#pragma unroll
        for (int j = 0; j < 8; ++j) hs[j] = 0.f;
        u16* base = ST + ((size_t)(bd * 17) * 16 + h) * 8192 + pn;
        u32x4 q[17]; float dec[17];
#pragma unroll
        for (int s = 0; s < 17; ++s) { q[s] = *(const u32x4*)(base + (size_t)s * 16 * 8192); dec[s] = CDEC[(bd * 18 + s) * 16 + h]; }
#pragma unroll
        for (int s = 0; s < 17; ++s) {
            const float d = dec[s];
            hs[0] = hs[0] * d + lo_f(q[s].x); hs[1] = hs[1] * d + hi_f(q[s].x); hs[2] = hs[2] * d + lo_f(q[s].y); hs[3] = hs[3] * d + hi_f(q[s].y);
            hs[4] = hs[4] * d + lo_f(q[s].z); hs[5] = hs[5] * d + hi_f(q[s].z); hs[6] = hs[6] * d + lo_f(q[s].w); hs[7] = hs[7] * d + hi_f(q[s].w);
            u32x4 o; o.x = cvt_pk_bf16(hs[0], hs[1]); o.y = cvt_pk_bf16(hs[2], hs[3]); o.z = cvt_pk_bf16(hs[4], hs[5]); o.w = cvt_pk_bf16(hs[6], hs[7]);
            *(u32x4*)(base + (size_t)s * 16 * 8192) = o;
        }
    }
}

__device__ __forceinline__ void s3_item(const Params& P, LAS unsigned char* lds, int item) {
    const int tid = tid_fresh(), w = tid >> 6, lane = tid & 63, r = lane & 31, hf = lane >> 5;
    const int g = item & 1, c = (item >> 1) & 15, b = item >> 5;
    const int seq0 = b * 2048, seq1 = seq0 + 2048, row0 = seq0 + 128 * c;
    LAS u16* Cs = (LAS u16*)lds;
    LAS u16* Gs = (LAS u16*)(lds + 34816);
    LAS u16* XT = (LAS u16*)(lds + 69632);
    LAS u16* Bs = XT;
    LAS float* ar = (LAS float*)(lds + 139264);
    LAS float* ssq = (LAS float*)(lds + 147456);
    const u16* XBC = (const u16*)(P.ws + OFF_XBC); const u16* ST = (const u16*)(P.ws + OFF_ST); u16* Yg = (u16*)(P.ws + OFF_Y);
    const float *CSF = (const float*)(P.ws + OFF_CSF), *CSB = (const float*)(P.ws + OFF_CSB), *DTF = (const float*)(P.ws + OFF_DTF), *DTB = (const float*)(P.ws + OFF_DTB);
    ConvLd<256> LX;
    stage_conv<128>(Cs, 136, XBC, row0, seq0, seq1, 1280 + 128 * g, P.scw, P.scb);
    stage_conv<128>(Bs, 136, XBC, row0, seq0, seq1, 1024 + 128 * g, P.scw, P.scb);
    if (tid < 128) ssq[tid] = 0.f;
    LDS_BARRIER();
    {
        const int wr2 = w >> 1, wc2 = w & 1;
        f32x16 g0, g1;
#pragma unroll
        for (int i = 0; i < 16; ++i) { g0[i] = 0.f; g1[i] = 0.f; }
#pragma unroll 2
        for (int ks = 0; ks < 8; ++ks) {
            const bf16x8 a = *(const LAS bf16x8*)(Cs + (32 * wr2 + r) * 136 + 16 * ks + 8 * hf);
            const bf16x8 b0 = *(const LAS bf16x8*)(Bs + (64 * wc2 + r) * 136 + 16 * ks + 8 * hf);
            const bf16x8 b1 = *(const LAS bf16x8*)(Bs + (64 * wc2 + 32 + r) * 136 + 16 * ks + 8 * hf);
            g0 = MFMA32(a, b0, g0); g1 = MFMA32(a, b1, g1);
        }
#pragma unroll
        for (int i = 0; i < 16; ++i) { const int l = 32 * wr2 + (i & 3) + 8 * (i >> 2) + 4 * hf;
            Gs[l * 136 + 64 * wc2 + r] = f2bf(g0[i]); Gs[l * 136 + 64 * wc2 + 32 + r] = f2bf(g1[i]); }
    }
    LDS_BARRIER();
    const int hq = __builtin_amdgcn_readfirstlane(w >> 1), rbh = __builtin_amdgcn_readfirstlane(w & 1);
#pragma unroll
    for (int pass = 0; pass < 2; ++pass) {
        const int h0 = 8 * g + 4 * pass, h = h0 + hq;
        if (pass == 0) stage_conv_load<256>(LX, XBC, row0, 64 * h0);
        float av[4];
#pragma unroll
        for (int e = 0; e < 4; ++e) { const int idx = tid + 512 * e, hh = idx >> 9, which = (idx >> 7) & 3, l = idx & 127;
            const float* srcp = (which == 0) ? CSF : (which == 1) ? CSB : (which == 2) ? DTF : DTB; av[e] = srcp[(size_t)(row0 + l) * 16 + h0 + hh]; }
        const u16* stf = ST + ((size_t)((b * 2 + 0) * 17 + (c + 1)) * 16 + h) * 8192 + lane * 16;
        const u16* stb = ST + ((size_t)((b * 2 + 1) * 17 + (16 - c)) * 16 + h) * 8192 + lane * 16;
        u32x4 hfr[2][2][2][2];
#pragma unroll
        for (int cb = 0; cb < 2; ++cb)
#pragma unroll
            for (int nl = 0; nl < 2; ++nl)
#pragma unroll
                for (int sx = 0; sx < 2; ++sx) { const int off = ((cb * 4 + nl) * 64) * 16 + 8 * sx; hfr[0][cb][nl][sx] = *(const u32x4*)(stf + off); hfr[1][cb][nl][sx] = *(const u32x4*)(stb + off); }
        stage_conv_compute<256, true>(LX, XT, 136, row0, seq0, seq1, 64 * h0, P.scw, P.scb);
#pragma unroll
        for (int e = 0; e < 4; ++e) { const int idx = tid + 512 * e, which = (idx >> 7) & 3; ar[idx] = av[e] * ((which < 2) ? 1.4426950408889634f : 1.0f); }
        LDS_BARRIER();
        LAS float* A = ar + hq * 512;
        f32x16 acc[2][2];
#pragma unroll
        for (int a = 0; a < 2; ++a)
#pragma unroll
            for (int cb = 0; cb < 2; ++cb)
#pragma unroll
                for (int i = 0; i < 16; ++i) acc[a][cb][i] = 0.f;
        const int l0 = 64 * rbh + r, l1 = l0 + 32;
        const float csf0 = A[l0], csb0 = A[128 + l0], dg0 = A[256 + l0] + A[384 + l0], csf1 = A[l1], csb1 = A[128 + l1], dg1 = A[256 + l1] + A[384 + l1];
        const float ef0 = __builtin_amdgcn_exp2f(csf0), eb0 = __builtin_amdgcn_exp2f(csb0), ef1 = __builtin_amdgcn_exp2f(csf1), eb1 = __builtin_amdgcn_exp2f(csb1), dsk = P.ssm_d[h];
#define S3_OFF(NBH) do { _Pragma("unroll") for (int nl = 0; nl < 2; ++nl) _Pragma("unroll") for (int sx = 0; sx < 2; ++sx) { const int no = 32 * (2 * (NBH) + nl) + 16 * sx + 4 * hf; \
            _Pragma("unroll") for (int rb2 = 0; rb2 < 2; ++rb2) { const int l = rb2 ? l1 : l0; const float ef = rb2 ? ef1 : ef0, eb = rb2 ? eb1 : eb0; \
                const u32x2 clo = *(const LAS u32x2*)(Cs + l * 136 + no), chi = *(const LAS u32x2*)(Cs + l * 136 + no + 8); \
                const float c0 = lo_f(clo.x), c1 = hi_f(clo.x), c2 = lo_f(clo.y), c3 = hi_f(clo.y), c4 = lo_f(chi.x), c5 = hi_f(chi.x), c6 = lo_f(chi.y), c7 = hi_f(chi.y); \
                u32x4 qf, qb; qf.x = cvt_pk_bf16(c0 * ef, c1 * ef); qf.y = cvt_pk_bf16(c2 * ef, c3 * ef); qf.z = cvt_pk_bf16(c4 * ef, c5 * ef); qf.w = cvt_pk_bf16(c6 * ef, c7 * ef); \
                qb.x = cvt_pk_bf16(c0 * eb, c1 * eb); qb.y = cvt_pk_bf16(c2 * eb, c3 * eb); qb.z = cvt_pk_bf16(c4 * eb, c5 * eb); qb.w = cvt_pk_bf16(c6 * eb, c7 * eb); \
                const bf16x8 af = __builtin_bit_cast(bf16x8, qf), ab = __builtin_bit_cast(bf16x8, qb); \
                _Pragma("unroll") for (int cb = 0; cb < 2; ++cb) { acc[rb2][cb] = MFMA32(af, __builtin_bit_cast(bf16x8, hfr[0][cb][nl][sx]), acc[rb2][cb]); \
                    acc[rb2][cb] = MFMA32(ab, __builtin_bit_cast(bf16x8, hfr[1][cb][nl][sx]), acc[rb2][cb]); } } } } while (0)
        S3_OFF(0);
#pragma unroll
        for (int cb = 0; cb < 2; ++cb)
#pragma unroll
            for (int nl = 0; nl < 2; ++nl)
#pragma unroll
                for (int sx = 0; sx < 2; ++sx) { const int off = ((cb * 4 + 2 + nl) * 64) * 16 + 8 * sx; hfr[0][cb][nl][sx] = *(const u32x4*)(stf + off); hfr[1][cb][nl][sx] = *(const u32x4*)(stb + off); }
#pragma unroll 1
        for (int ks = 0; ks < 8; ++ks) {
            const int sb = 16 * ks + 8 * hf;
            const bf16x8 x0 = *(const LAS bf16x8*)(XT + (hq * 64 + r) * 136 + sb), x1 = *(const LAS bf16x8*)(XT + (hq * 64 + 32 + r) * 136 + sb);
#pragma unroll
            for (int rb2 = 0; rb2 < 2; ++rb2) { const int l = rb2 ? l1 : l0; const float csf_l = rb2 ? csf1 : csf0, csb_l = rb2 ? csb1 : csb0;
                const int RB = 2 * rbh + rb2;
                const bf16x8 gv = *(const LAS bf16x8*)(Gs + l * 136 + sb); float o[8];
                if (ks < 2 * RB) {
                    const f32x4 c0 = *(const LAS f32x4*)(A + sb), c1 = *(const LAS f32x4*)(A + sb + 4), d0 = *(const LAS f32x4*)(A + 256 + sb), d1 = *(const LAS f32x4*)(A + 256 + sb + 4);
#pragma unroll
                    for (int j = 0; j < 4; ++j) { o[j] = bf2f((u16)gv[j]) * (__builtin_amdgcn_exp2f(csf_l - c0[j]) * d0[j]); o[4 + j] = bf2f((u16)gv[4 + j]) * (__builtin_amdgcn_exp2f(csf_l - c1[j]) * d1[j]); }
                } else if (ks > 2 * RB + 1) {
                    const f32x4 c0 = *(const LAS f32x4*)(A + 128 + sb), c1 = *(const LAS f32x4*)(A + 128 + sb + 4), d0 = *(const LAS f32x4*)(A + 384 + sb), d1 = *(const LAS f32x4*)(A + 384 + sb + 4);
#pragma unroll
                    for (int j = 0; j < 4; ++j) { o[j] = bf2f((u16)gv[j]) * (__builtin_amdgcn_exp2f(csb_l - c0[j]) * d0[j]); o[4 + j] = bf2f((u16)gv[4 + j]) * (__builtin_amdgcn_exp2f(csb_l - c1[j]) * d1[j]); }
                } else {
                    float cfs[8], cbs[8], dfs[8], dbs[8];
#pragma unroll
                    for (int q = 0; q < 2; ++q) { const f32x4 t0 = *(const LAS f32x4*)(A + sb + 4 * q), t1 = *(const LAS f32x4*)(A + 128 + sb + 4 * q), t2 = *(const LAS f32x4*)(A + 256 + sb + 4 * q), t3 = *(const LAS f32x4*)(A + 384 + sb + 4 * q);
#pragma unroll
                        for (int j = 0; j < 4; ++j) { cfs[4 * q + j] = t0[j]; cbs[4 * q + j] = t1[j]; dfs[4 * q + j] = t2[j]; dbs[4 * q + j] = t3[j]; } }
#pragma unroll
                    for (int j = 0; j < 8; ++j) { const int ss = sb + j; const bool le = ss <= l, eq = ss == l;
                        const float arg = le ? (csf_l - cfs[j]) : (csb_l - cbs[j]), sc = le ? dfs[j] : dbs[j];
                        const float f = __builtin_amdgcn_exp2f(arg) * sc + (eq ? dbs[j] : 0.f);
                        o[j] = bf2f((u16)gv[j]) * f + (eq ? dsk : 0.f); }
                }
                u32x4 q; q.x = cvt_pk_bf16(o[0], o[1]); q.y = cvt_pk_bf16(o[2], o[3]); q.z = cvt_pk_bf16(o[4], o[5]); q.w = cvt_pk_bf16(o[6], o[7]);
                const bf16x8 am = __builtin_bit_cast(bf16x8, q);
                acc[rb2][0] = MFMA32(am, x0, acc[rb2][0]); acc[rb2][1] = MFMA32(am, x1, acc[rb2][1]); }
        }
        S3_OFF(1);
#undef S3_OFF
        if (pass == 0) stage_conv_load<256>(LX, XBC, row0, 64 * (8 * g + 4));
        u32x4 zv[8];
        { const int t5 = tid_fresh(); const u16* zb = Yg + (size_t)row0 * 2048 + 64 * h0 + (t5 & 31) * 8;
#pragma unroll
          for (int e = 0; e < 8; ++e) zv[e] = *(const u32x4*)(zb + (size_t)((t5 >> 5) + 16 * e) * 2048); }
        LDS_BARRIER();
#pragma unroll
        for (int rb2 = 0; rb2 < 2; ++rb2)
#pragma unroll
            for (int cb = 0; cb < 2; ++cb)
#pragma unroll
                for (int i = 0; i < 16; i += 2) { const u32 pk = cvt_pk_bf16(acc[rb2][cb][i], acc[rb2][cb][i + 1]);
                    const int ro = (64 * rbh + 32 * rb2 + 8 * (i >> 2) + 4 * hf + (i & 3)) * 264 + hq * 64 + 32 * cb + r;
                    XT[ro] = (u16)(pk & 0xffffu); XT[ro + 264] = (u16)(pk >> 16); }
        LDS_BARRIER();
        {
            const int t2 = tid_fresh();
            u16* yb = Yg + (size_t)row0 * 2048 + 64 * h0 + (t2 & 31) * 8;
#pragma unroll
            for (int e = 0; e < 8; ++e) { const int l = (t2 >> 5) + 16 * e; const u32x4 yv = *(const LAS u32x4*)(XT + l * 264 + (t2 & 31) * 8); const u32x4 z = zv[e];
                float v[8] = {lo_f(yv.x) * lo_f(z.x), hi_f(yv.x) * hi_f(z.x), lo_f(yv.y) * lo_f(z.y), hi_f(yv.y) * hi_f(z.y),
                              lo_f(yv.z) * lo_f(z.z), hi_f(yv.z) * hi_f(z.z), lo_f(yv.w) * lo_f(z.w), hi_f(yv.w) * hi_f(z.w)};
                float sv = 0.f;
#pragma unroll
                for (int j = 0; j < 8; ++j) sv += v[j] * v[j];
#pragma unroll
                for (int o = 16; o >= 1; o >>= 1) sv += __shfl_xor(sv, o);
                if ((t2 & 31) == 0) atomicAdd((float*)(ssq + l), sv);
                u32x4 q; q.x = cvt_pk_bf16(v[0], v[1]); q.y = cvt_pk_bf16(v[2], v[3]); q.z = cvt_pk_bf16(v[4], v[5]); q.w = cvt_pk_bf16(v[6], v[7]);
                *(u32x4*)(yb + (size_t)l * 2048) = q; }
        }
        if (pass == 1) { __syncthreads(); } else { LDS_BARRIER(); }
    }
    {
        const int t4 = tid_fresh();
        const int c8 = (t4 & 63) * 8;
        const f32x4 w0 = *(const f32x4*)(P.ssm_nw + 512 * g + c8), w1 = *(const f32x4*)(P.ssm_nw + 512 * g + c8 + 4);
        u16* ybase = Yg + (size_t)(row0 + (t4 >> 6)) * 2048 + 512 * g + c8;
#pragma unroll
        for (int hb = 0; hb < 1; ++hb) {
            u32x4 qv[16];
#pragma unroll
            for (int i = 0; i < 16; ++i) qv[i] = *(const u32x4*)(ybase + (size_t)i * 8 * 2048);
#pragma unroll
            for (int i = 0; i < 16; ++i) { const int l = (t4 >> 6) + 8 * i;
                const float rstd = rsqrtf(ssq[l] * (1.0f / 512.0f) + EPSF); const u32x4 q = qv[i];
                u32x4 o; o.x = cvt_pk_bf16(lo_f(q.x) * rstd * w0[0], hi_f(q.x) * rstd * w0[1]); o.y = cvt_pk_bf16(lo_f(q.y) * rstd * w0[2], hi_f(q.y) * rstd * w0[3]);
                o.z = cvt_pk_bf16(lo_f(q.z) * rstd * w1[0], hi_f(q.z) * rstd * w1[1]); o.w = cvt_pk_bf16(lo_f(q.w) * rstd * w1[2], hi_f(q.w) * rstd * w1[3]);
                *(u32x4*)(ybase + (size_t)(hb * 8 + i) * 8 * 2048) = o; }
        }
    }
    LDS_BARRIER();
}

__device__ __forceinline__ void phase_lnb(const Params& P) {
    constexpr int NR = 4;
    const int lane = tid_fresh() & 63, gw = blockIdx.x * 8 + (tid_fresh() >> 6), nwv = gridDim.x * 8;
    u16* Yg = (u16*)(P.ws + OFF_Y);
    f32x4 lw[4], lb[4];
#pragma unroll
    for (int i = 0; i < 4; ++i) { const int col = (i >> 1) * 512 + lane * 8 + (i & 1) * 4; lw[i] = *(const f32x4*)(P.lnw + col); lb[i] = *(const f32x4*)(P.lnb + col); }
    for (int row0 = gw * NR; row0 < TX; row0 += nwv * NR) {
        u32x4 raw[NR][2];
#pragma unroll
        for (int q = 0; q < NR; ++q) { const u16* p = Yg + (size_t)(row0 + q) * 2048 + 1024 + lane * 8; raw[q][0] = *(const u32x4*)p; raw[q][1] = *(const u32x4*)(p + 512); }
#pragma unroll
        for (int q = 0; q < NR; ++q) {
            f32x4 v[4];
            v[0] = (f32x4){lo_f(raw[q][0].x), hi_f(raw[q][0].x), lo_f(raw[q][0].y), hi_f(raw[q][0].y)}; v[1] = (f32x4){lo_f(raw[q][0].z), hi_f(raw[q][0].z), lo_f(raw[q][0].w), hi_f(raw[q][0].w)};
            v[2] = (f32x4){lo_f(raw[q][1].x), hi_f(raw[q][1].x), lo_f(raw[q][1].y), hi_f(raw[q][1].y)}; v[3] = (f32x4){lo_f(raw[q][1].z), hi_f(raw[q][1].z), lo_f(raw[q][1].w), hi_f(raw[q][1].w)};
            float s = 0.f;
#pragma unroll
            for (int i = 0; i < 4; ++i) s += (v[i][0] + v[i][1]) + (v[i][2] + v[i][3]);
            const float mu = wave_sum(s) * (1.0f / 1024.0f);
            float qq = 0.f;
#pragma unroll
            for (int i = 0; i < 4; ++i) { v[i] = v[i] - mu; qq += v[i][0] * v[i][0] + v[i][1] * v[i][1] + v[i][2] * v[i][2] + v[i][3] * v[i][3]; }
            const float rstd = rsqrtf(wave_sum(qq) * (1.0f / 1024.0f) + EPSF);
            u32x4 o[2];
#pragma unroll
            for (int i = 0; i < 4; ++i) { const f32x4 t = v[i] * rstd * lw[i] + lb[i];
                const u32 a = cvt_pk_bf16(silu_f(t[0]), silu_f(t[1])), b = cvt_pk_bf16(silu_f(t[2]), silu_f(t[3]));
                if ((i & 1) == 0) { o[i >> 1].x = a; o[i >> 1].y = b; } else { o[i >> 1].z = a; o[i >> 1].w = b; } }
            u16* p = Yg + (size_t)(row0 + q) * 2048 + 1024 + lane * 8;
            *(u32x4*)p = o[0]; *(u32x4*)(p + 512) = o[1];
        }
    }
}

template <int PH> __device__ __forceinline__ void run_phase(const Params& P, LAS unsigned char* lds) {
    unsigned char* ws = P.ws;
    const float* MOD = (const float*)(ws + OFF_MOD);
    if constexpr (PH == 0) phase_prep(P, lds);
    if constexpr (PH == 1) phase_norm<0>(P, P.x, P.ctx, TT, P.norm_ffn1, 0, 1, (u16*)(ws + OFF_H), nullptr);
    if constexpr (PH == 2) { Gemm gm{(const bf16_t*)(ws + OFF_H), (const bf16_t*)(ws + OFF_WGU1), TT, NGU, 1024}; StaticOrder S; S.init(TT, NGU, (int)gridDim.x, (int)blockIdx.x);
        EpiSwiGLU E{(bf16_t*)(ws + OFF_ACT)}; gemm_phase<EpiSwiGLU, StaticOrder, false>(lds, gm, S, E, nullptr); }
    if constexpr (PH == 3) { Gemm gm{(const bf16_t*)(ws + OFF_ACT), (const bf16_t*)(ws + OFF_WD1), TT, 1024, DFF}; StaticOrder S; S.init(TT, 1024, (int)gridDim.x, (int)blockIdx.x);
        EpiResidT<0, 1> E{P.x, P.out, P.ctx, ws + OFF_XC1, MOD + 2 * 1024, 0.5f}; gemm_phase<EpiResidT<0, 1>, StaticOrder, false>(lds, gm, S, E, nullptr); }
    if constexpr (PH == 4) phase_norm_b<0>(P, (const u16*)P.out, (const u16*)(ws + OFF_XC1), TT, P.norm_mix, 3, 4, (u16*)(ws + OFF_H), nullptr);
    if constexpr (PH == 5) { Gemm gm{(const bf16_t*)(ws + OFF_H), (const bf16_t*)(ws + OFF_WIN), TX, NIN, 1024}; InOrder S; S.init(TX, NIN, (int)gridDim.x, (int)blockIdx.x);
        EpiInProj E{(bf16_t*)(ws + OFF_XBC), (float*)(ws + OFF_DT), (bf16_t*)(ws + OFF_Y), (bf16_t*)(ws + OFF_U)}; gemm_phase<EpiInProj, InOrder, false>(lds, gm, S, E, nullptr); }
    if constexpr (PH == 6) phase_p6(P, lds);
    if constexpr (PH == 7) { for (int it = blockIdx.x; it < 1152; it += gridDim.x) s1_item(P, lds, it); }
    if constexpr (PH == 8) {
        const int mine = (int)(blockIdx.x % 16u); int k = 0; bool done = false;
        u32x4 raw[4], rawn[4];
        if ((int)blockIdx.x < 4096) uconv_load(P, blockIdx.x, raw);
        for (int it = blockIdx.x; it < 4096; it += gridDim.x, ++k) { if (k == mine) { phase_s2(P); done = true; }
            uconv_item(P, lds, it, raw, it + (int)gridDim.x, rawn);
#pragma unroll
            for (int i = 0; i < 4; ++i) raw[i] = rawn[i]; }
        if (!done) phase_s2(P);
    }
    if constexpr (PH == 9) { for (int it = blockIdx.x; it < 1024; it += gridDim.x) s3_item(P, lds, it); phase_lnb(P); }
    if constexpr (PH == 10) { Gemm gm{(const bf16_t*)(ws + OFF_Y), (const bf16_t*)(ws + OFF_WOUT), TX, 1024, 2048}; StaticOrder S; S.init(TX, 1024, (int)gridDim.x, (int)blockIdx.x);
        EpiResidT<1, 1> E{P.out, ws + OFF_XBC, P.out, ws + OFF_XBC, MOD + 5 * 1024, 1.0f}; gemm_phase<EpiResidT<1, 1>, StaticOrder, false>(lds, gm, S, E, nullptr); }
    if constexpr (PH == 11) phase_norm_b<0>(P, (const u16*)(ws + OFF_XBC), (const u16*)(ws + OFF_XBC), TX, P.norm_ffn2, 6, 7, (u16*)(ws + OFF_H), nullptr);
    if constexpr (PH == 12) { Gemm gm{(const bf16_t*)(ws + OFF_H), (const bf16_t*)(ws + OFF_WGU2), TX, NGU, 1024}; StaticOrder S; S.init(TX, NGU, (int)gridDim.x, (int)blockIdx.x);
        EpiSwiGLU E{(bf16_t*)(ws + OFF_ACT)}; gemm_phase<EpiSwiGLU, StaticOrder, false>(lds, gm, S, E, nullptr); }
    if constexpr (PH == 13) { Gemm gm{(const bf16_t*)(ws + OFF_ACT), (const bf16_t*)(ws + OFF_WD2), TX, 1024, DFF}; StaticOrder S; S.init(TX, 1024, (int)gridDim.x, (int)blockIdx.x);
        EpiResidT<1, 1> E{ws + OFF_XBC, ws + OFF_U, ws + OFF_XBC, ws + OFF_U, MOD + 8 * 1024, 0.5f}; gemm_phase<EpiResidT<1, 1>, StaticOrder, false>(lds, gm, S, E, nullptr); }
    if constexpr (PH == 14) phase_norm_b<1>(P, (const u16*)(ws + OFF_U), (const u16*)(ws + OFF_U), TX, P.fnorm, 0, 0, nullptr, P.out);
}

template <int PH> __global__ void __launch_bounds__(512, 2) k_one(Params P) {
    extern __shared__ __attribute__((aligned(16))) unsigned char shm[];
    run_phase<PH>(P, (LAS unsigned char*)shm);
}

__device__ __forceinline__ void grid_bar(unsigned* ctr, unsigned target) {
    __syncthreads();
    if (tid_fresh() == 0) {
        __builtin_amdgcn_fence(__ATOMIC_RELEASE, "agent");
        __hip_atomic_fetch_add(ctr, 1u, __ATOMIC_RELAXED, __HIP_MEMORY_SCOPE_AGENT);
        unsigned v;
        do { __builtin_amdgcn_s_sleep(1); v = __hip_atomic_load(ctr, __ATOMIC_RELAXED, __HIP_MEMORY_SCOPE_AGENT); asm volatile("" : "+v"(v)); } while (v < target);
        __builtin_amdgcn_fence(__ATOMIC_ACQUIRE, "agent");
    }
    __syncthreads();
}
constexpr bool phase_empty(int ph) { return ph == 6; }
template <int PH, int NB> __device__ __forceinline__ void run_all(const Params& P, LAS unsigned char* lds, cg::grid_group& grid) {
    unsigned* ctr = (unsigned*)(P.ws + OFF_BAR);
    if constexpr (PH == 0) { if (blockIdx.x == 0 && threadIdx.x == 0) __hip_atomic_store(ctr, 0u, __ATOMIC_RELAXED, __HIP_MEMORY_SCOPE_AGENT); }
    if constexpr (phase_empty(PH)) { if constexpr (PH + 1 < NPHASE) run_all<PH + 1, NB>(P, lds, grid); }
    else {
        run_phase<PH>(P, lds);
        constexpr int NXT = (PH + 1 < NPHASE && phase_empty(PH + 1)) ? PH + 2 : PH + 1;
        if constexpr (NXT < NPHASE) {
            if constexpr (PH == 0) grid.sync(); else grid_bar(ctr, (unsigned)NB * gridDim.x);
            run_all<NXT, (PH == 0 ? NB : NB + 1)>(P, lds, grid);
        }
    }
}
__global__ void __launch_bounds__(512, 2) mega(Params P) {
    extern __shared__ __attribute__((aligned(16))) unsigned char shm[];
    cg::grid_group grid = cg::this_grid();
    run_all<0, 1>(P, (LAS unsigned char*)shm, grid);
}

template <int PH> static void launch_each(int grid, hipStream_t stream, const Params& p) {
    static bool attr = false; if (!attr) { (void)hipFuncSetAttribute((const void*)k_one<PH>, hipFuncAttributeMaxDynamicSharedMemorySize, LDS_BYTES); attr = true; }
    hipLaunchKernelGGL(k_one<PH>, dim3(grid), dim3(512), LDS_BYTES, stream, p);
    if constexpr (PH + 1 < NPHASE) launch_each<PH + 1>(grid, stream, p);
}

#ifndef MK_MULTI
#define MK_MULTI 0
#endif
extern "C" void kernel_launch(void* const* d_in, const int* in_sizes, int n_in, void* d_out, int out_size, void* d_ws, size_t ws_size, hipStream_t stream) {
    static int grid = 0;
    if (grid == 0) {
        if (n_in != 30 || ws_size < WS_TOTAL) { fprintf(stderr, "kernel_launch: expected 30 inputs and >= %zu bytes of workspace (got %d, %zu)\n", (size_t)WS_TOTAL, n_in, ws_size); grid = -1; return; }
        int dev = 0, cus = 0, per_cu = 0;
        (void)hipGetDevice(&dev); (void)hipDeviceGetAttribute(&cus, hipDeviceAttributeMultiprocessorCount, dev);
        if (hipFuncSetAttribute((const void*)mega, hipFuncAttributeMaxDynamicSharedMemorySize, LDS_BYTES) != hipSuccess) { fprintf(stderr, "kernel_launch: hipFuncSetAttribute failed\n"); }
        if (hipOccupancyMaxActiveBlocksPerMultiprocessor(&per_cu, (const void*)mega, 512, LDS_BYTES) != hipSuccess || per_cu < 1) { fprintf(stderr, "kernel_launch: occupancy query says %d\n", per_cu); per_cu = 1; }
        (void)hipGetLastError();
        grid = cus * per_cu;
    }
    if (grid < 0) return;
    Params p{};
    const float** pp = (const float**)&p;
    for (int i = 0; i < 30; ++i) pp[i] = (const float*)d_in[i];
    p.out = (float*)d_out; p.ws = (unsigned char*)d_ws;
#if MK_MULTI
    launch_each<0>(grid, stream, p);
#else
    void* args[] = {&p};
    hipError_t e = hipLaunchCooperativeKernel((const void*)mega, dim3(grid), dim3(512), args, LDS_BYTES, stream);
    if (e != hipSuccess) fprintf(stderr, "kernel_launch: cooperative launch failed: %s (grid %d)\n", hipGetErrorString(e), grid);
#endif
}
```

```cpp
#include <hip/hip_runtime.h>
#include <hip/hip_cooperative_groups.h>
#include <cstdio>
namespace cg = cooperative_groups;
__device__ __forceinline__ int tid_fresh() { int t = (int)threadIdx.x; asm volatile("" : "+v"(t)); return t; }
namespace pg8 {
#define PG8_LAS __attribute__((address_space(3)))
typedef unsigned short bf16_t;
typedef short bf16x8 __attribute__((ext_vector_type(8)));
typedef float f32x4 __attribute__((ext_vector_type(4)));
typedef unsigned u32x4 __attribute__((ext_vector_type(4)));
constexpr int BM = 256, BK = 64, HALF = 128, HTB = HALF * BK * 2  , STAGE_BYTES = 8 * HTB, NXCD = 8, WGM = 8;

__host__ __device__ __forceinline__ int lds_byte(int r, int c) { const int st = (r >> 4) * 2 + (c >> 5), rr = r & 15, cc = c & 31, ob = rr * 64 + cc * 2; return st * 1024 + (ob ^ (((ob >> 9) & 1) << 5)); }
__host__ __device__ __forceinline__ void stage_rc(int b, int& R, int& C) { const int st = b / 1024, sb = b % 1024, swz = sb ^ (((sb >> 9) & 1) << 5); R = (st >> 1) * 16 + swz / 64; C = (st & 1) * 32 + (swz % 64) / 2; }
__host__ __device__ __forceinline__ int perm32(int rho) { const int n = rho >> 4, i = rho & 15; return 8 * (i >> 2) + 4 * n + (i & 3); }

struct Unit { int pm, pn; };
struct Gemm { const bf16_t* A; const bf16_t* Bt; int M, N, K; };

struct StaticOrder {
    int nM, nN, nwg, G, c;
    __host__ __device__ void init(int M, int N, int G_, int c_) { nM = M / BM; nN = N / BM; nwg = nM * nN; G = G_; c = c_; }
    __host__ __device__ bool next(int i, Unit& u) const {
        const long L = (long)i * G + c; if (L >= nwg) return false;
        int wgid = (int)L; { const int q = nwg / NXCD, r = nwg % NXCD, xcd = wgid % NXCD, off = wgid / NXCD; wgid = (xcd < r ? xcd * (q + 1) : r * (q + 1) + (xcd - r) * q) + off; }
        const int nig = WGM * nN, gid = wgid / nig, fm = gid * WGM, gsz = (nM - fm) < WGM ? (nM - fm) : WGM;
        u.pm = fm + ((wgid % nig) % gsz); u.pn = (wgid % nig) / gsz; return true;
    }
    __device__ __forceinline__ void a_ready(const Unit&) const {}
    __device__ __forceinline__ void done(const Unit&) const {}
};
__device__ __forceinline__ unsigned cvt_pk_bf16(float lo, float hi) { unsigned r; asm volatile("v_cvt_pk_bf16_f32 %0, %1, %2" : "=v"(r) : "v"(lo), "v"(hi)); return r; }
typedef float f32x2 __attribute__((ext_vector_type(2)));
template <class Epi, class Sched, bool STAMP = false>
__device__ __forceinline__ void gemm_phase(PG8_LAS unsigned char* lds, const Gemm g, const Sched& S, const Epi& E, unsigned long long* stamps) {
    const int tid = tid_fresh(), wid = __builtin_amdgcn_readfirstlane(tid >> 6), lane = tid & 63, wr = wid >> 2, wc = wid & 3, fr = lane & 15, fq = lane >> 4;
    const int K = g.K, nt = K / BK;
    int ts_lo = 0, ts_hi = 0, nts = 0; const unsigned long long rt_entry = STAMP ? (unsigned long long)wall_clock64() : 0ull;
#define PG8_STAMP() do { if (STAMP && wid == 0 && nts < 64) { const unsigned long long _c = (unsigned long long)clock64(); \
        ts_lo = (lane == nts) ? (int)(unsigned)_c : ts_lo; ts_hi = (lane == nts) ? (int)(unsigned)(_c >> 32) : ts_hi; ++nts; } } while (0)
    PG8_STAMP();
    unsigned voffA[2], voffB[2];
#pragma unroll
    for (int i = 0; i < 2; ++i) { int R, C; stage_rc(tid * 16 + i * 8192, R, C); const int Rb = Epi::PERM ? ((R & ~31) + perm32(R & 31)) : R;
        voffA[i] = (unsigned)(R * K + C) * 2u; voffB[i] = (unsigned)(Rb * K + C) * 2u; }
    const size_t kstep = (size_t)(BK * 2);
    const size_t hstep = (size_t)HALF * K * 2;
    const size_t tstep = 2 * hstep;
    const unsigned ldsw = (unsigned)wid * 1024u;
    const int aoff = lds_byte(wr * 64 + fr, fq * 8), boff = lds_byte(wc * 32 + fr, fq * 8);
#define PG8_SA(b, h) (((b) * 2 + (h)) * HTB)
#define PG8_SB(b, h) ((4 + (b) * 2 + (h)) * HTB)
#define PG8_STAGE(bufoff, gbase, voff) do { _Pragma("unroll") for (int _i = 0; _i < 2; ++_i) \
        __builtin_amdgcn_global_load_lds((const unsigned*)((const char*)(gbase) + (voff)[_i]), (PG8_LAS unsigned*)(lds + (bufoff) + ldsw + _i * 8192), 16, 0, 0); } while (0)
#define PG8_LDA(dst, b, h) do { _Pragma("unroll") for (int m = 0; m < 4; ++m) _Pragma("unroll") for (int k = 0; k < 2; ++k) dst[m][k] = *(const PG8_LAS bf16x8*)(lds + PG8_SA(b, h) + aoff + m * 2048 + k * 1024); } while (0)
#define PG8_LDB(dst, b, h) do { _Pragma("unroll") for (int n = 0; n < 2; ++n) _Pragma("unroll") for (int k = 0; k < 2; ++k) dst[n][k] = *(const PG8_LAS bf16x8*)(lds + PG8_SB(b, h) + boff + n * 2048 + k * 1024); } while (0)
#define PG8_MMA(ai, bj, At, Bt) do { __builtin_amdgcn_s_setprio(1); _Pragma("unroll") for (int m = 0; m < 4; ++m) _Pragma("unroll") for (int n = 0; n < 2; ++n) _Pragma("unroll") for (int k = 0; k < 2; ++k) \
        acc[ai][bj][m][n] = __builtin_amdgcn_mfma_f32_16x16x32_bf16(Bt[n][k], At[m][k], acc[ai][bj][m][n], 0, 0, 0); __builtin_amdgcn_s_setprio(0); } while (0)
#define PG8_WAIT_V(n) asm volatile("s_waitcnt vmcnt(" #n ")" ::: "memory")
#define PG8_WAIT_L(n) asm volatile("s_waitcnt lgkmcnt(" #n ")" ::: "memory")
#define PG8_BAR __builtin_amdgcn_s_barrier()
#define PG8_SCHED __builtin_amdgcn_sched_barrier(0)
    Unit cur, nxt; int ui = 0;
    if (!S.next(0, cur)) return;
    f32x4 acc[2][2][4][2];
#pragma unroll
    for (int a = 0; a < 2; ++a)
#pragma unroll
        for (int b = 0; b < 2; ++b)
#pragma unroll
            for (int m = 0; m < 4; ++m)
#pragma unroll
                for (int n = 0; n < 2; ++n) acc[a][b][m][n] = (f32x4){0.f, 0.f, 0.f, 0.f};
    bf16x8 At[4][2], B0[2][2], B1[2][2];
    const char* cA = (const char*)g.A + (size_t)cur.pm * tstep; const char* cB = (const char*)g.Bt + (size_t)cur.pn * tstep;
    S.a_ready(cur);
    PG8_STAGE(PG8_SB(0, 0), cB, voffB); PG8_STAGE(PG8_SA(0, 0), cA, voffA); PG8_STAGE(PG8_SB(0, 1), cB + hstep, voffB); PG8_STAGE(PG8_SA(0, 1), cA + hstep, voffA);
    if (wr == 1) PG8_BAR;
    PG8_WAIT_V(4); PG8_BAR;
    PG8_STAGE(PG8_SB(1, 0), cB + kstep, voffB); PG8_STAGE(PG8_SA(1, 0), cA + kstep, voffA); PG8_STAGE(PG8_SB(1, 1), cB + hstep + kstep, voffB);
    PG8_WAIT_V(6); PG8_BAR;
    PG8_STAMP();
    for (;;) {
        const bool has_next = S.next(ui + 1, nxt);
        const char* nA = has_next ? (const char*)g.A + (size_t)nxt.pm * tstep : cA; const char* nB = has_next ? (const char*)g.Bt + (size_t)nxt.pn * tstep : cB;
        for (int t = 0; t < nt; t += 2) {
            const bool last = (t == nt - 2);
            const char* a1 = cA + (size_t)(t + 1) * kstep;
            const char* a2 = last ? nA : cA + (size_t)(t + 2) * kstep; const char* b2 = last ? nB : cB + (size_t)(t + 2) * kstep;
            const char* a3 = a2 + kstep; const char* b3 = b2 + kstep;
            if (last && has_next) S.a_ready(nxt);
            PG8_LDB(B0, 0, 0); PG8_SCHED; PG8_LDA(At, 0, 0); PG8_STAGE(PG8_SA(1, 1), a1 + hstep, voffA);
            PG8_WAIT_L(8); PG8_BAR; PG8_WAIT_L(0); PG8_MMA(0, 0, At, B0); PG8_BAR; PG8_SCHED;
            PG8_LDB(B1, 0, 1); PG8_STAGE(PG8_SB(0, 0), b2, voffB);
            PG8_BAR; PG8_WAIT_L(0); PG8_MMA(0, 1, At, B1); PG8_BAR;
            PG8_LDA(At, 0, 1); PG8_STAGE(PG8_SA(0, 0), a2, voffA);
            PG8_BAR; PG8_WAIT_L(0); PG8_MMA(1, 0, At, B0); PG8_BAR; PG8_SCHED;
            PG8_STAGE(PG8_SB(0, 1), b2 + hstep, voffB);
            PG8_WAIT_V(6); PG8_BAR; PG8_MMA(1, 1, At, B1); PG8_BAR;
            PG8_LDB(B0, 1, 0); PG8_SCHED; PG8_LDA(At, 1, 0); PG8_STAGE(PG8_SA(0, 1), a2 + hstep, voffA);
            PG8_WAIT_L(8); PG8_BAR; PG8_WAIT_L(0); PG8_MMA(0, 0, At, B0); PG8_BAR; PG8_SCHED;
            PG8_LDB(B1, 1, 1); PG8_STAGE(PG8_SB(1, 0), b3, voffB);
            PG8_BAR; PG8_WAIT_L(0); PG8_MMA(0, 1, At, B1); PG8_BAR;
            PG8_LDA(At, 1, 1); PG8_STAGE(PG8_SA(1, 0), a3, voffA);
            PG8_BAR; PG8_WAIT_L(0); PG8_MMA(1, 0, At, B0); PG8_BAR; PG8_SCHED;
            PG8_STAGE(PG8_SB(1, 1), b3 + hstep, voffB);
            PG8_WAIT_V(6); PG8_BAR; PG8_MMA(1, 1, At, B1); PG8_BAR;
        }
        PG8_STAMP();
        if constexpr (!Epi::AFTER_DRAIN) { E(acc, cur, wr, wc, fr, fq); S.done(cur); }
        PG8_STAMP();
        if (!has_next) break;
#pragma unroll
        for (int a = 0; a < 2; ++a)
#pragma unroll
            for (int b = 0; b < 2; ++b)
#pragma unroll
                for (int m = 0; m < 4; ++m)
#pragma unroll
                    for (int n = 0; n < 2; ++n) acc[a][b][m][n] = (f32x4){0.f, 0.f, 0.f, 0.f};
        cur = nxt; cA = nA; cB = nB; ++ui;
    }
    PG8_WAIT_V(0);
    if (wr == 0) PG8_BAR;
    PG8_BAR;
    if constexpr (Epi::AFTER_DRAIN) { E.fused(acc, cur, wr, wc, fr, fq, lds, wid, lane); S.done(cur); }
    PG8_STAMP();
    if (STAMP && wid == 0) { stamps[lane] = lane < nts ? (((unsigned long long)(unsigned)ts_hi << 32) | (unsigned)ts_lo) : 0ull;
        if (lane == 62) stamps[62] = rt_entry; if (lane == 63) stamps[63] = (unsigned long long)wall_clock64(); }
#undef PG8_STAMP
#undef PG8_SA
#undef PG8_SB
#undef PG8_STAGE
#undef PG8_LDA
#undef PG8_LDB
#undef PG8_MMA
#undef PG8_WAIT_V
#undef PG8_WAIT_L
#undef PG8_BAR
#undef PG8_SCHED
}
}
using namespace pg8;
#define LAS __attribute__((address_space(3)))
typedef unsigned short u16;
typedef unsigned int u32;
typedef float f32x16 __attribute__((ext_vector_type(16)));
typedef unsigned int u32x2 __attribute__((ext_vector_type(2)));

constexpr int TX = 65536, TCX = 8192, TT = 73728;
constexpr int DFF = 2816, NGU = 5632, NIN = 4864;
constexpr float EPSF = 1e-6f;
constexpr int LDS_BYTES = 160768;
constexpr int NPHASE = 15;

constexpr size_t SZ_WGU = (size_t)NGU * 1024 * 2, SZ_WD = (size_t)1024 * DFF * 2, SZ_WIN = (size_t)NIN * 1024 * 2, SZ_WOUT = (size_t)1024 * 2048 * 2;
constexpr size_t OFF_WGU1 = 0, OFF_WD1 = OFF_WGU1 + SZ_WGU, OFF_WGU2 = OFF_WD1 + SZ_WD, OFF_WD2 = OFF_WGU2 + SZ_WGU, OFF_WIN = OFF_WD2 + SZ_WD, OFF_WOUT = OFF_WIN + SZ_WIN;
constexpr size_t OFF_MOD = OFF_WOUT + SZ_WOUT;
constexpr size_t OFF_XC1 = OFF_MOD + (size_t)33 * 9216 * 4;
constexpr size_t OFF_DT = OFF_XC1 + (size_t)TCX * 1024 * 4;
constexpr size_t SZ_A16 = (size_t)TT * 16 * 4;
constexpr size_t OFF_DTF = OFF_DT + (size_t)TT * 32 * 4, OFF_DTB = OFF_DTF + SZ_A16, OFF_CSF = OFF_DTB + SZ_A16, OFF_CSB = OFF_CSF + SZ_A16;
constexpr size_t OFF_CDEC = OFF_CSB + SZ_A16;
constexpr size_t OFF_BAR = OFF_CDEC + (size_t)32 * 2 * 18 * 16 * 4;
constexpr size_t OFF_BIG = OFF_BAR + 256;
constexpr size_t SZ_H = (size_t)TT * 1024 * 2, SZ_ACT = (size_t)TT * DFF * 2, SZ_ST = (size_t)32 * 2 * 17 * 16 * 8192 * 2;
constexpr size_t OFF_H = OFF_BIG, OFF_ACT = OFF_BIG + SZ_H, OFF_ST = OFF_BIG;
constexpr size_t WS_TOTAL = (size_t)1 << 30;
constexpr size_t OFF_U = WS_TOTAL - (size_t)TX * 1024 * 2, OFF_XBC = OFF_U - (size_t)TT * 1536 * 2, OFF_Y = OFF_XBC - (size_t)TX * 2048 * 2;
static_assert(OFF_BIG % 256 == 0 && OFF_ACT + SZ_ACT <= WS_TOTAL && OFF_Y >= OFF_ST + SZ_ST && OFF_Y >= OFF_H + SZ_H, "workspace map");

struct Params {
    const float *x, *c, *ctx, *c_ctx, *w_mod, *b_mod, *norm_ffn1, *g1, *u1, *d1, *norm_mix, *w_in, *scw, *scb, *dtbf, *dtbb, *alf, *alb, *ssm_d, *ssm_nw, *ccw, *ccb, *lnw, *lnb,
        *w_out, *norm_ffn2, *g2, *u2, *d2, *fnorm;
    float* out; unsigned char* ws; int ph_lo, ph_hi;
};

__device__ __forceinline__ float bf2f(u16 v) { return __uint_as_float(((u32)v) << 16); }
__device__ __forceinline__ u16 f2bf(float f) { u32 u = __float_as_uint(f); u += 0x7FFFu + ((u >> 16) & 1u); return (u16)(u >> 16); }
__device__ __forceinline__ float lo_f(u32 v) { return __uint_as_float(v << 16); }
__device__ __forceinline__ float hi_f(u32 v) { return __uint_as_float(v & 0xffff0000u); }
__device__ __forceinline__ float silu_f(float x) { return x * __builtin_amdgcn_rcpf(1.0f + __expf(-x)); }
__device__ __forceinline__ float sigm_f(float x) { return __builtin_amdgcn_rcpf(1.0f + __expf(-x)); }
#define LDS_BARRIER() do { asm volatile("s_waitcnt lgkmcnt(0)" ::: "memory"); __builtin_amdgcn_s_barrier(); asm volatile("" ::: "memory"); } while (0)
__device__ __forceinline__ float wave_sum(float v) {
#pragma unroll
    for (int o = 32; o >= 1; o >>= 1) v += __shfl_xor(v, o);
    return v;
}

typedef float f32x2v __attribute__((ext_vector_type(2)));
__device__ __forceinline__ f32x2v sigm2(f32x2v x) { f32x2v e = x * (-1.4426950408889634f); e[0] = __builtin_amdgcn_exp2f(e[0]); e[1] = __builtin_amdgcn_exp2f(e[1]); e = e + 1.0f;
    f32x2v r; r[0] = __builtin_amdgcn_rcpf(e[0]); r[1] = __builtin_amdgcn_rcpf(e[1]); return r; }
__device__ __forceinline__ unsigned swiglu_pk(float g0, float g1, float u0, float u1) { const f32x2v g = {g0, g1}, u = {u0, u1}; const f32x2v o = (g * sigm2(g)) * u; return cvt_pk_bf16(o[0], o[1]); }
__device__ __forceinline__ unsigned glu_pk(float a0, float a1, float b0, float b1) { const f32x2v a = {a0, a1}, b = {b0, b1}; const f32x2v o = a * sigm2(b); return cvt_pk_bf16(o[0], o[1]); }
struct InOrder : StaticOrder {
    __device__ bool next(int i, Unit& u) const {
        const long L = (long)i * G + c;
        if (L < nwg) return StaticOrder::next(i, u);
        const int e = (int)(L - nwg); if (e >= 192) return false;
        u.pm = 256 + (e & 31); u.pn = e >> 5; return true;
    }
};

struct EpiSwiGLU {
    static constexpr bool PERM = true, AFTER_DRAIN = false;
    bf16_t* O;
    __device__ __forceinline__ void operator()(const f32x4 (&acc)[2][2][4][2], const Unit& u, int wr, int wc, int fr, int fq) const {
        const int row0 = u.pm * BM + wr * 64 + fr, col0 = u.pn * 128 + wc * 32 + 8 * fq;
#pragma unroll
        for (int ai = 0; ai < 2; ++ai)
#pragma unroll
            for (int m = 0; m < 4; ++m) {
                bf16_t* rowp = O + (size_t)(row0 + ai * HALF + m * 16) * DFF + col0;
                const f32x4 g0 = acc[ai][0][m][0], g1 = acc[ai][0][m][1], u0 = acc[ai][1][m][0], u1 = acc[ai][1][m][1];
                u32x4 w;
                w.x = swiglu_pk(g0[0], g0[1], u0[0], u0[1]); w.y = swiglu_pk(g0[2], g0[3], u0[2], u0[3]);
                w.z = swiglu_pk(g1[0], g1[1], u1[0], u1[1]); w.w = swiglu_pk(g1[2], g1[3], u1[2], u1[3]);
                *(u32x4*)rowp = w;
            }
    }
};

struct EpiResid {
    static constexpr bool PERM = false, AFTER_DRAIN = false;
    const float* baseX; float* outX; const float* baseC; float* outC; const float* mod; float s;
    __device__ __forceinline__ void operator()(const f32x4 (&acc)[2][2][4][2], const Unit& u, int wr, int wc, int fr, int fq) const {
        const int row0 = u.pm * BM + wr * 64 + fr, col0 = u.pn * BM + wc * 32 + 4 * fq;
        const bool isx = u.pm < 256; const int b = isx ? (u.pm >> 3) : 32;
        const float* bp0 = isx ? baseX + (size_t)row0 * 1024 : baseC + (size_t)(row0 - TX) * 1024;
        float* op0 = isx ? outX + (size_t)row0 * 1024 : outC + (size_t)(row0 - TX) * 1024;
        f32x4 mv[2][2];
#pragma unroll
        for (int bj = 0; bj < 2; ++bj)
#pragma unroll
            for (int n = 0; n < 2; ++n) mv[bj][n] = *(const f32x4*)(mod + (size_t)b * 9216 + col0 + bj * HALF + n * 16) * s;
#pragma unroll
        for (int ai = 0; ai < 2; ++ai)
#pragma unroll
            for (int m = 0; m < 4; ++m) {
                const size_t ro = (size_t)(ai * HALF + m * 16) * 1024 + col0;
                f32x4 bv[2][2];
#pragma unroll
                for (int bj = 0; bj < 2; ++bj)
#pragma unroll
                    for (int n = 0; n < 2; ++n) bv[bj][n] = *(const f32x4*)(bp0 + ro + bj * HALF + n * 16);
#pragma unroll
                for (int bj = 0; bj < 2; ++bj)
#pragma unroll
                    for (int n = 0; n < 2; ++n) *(f32x4*)(op0 + ro + bj * HALF + n * 16) = bv[bj][n] + mv[bj][n] * acc[ai][bj][m][n];
            }
    }
};

template <int BT, int OT>
struct EpiResidT {
    static constexpr bool PERM = false, AFTER_DRAIN = false;
    const void* baseX; void* outX; const void* baseC; void* outC; const float* mod; float s;
    __device__ __forceinline__ void operator()(const f32x4 (&acc)[2][2][4][2], const Unit& u, int wr, int wc, int fr, int fq) const {
        const int row0 = u.pm * BM + wr * 64 + fr, col0 = u.pn * BM + wc * 32 + 4 * fq;
        const bool isx = u.pm < 256; const int b = isx ? (u.pm >> 3) : 32;
        const size_t eo = (size_t)(isx ? row0 : row0 - TX) * 1024 + col0;
        const char* bp0 = (const char*)(isx ? baseX : baseC) + eo * (BT ? 2 : 4);
        char* op0 = (char*)(isx ? outX : outC) + eo * (OT ? 2 : 4);
        f32x4 mv[2][2];
#pragma unroll
        for (int bj = 0; bj < 2; ++bj)
#pragma unroll
            for (int n = 0; n < 2; ++n) mv[bj][n] = *(const f32x4*)(mod + (size_t)b * 9216 + col0 + bj * HALF + n * 16) * s;
#pragma unroll
        for (int ai = 0; ai < 2; ++ai)
#pragma unroll
            for (int m = 0; m < 4; ++m) {
                const size_t ro = (size_t)(ai * HALF + m * 16) * 1024;
                f32x4 bv[2][2];
#pragma unroll
                for (int bj = 0; bj < 2; ++bj)
#pragma unroll
                    for (int n = 0; n < 2; ++n) { const size_t e = ro + bj * HALF + n * 16;
                        if (BT) { const u32x2 q = *(const u32x2*)(bp0 + e * 2); bv[bj][n] = (f32x4){lo_f(q.x), hi_f(q.x), lo_f(q.y), hi_f(q.y)}; }
                        else bv[bj][n] = *(const f32x4*)(bp0 + e * 4); }
#pragma unroll
                for (int bj = 0; bj < 2; ++bj)
#pragma unroll
                    for (int n = 0; n < 2; ++n) { const size_t e = ro + bj * HALF + n * 16; const f32x4 x = bv[bj][n] + mv[bj][n] * acc[ai][bj][m][n];
                        if (OT) { u32x2 q; q.x = cvt_pk_bf16(x[0], x[1]); q.y = cvt_pk_bf16(x[2], x[3]); *(u32x2*)(op0 + e * 2) = q; }
                        else *(f32x4*)(op0 + e * 4) = x; }
            }
    }
};

struct EpiInProj {
    static constexpr bool PERM = true, AFTER_DRAIN = false;
    bf16_t* XBC; float* DT; bf16_t* Y; bf16_t* U;
    __device__ __forceinline__ void operator()(const f32x4 (&acc)[2][2][4][2], const Unit& u, int wr, int wc, int fr, int fq) const {
        const int row0 = u.pm * BM + wr * 64 + fr, cin = wc * 32 + 8 * fq, pn = u.pn;
        if (pn == 5) {
            if (wc == 0) {
#pragma unroll
                for (int ai = 0; ai < 2; ++ai)
#pragma unroll
                    for (int m = 0; m < 4; ++m) {
                        float* rp = DT + (size_t)(row0 + ai * HALF + m * 16) * 32 + 8 * fq;
                        *(f32x4*)rp = acc[ai][0][m][0]; *(f32x4*)(rp + 4) = acc[ai][0][m][1];
                    }
            }
        } else if (pn <= 10) {
            bf16_t* base; int ld;
            if (pn <= 4) { base = XBC + pn * 256; ld = 1536; } else if (pn == 6) { base = XBC + 1280; ld = 1536; } else { base = Y + (pn - 7) * 256; ld = 2048; }
#pragma unroll
            for (int ai = 0; ai < 2; ++ai)
#pragma unroll
                for (int m = 0; m < 4; ++m) {
                    bf16_t* rowp = base + (size_t)(row0 + ai * HALF + m * 16) * ld + cin;
#pragma unroll
                    for (int bj = 0; bj < 2; ++bj) {
                        f32x4 v0 = acc[ai][bj][m][0], v1 = acc[ai][bj][m][1];
                        if (pn >= 7) {
#pragma unroll
                            for (int j = 0; j < 4; ++j) { v0[j] = silu_f(v0[j]); v1[j] = silu_f(v1[j]); } }
                        u32x4 w; w.x = cvt_pk_bf16(v0[0], v0[1]); w.y = cvt_pk_bf16(v0[2], v0[3]); w.z = cvt_pk_bf16(v1[0], v1[1]); w.w = cvt_pk_bf16(v1[2], v1[3]);
                        *(u32x4*)(rowp + bj * HALF) = w;
                    }
                }
        } else {
            bf16_t* base = U + (pn - 11) * 128 + cin;
#pragma unroll
            for (int ai = 0; ai < 2; ++ai)
#pragma unroll
                for (int m = 0; m < 4; ++m) {
                    bf16_t* rowp = base + (size_t)(row0 + ai * HALF + m * 16) * 1024;
                    const f32x4 a0 = acc[ai][0][m][0], a1 = acc[ai][0][m][1], b0 = acc[ai][1][m][0], b1 = acc[ai][1][m][1];
                    u32x4 w;
                    w.x = glu_pk(a0[0], a0[1], b0[0], b0[1]); w.y = glu_pk(a0[2], a0[3], b0[2], b0[3]);
                    w.z = glu_pk(a1[0], a1[1], b1[0], b1[1]); w.w = glu_pk(a1[2], a1[3], b1[2], b1[3]);
                    *(u32x4*)rowp = w;
                }
        }
    }
};

__device__ __forceinline__ void prep_mod_item(const Params& P, LAS unsigned char* lds, int it) {
    const int tid = tid_fresh();
    LAS float* cc = (LAS float*)lds;
    for (int i = tid; i < 33 * 1024; i += 512) { const int r = i >> 10, k = i & 1023; const float v = (r < 32) ? P.c[r * 1024 + k] : P.c_ctx[k]; cc[i] = silu_f(v); }
    __syncthreads();
    const int n0 = it * 64, col = tid & 63, kk = tid >> 6;
    float acc[33];
#pragma unroll
    for (int r = 0; r < 33; ++r) acc[r] = 0.f;
    const float* wp = P.w_mod + (size_t)(kk * 128) * 9216 + n0 + col;
    float wv[16], wn[16];
#pragma unroll
    for (int i = 0; i < 16; ++i) wv[i] = wp[(size_t)i * 9216];
#pragma unroll 1
    for (int kc = 0; kc < 8; ++kc) {
        if (kc < 7) {
#pragma unroll
            for (int i = 0; i < 16; ++i) wn[i] = wp[(size_t)((kc + 1) * 16 + i) * 9216]; }
#pragma unroll
        for (int q = 0; q < 4; ++q)
#pragma unroll
            for (int r = 0; r < 33; ++r) { const f32x4 c4 = *(const LAS f32x4*)(cc + r * 1024 + kk * 128 + kc * 16 + q * 4);
                acc[r] += c4[0] * wv[4 * q] + c4[1] * wv[4 * q + 1] + c4[2] * wv[4 * q + 2] + c4[3] * wv[4 * q + 3]; }
#pragma unroll
        for (int i = 0; i < 16; ++i) wv[i] = wn[i];
    }
    __syncthreads();
    LAS float* red = (LAS float*)lds;
#pragma unroll
    for (int r = 0; r < 33; ++r) red[(kk * 33 + r) * 64 + col] = acc[r];
    __syncthreads();
    float* MOD = (float*)(P.ws + OFF_MOD);
    for (int o = tid; o < 33 * 64; o += 512) { const int r = o >> 6, cl = o & 63; float s = 0.f;
#pragma unroll
        for (int q = 0; q < 8; ++q) s += red[(q * 33 + r) * 64 + cl];
        MOD[(size_t)r * 9216 + n0 + cl] = s + P.b_mod[n0 + cl]; }
    __syncthreads();
}

struct TileD { const float* src; u16* dst; int sld, nvalid, dld; };
__device__ __forceinline__ TileD prep_decode(const Params& P, int t) {
    const float* src; int sld, scol0, nvalid = 64, kt, n0, dld; u16* dst;
    if (t < 2816) {
        const int f = t >= 1408; const int tt = t - f * 1408; const int nt = tt >> 4; kt = tt & 15; n0 = nt * 64;
        const int j = n0 >> 8, s0 = n0 & 255;
        src = (s0 < 128) ? (f ? P.g2 : P.g1) : (f ? P.u2 : P.u1); scol0 = 128 * j + (s0 & 127); sld = DFF;
        dst = (u16*)(P.ws + (f ? OFF_WGU2 : OFF_WGU1)); dld = 1024;
    } else if (t < 2816 + 1408) {
        const int t2 = t - 2816; const int f = t2 >= 704; const int tt = t2 - f * 704; const int nt = tt / 44; kt = tt % 44; n0 = nt * 64;
        src = f ? P.d2 : P.d1; scol0 = n0; sld = 1024; dst = (u16*)(P.ws + (f ? OFF_WD2 : OFF_WD1)); dld = DFF;
    } else if (t < 2816 + 1408 + 1216) {
        const int tt = t - 4224; const int nt = tt >> 4; kt = tt & 15; n0 = nt * 64;
        const int pn = n0 >> 8, s0 = n0 & 255;
        if (pn < 4) scol0 = 1024 + n0; else if (pn == 4) scol0 = 2048 + s0; else if (pn == 5) { scol0 = 2560; nvalid = s0 ? 0 : 32; }
        else if (pn == 6) scol0 = 2304 + s0; else if (pn <= 10) scol0 = n0 - 1792;
        else { const int j = pn - 11; scol0 = (s0 < 128) ? (2592 + 128 * j + s0) : (2592 + 1024 + 128 * j + (s0 - 128)); }
        src = P.w_in; sld = 4640; dst = (u16*)(P.ws + OFF_WIN); dld = 1024;
    } else {
        const int tt = t - 5440; const int nt = tt >> 5; kt = tt & 31; n0 = nt * 64;
        src = P.w_out; scol0 = n0; sld = 1024; dst = (u16*)(P.ws + OFF_WOUT); dld = 2048;
    }
    TileD d; d.src = src + (size_t)(kt * 64) * sld + scol0; d.dst = dst + (size_t)n0 * dld + kt * 64; d.sld = sld; d.nvalid = nvalid; d.dld = dld; return d;
}
__device__ __forceinline__ void prep_load(const TileD& d, int tid, float (&v)[8]) {
#pragma unroll
    for (int e = 0; e < 8; ++e) { const int idx = tid + 512 * e, kk = idx >> 6, nn = idx & 63; v[e] = (nn < d.nvalid) ? d.src[(size_t)kk * d.sld + nn] : 0.f; }
}
__device__ __forceinline__ void prep_store(const TileD& d, int tid, const float (&v)[8], LAS unsigned char* lds) {
    LAS float* tile = (LAS float*)lds;
#pragma unroll
    for (int e = 0; e < 8; ++e) { const int idx = tid + 512 * e, kk = idx >> 6, nn = idx & 63; tile[kk * 65 + nn] = v[e]; }
    __syncthreads();
    { const int nn = tid >> 3, ks = (tid & 7) * 8; u32x4 w;
      w.x = cvt_pk_bf16(tile[(ks + 0) * 65 + nn], tile[(ks + 1) * 65 + nn]); w.y = cvt_pk_bf16(tile[(ks + 2) * 65 + nn], tile[(ks + 3) * 65 + nn]);
      w.z = cvt_pk_bf16(tile[(ks + 4) * 65 + nn], tile[(ks + 5) * 65 + nn]); w.w = cvt_pk_bf16(tile[(ks + 6) * 65 + nn], tile[(ks + 7) * 65 + nn]);
      *(u32x4*)(d.dst + (size_t)nn * d.dld + ks) = w; }
    __syncthreads();
}

__device__ __forceinline__ void phase_prep(const Params& P, LAS unsigned char* lds) {
    constexpr int NMOD = 144, NTILE = 2816 + 1408 + 1216 + 512;
    const int tid = tid_fresh();
    int it = blockIdx.x;
    if (it < NMOD) { prep_mod_item(P, lds, it); it += gridDim.x; }
    if (it >= NMOD + NTILE) return;
    TileD d = prep_decode(P, it - NMOD); float v[8]; prep_load(d, tid, v);
    for (;;) {
        const int nx = it + gridDim.x; const bool has = nx < NMOD + NTILE;
        TileD dn = d; float vn[8];
        if (has) { dn = prep_decode(P, nx - NMOD); prep_load(dn, tid, vn); }
        prep_store(d, tid, v, lds);
        if (!has) break;
        d = dn; it = nx;
#pragma unroll
        for (int e = 0; e < 8; ++e) v[e] = vn[e];
    }
}

template <int MODE>
__device__ __forceinline__ void phase_norm(const Params& P, const float* srcX, const float* srcC, int nrows, const float* nw, int shIdx, int scIdx, u16* H, float* outF) {
    constexpr int NR = 4;
    const int lane = tid_fresh() & 63, gw = blockIdx.x * 8 + (tid_fresh() >> 6), nwv = gridDim.x * 8;
    const float* MOD = (const float*)(P.ws + OFF_MOD);
    f32x4 w[4];
#pragma unroll
    for (int i = 0; i < 4; ++i) w[i] = *(const f32x4*)(nw + i * 256 + lane * 4);
    f32x4 v[NR][4], vn[NR][4];
    int row0 = gw * NR;
    if (row0 < nrows) { const float* src0 = (row0 < TX) ? srcX + (size_t)row0 * 1024 : srcC + (size_t)(row0 - TX) * 1024;
#pragma unroll
        for (int q = 0; q < NR; ++q)
#pragma unroll
            for (int i = 0; i < 4; ++i) v[q][i] = *(const f32x4*)(src0 + q * 1024 + i * 256 + lane * 4); }
    for (; row0 < nrows; row0 += nwv * NR) {
        const int rown = row0 + nwv * NR;
        if (rown < nrows) { const float* src1 = (rown < TX) ? srcX + (size_t)rown * 1024 : srcC + (size_t)(rown - TX) * 1024;
#pragma unroll
            for (int q = 0; q < NR; ++q)
#pragma unroll
                for (int i = 0; i < 4; ++i) vn[q][i] = *(const f32x4*)(src1 + q * 1024 + i * 256 + lane * 4); }
        const int b = (row0 < TX) ? (row0 >> 11) : 32;
        float rstd[NR];
#pragma unroll
        for (int q = 0; q < NR; ++q) { float ss = 0.f;
#pragma unroll
            for (int i = 0; i < 4; ++i) ss += v[q][i][0] * v[q][i][0] + v[q][i][1] * v[q][i][1] + v[q][i][2] * v[q][i][2] + v[q][i][3] * v[q][i][3];
            rstd[q] = rsqrtf(wave_sum(ss) * (1.0f / 1024.0f) + EPSF); }
#pragma unroll
        for (int i = 0; i < 4; ++i) { const int col = i * 256 + lane * 4;
            if (MODE == 0) {
                const f32x4 sh = *(const f32x4*)(MOD + (size_t)b * 9216 + shIdx * 1024 + col), sc = *(const f32x4*)(MOD + (size_t)b * 9216 + scIdx * 1024 + col);
                const f32x4 ws = w[i] * (sc + 1.0f);
#pragma unroll
                for (int q = 0; q < NR; ++q) { const f32x4 o = v[q][i] * rstd[q] * ws + sh;
                    uint2 pk; pk.x = cvt_pk_bf16(o[0], o[1]); pk.y = cvt_pk_bf16(o[2], o[3]);
                    *(uint2*)(H + (size_t)(row0 + q) * 1024 + col) = pk; }
            } else {
#pragma unroll
                for (int q = 0; q < NR; ++q) *(f32x4*)(outF + (size_t)(row0 + q) * 1024 + col) = v[q][i] * rstd[q] * w[i];
            } }
#pragma unroll
        for (int q = 0; q < NR; ++q)
#pragma unroll
            for (int i = 0; i < 4; ++i) v[q][i] = vn[q][i];
    }
}

template <int MODE>
__device__ __forceinline__ void phase_norm_b(const Params& P, const u16* srcX, const u16* srcC, int nrows, const float* nw, int shIdx, int scIdx, u16* H, float* outF) {
    constexpr int NR = 4;
    const int lane = tid_fresh() & 63, gw = blockIdx.x * 8 + (tid_fresh() >> 6), nwv = gridDim.x * 8;
    const float* MOD = (const float*)(P.ws + OFF_MOD);
    f32x4 w[4];
#pragma unroll
    for (int i = 0; i < 4; ++i) w[i] = *(const f32x4*)(nw + (i >> 1) * 512 + lane * 8 + (i & 1) * 4);
    for (int row0 = gw * NR; row0 < nrows; row0 += nwv * NR) {
        const u16* src0 = (row0 < TX) ? srcX + (size_t)row0 * 1024 : srcC + (size_t)(row0 - TX) * 1024;
        u32x4 raw[NR][2];
#pragma unroll
        for (int q = 0; q < NR; ++q) { raw[q][0] = *(const u32x4*)(src0 + q * 1024 + lane * 8); raw[q][1] = *(const u32x4*)(src0 + q * 1024 + 512 + lane * 8); }
        const int b = (row0 < TX) ? (row0 >> 11) : 32;
        f32x4 sh[4], ws[4];
#pragma unroll
        for (int i = 0; i < 4; ++i) { const int col = (i >> 1) * 512 + lane * 8 + (i & 1) * 4;
            if (MODE == 0) { sh[i] = *(const f32x4*)(MOD + (size_t)b * 9216 + shIdx * 1024 + col); ws[i] = w[i] * (*(const f32x4*)(MOD + (size_t)b * 9216 + scIdx * 1024 + col) + 1.0f); }
            else { sh[i] = (f32x4){0.f, 0.f, 0.f, 0.f}; ws[i] = w[i]; } }
#pragma unroll
        for (int q = 0; q < NR; ++q) {
            f32x4 v[4];
            v[0] = (f32x4){lo_f(raw[q][0].x), hi_f(raw[q][0].x), lo_f(raw[q][0].y), hi_f(raw[q][0].y)}; v[1] = (f32x4){lo_f(raw[q][0].z), hi_f(raw[q][0].z), lo_f(raw[q][0].w), hi_f(raw[q][0].w)};
            v[2] = (f32x4){lo_f(raw[q][1].x), hi_f(raw[q][1].x), lo_f(raw[q][1].y), hi_f(raw[q][1].y)}; v[3] = (f32x4){lo_f(raw[q][1].z), hi_f(raw[q][1].z), lo_f(raw[q][1].w), hi_f(raw[q][1].w)};
            float ss = 0.f;
#pragma unroll
            for (int i = 0; i < 4; ++i) ss += v[i][0] * v[i][0] + v[i][1] * v[i][1] + v[i][2] * v[i][2] + v[i][3] * v[i][3];
            const float rstd = rsqrtf(wave_sum(ss) * (1.0f / 1024.0f) + EPSF);
            if (MODE == 1) {
                float* op = outF + (size_t)(row0 + q) * 1024 + lane * 8;
                *(f32x4*)op = v[0] * rstd * ws[0]; *(f32x4*)(op + 4) = v[1] * rstd * ws[1]; *(f32x4*)(op + 512) = v[2] * rstd * ws[2]; *(f32x4*)(op + 516) = v[3] * rstd * ws[3];
                continue; }
            u32x4 o0, o1; f32x4 t;
            t = v[0] * rstd * ws[0] + sh[0]; o0.x = cvt_pk_bf16(t[0], t[1]); o0.y = cvt_pk_bf16(t[2], t[3]);
            t = v[1] * rstd * ws[1] + sh[1]; o0.z = cvt_pk_bf16(t[0], t[1]); o0.w = cvt_pk_bf16(t[2], t[3]);
            t = v[2] * rstd * ws[2] + sh[2]; o1.x = cvt_pk_bf16(t[0], t[1]); o1.y = cvt_pk_bf16(t[2], t[3]);
            t = v[3] * rstd * ws[3] + sh[3]; o1.z = cvt_pk_bf16(t[0], t[1]); o1.w = cvt_pk_bf16(t[2], t[3]);
            *(u32x4*)(H + (size_t)(row0 + q) * 1024 + lane * 8) = o0; *(u32x4*)(H + (size_t)(row0 + q) * 1024 + 512 + lane * 8) = o1;
        }
    }
}

typedef float f32x2 __attribute__((ext_vector_type(2)));
template <int NC> struct ConvLd { u32 v[128 / (512 / (NC / 2)) + 4]; };
template <int NC>
__device__ __forceinline__ void stage_conv_load(ConvLd<NC>& L, const u16* XBC, int row0, int col0) {
    constexpr int NP = NC / 2, NTG = 512 / NP, TPG = 128 / NTG;
    const int tid = tid_fresh(), cp = tid % NP, tg = tid / NP, ch = col0 + 2 * cp, l0 = tg * TPG;
    const u16* p = XBC + (ptrdiff_t)(row0 + l0 - 2) * 1536 + ch;
#pragma unroll
    for (int i = 0; i < TPG + 4; ++i) L.v[i] = *(const u32*)(p + (size_t)i * 1536);
}
template <int NC, bool TR>
__device__ __forceinline__ void stage_conv_compute(const ConvLd<NC>& L, LAS u16* dst, int ld, int row0, int seq0, int seq1, int col0, const float* cw, const float* cb) {
    constexpr int NP = NC / 2, NTG = 512 / NP, TPG = 128 / NTG;
    const int tid = tid_fresh(), cp = tid % NP, tg = tid / NP, ch = col0 + 2 * cp, l0 = tg * TPG;
    f32x2 w[5];
#pragma unroll
    for (int k = 0; k < 5; ++k) w[k] = *(const f32x2*)(cw + k * 1536 + ch);
    const f32x2 bias = *(const f32x2*)(cb + ch);
    const int rlo = row0 + l0 - 2;
    const bool z0 = rlo < seq0, z1 = rlo + 1 < seq0, z2 = rlo + TPG + 2 >= seq1, z3 = rlo + TPG + 3 >= seq1;
#pragma unroll
    for (int q = 0; q < TPG / 8; ++q) {
        f32x2 in[12];
#pragma unroll
        for (int i = 0; i < 12; ++i) { const int gi = 8 * q + i; u32 v = L.v[gi];
            if (gi == 0) v = z0 ? 0u : v; if (gi == 1) v = z1 ? 0u : v; if (gi == TPG + 2) v = z2 ? 0u : v; if (gi == TPG + 3) v = z3 ? 0u : v;
            in[i][0] = lo_f(v); in[i][1] = hi_f(v); }
        float o0[8], o1[8];
        f32x2 acc8[8];
#pragma unroll
        for (int t = 0; t < 8; ++t) acc8[t] = bias;
#pragma unroll
        for (int k = 0; k < 5; ++k)
#pragma unroll
            for (int t = 0; t < 8; ++t) acc8[t] = in[t + k] * w[k] + acc8[t];
        f32x2 e8[8];
#pragma unroll
        for (int t = 0; t < 8; ++t) { e8[t] = acc8[t] * (-1.4426950408889634f); }
#pragma unroll
        for (int t = 0; t < 8; ++t) { e8[t][0] = __builtin_amdgcn_exp2f(e8[t][0]); e8[t][1] = __builtin_amdgcn_exp2f(e8[t][1]); }
#pragma unroll
        for (int t = 0; t < 8; ++t) { e8[t] = e8[t] + 1.0f; }
#pragma unroll
        for (int t = 0; t < 8; ++t) { e8[t][0] = __builtin_amdgcn_rcpf(e8[t][0]); e8[t][1] = __builtin_amdgcn_rcpf(e8[t][1]); }
#pragma unroll
        for (int t = 0; t < 8; ++t) { const f32x2 o = acc8[t] * e8[t]; o0[t] = o[0]; o1[t] = o[1];
            if (!TR) *(LAS u32*)(dst + (l0 + 8 * q + t) * ld + 2 * cp) = cvt_pk_bf16(o[0], o[1]); }
        if (TR) {
            u32x4 a, b;
            a.x = cvt_pk_bf16(o0[0], o0[1]); a.y = cvt_pk_bf16(o0[2], o0[3]); a.z = cvt_pk_bf16(o0[4], o0[5]); a.w = cvt_pk_bf16(o0[6], o0[7]);
            b.x = cvt_pk_bf16(o1[0], o1[1]); b.y = cvt_pk_bf16(o1[2], o1[3]); b.z = cvt_pk_bf16(o1[4], o1[5]); b.w = cvt_pk_bf16(o1[6], o1[7]);
            *(LAS u32x4*)(dst + (2 * cp) * ld + l0 + 8 * q) = a; *(LAS u32x4*)(dst + (2 * cp + 1) * ld + l0 + 8 * q) = b;
        }
    }
}
template <int NC, bool TR>
__device__ __forceinline__ void stage_conv_impl(LAS u16* dst, int ld, const u16* XBC, int row0, int seq0, int seq1, int col0, const float* cw, const float* cb) {
    ConvLd<NC> L; stage_conv_load<NC>(L, XBC, row0, col0); stage_conv_compute<NC, TR>(L, dst, ld, row0, seq0, seq1, col0, cw, cb);
}
template <int NC> __device__ __forceinline__ void stage_conv(LAS u16* dst, int ld, const u16* XBC, int row0, int seq0, int seq1, int col0, const float* cw, const float* cb) {
    stage_conv_impl<NC, false>(dst, ld, XBC, row0, seq0, seq1, col0, cw, cb); }
template <int NC> __device__ __forceinline__ void stage_conv_t(LAS u16* dst, int ld, const u16* XBC, int row0, int seq0, int seq1, int col0, const float* cw, const float* cb) {
    stage_conv_impl<NC, true>(dst, ld, XBC, row0, seq0, seq1, col0, cw, cb); }

__device__ __forceinline__ void dtprep_item(const Params& P, LAS unsigned char* lds, int tc) {
    const int tid = tid_fresh(), dh = tid & 31, seg = tid >> 5, dir = dh >> 4, h = dh & 15;
    const bool isx = tc < 512; const int b = isx ? (tc >> 4) : ((tc - 512) >> 1); const int cidx = isx ? (tc & 15) : ((tc - 512) & 1);
    const int row0 = tc * 128;
    const int jscan = isx ? (dir ? 17 - cidx : cidx + 2) : (dir ? 1 - cidx : cidx);
    const float bias = dir ? P.dtbb[h] : P.dtbf[h]; const float a = -__expf(dir ? P.alb[h] : P.alf[h]);
    const float* DT = (const float*)(P.ws + OFF_DT);
    float dt[8], cs[8];
#pragma unroll
    for (int i = 0; i < 8; ++i) { const float raw = DT[(size_t)(row0 + seg * 8 + i) * 32 + dh] + bias; dt[i] = (raw > 20.f) ? raw : log1pf(__expf(raw)); }
    float run = 0.f;
    if (dir == 0) {
#pragma unroll
        for (int i = 0; i < 8; ++i) { run += dt[i] * a; cs[i] = run; }
    } else {
#pragma unroll
        for (int i = 7; i >= 0; --i) { run += dt[i] * a; cs[i] = run; }
    }
    LAS float* segsum = (LAS float*)lds;
    segsum[seg * 32 + dh] = run;
    __syncthreads();
    float off = 0.f, tot = 0.f;
#pragma unroll
    for (int s2 = 0; s2 < 16; ++s2) { const float v = segsum[s2 * 32 + dh]; tot += v; if (dir == 0 ? (s2 < seg) : (s2 > seg)) off += v; }
    float* DTO = (float*)(P.ws + (dir ? OFF_DTB : OFF_DTF)); float* CSO = (float*)(P.ws + (dir ? OFF_CSB : OFF_CSF));
#pragma unroll
    for (int i = 0; i < 8; ++i) { const size_t o = (size_t)(row0 + seg * 8 + i) * 16 + h; DTO[o] = dt[i]; CSO[o] = cs[i] + off; }
    if (seg == 0) ((float*)(P.ws + OFF_CDEC))[((b * 2 + dir) * 18 + jscan) * 16 + h] = __expf(tot);
    __syncthreads();
}

__device__ __forceinline__ void uconv_load(const Params& P, int item, u32x4 (&raw)[4]) {
    const int tid = tid_fresh(); const bool isH = item < 2048; const int e = item & 2047, b = e >> 6, q = (e >> 1) & 31, chalf = e & 1;
    const u16* Ug = (const u16*)(P.ws + OFF_U); const int choff = (isH ? 0 : 512) + 256 * chalf;
#pragma unroll
    for (int i = 0; i < 4; ++i) { const int idx = tid + 512 * i, tok = idx >> 5, c8 = idx & 31; int grow;
        if (isH) grow = b * 2048 + q * 64 + tok; else grow = b * 2048 + (tok & 31) * 64 + 2 * q + (tok >> 5);
        raw[i] = *(const u32x4*)(Ug + (size_t)grow * 1024 + choff + c8 * 8); }
}
__device__ __forceinline__ void uconv_item(const Params& P, LAS unsigned char* lds, int item, const u32x4 (&raw)[4], int nx, u32x4 (&rawn)[4]) {
    const int tid = tid_fresh(); const bool isH = item < 2048; const int e = item & 2047, b = e >> 6, q = (e >> 1) & 31, chalf = e & 1;
    LAS float* in = (LAS float*)lds;
    u16* Yg = (u16*)(P.ws + OFF_Y);
    const int choff = (isH ? 0 : 512) + 256 * chalf;
    const int cp = tid & 127, tq = tid >> 7, ch = choff + 2 * cp;
    f32x2 w[31];
#pragma unroll
    for (int k = 0; k < 31; ++k) w[k] = *(const f32x2*)(P.ccw + k * 1024 + ch);
    const f32x2 bias = *(const f32x2*)(P.ccb + ch);
    if (nx < 4096) uconv_load(P, nx, rawn);
#pragma unroll
    for (int i = 0; i < 4; ++i) { const int idx = tid + 512 * i, tok = idx >> 5, c8 = idx & 31; const int lrow = isH ? (15 + tok) : ((tok >> 5) * 62 + 15 + (tok & 31));
        const u32x4 v = raw[i];
        *(LAS f32x4*)(in + lrow * 256 + c8 * 8) = (f32x4){lo_f(v.x), hi_f(v.x), lo_f(v.y), hi_f(v.y)};
        *(LAS f32x4*)(in + lrow * 256 + c8 * 8 + 4) = (f32x4){lo_f(v.z), hi_f(v.z), lo_f(v.w), hi_f(v.w)}; }
    { const int npad = isH ? 30 : 60;
      for (int idx = tid; idx < npad * 64; idx += 512) { const int pr = idx >> 6, c4 = idx & 63; int lrow;
          if (isH) lrow = (pr < 15) ? pr : 64 + pr; else { const int line = pr / 30, k = pr % 30; lrow = line * 62 + ((k < 15) ? k : 32 + k); }
          *(LAS f32x4*)(in + lrow * 256 + c4 * 4) = (f32x4){0.f, 0.f, 0.f, 0.f}; } }
    LDS_BARRIER();
    const int base_row = isH ? 16 * tq : (62 * (tq >> 1) + 16 * (tq & 1));
    f32x2 win[46];
#pragma unroll
    for (int i = 0; i < 46; ++i) win[i] = *(const LAS f32x2*)(in + (base_row + i) * 256 + 2 * cp);
    const int g0 = isH ? (b * 2048 + q * 64 + 16 * tq) : (b * 2048 + (16 * (tq & 1)) * 64 + 2 * q + (tq >> 1));
    const int gstep = isH ? 1 : 64;
#pragma unroll
    for (int og = 0; og < 16; og += 8) {
        f32x2 a[8];
#pragma unroll
        for (int j = 0; j < 8; ++j) a[j] = bias;
#pragma unroll
        for (int k = 0; k < 31; ++k)
#pragma unroll
            for (int j = 0; j < 8; ++j) a[j] = win[og + j + k] * w[k] + a[j];
#pragma unroll
        for (int j = 0; j < 8; ++j) *(u32*)(Yg + (size_t)(g0 + (og + j) * gstep) * 2048 + 1024 + ch) = cvt_pk_bf16(a[j][0], a[j][1]);
    }
    LDS_BARRIER();
}

__device__ __forceinline__ void phase_p6(const Params& P, LAS unsigned char* lds) {
    for (int it = blockIdx.x; it < 576; it += gridDim.x) dtprep_item(P, lds, it);
}

__device__ __forceinline__ bf16x8 gather8(const LAS u16* p, int stride) {
    bf16x8 r;
#pragma unroll
    for (int j = 0; j < 8; ++j) r[j] = (short)p[j * stride];
    return r;
}
#define MFMA32(a, b, c) __builtin_amdgcn_mfma_f32_32x32x16_bf16((a), (b), (c), 0, 0, 0)

__device__ __forceinline__ void s1_item(const Params& P, LAS unsigned char* lds, int item) {
    const int tid = tid_fresh(), w = tid >> 6, lane = tid & 63, r = lane & 31, hf = lane >> 5;
    const int g = item & 1, tc = (item >> 1) % 18, b = item / 36;
    const bool isx = tc < 16;
    const int seq0 = isx ? b * 2048 : TX + b * 256, seq1 = seq0 + (isx ? 2048 : 256), row0 = seq0 + 128 * (isx ? tc : tc - 16);
    const int jf = isx ? tc + 2 : tc - 16, jb = 17 - tc;
    LAS u16* BT = (LAS u16*)lds;
    LAS u16* XT = (LAS u16*)(lds + 34816);
    LAS float* wfb = (LAS float*)(lds + 34816 + 69632);
    const u16* XBC = (const u16*)(P.ws + OFF_XBC);
    const float *CSF = (const float*)(P.ws + OFF_CSF), *CSB = (const float*)(P.ws + OFF_CSB), *DTF = (const float*)(P.ws + OFF_DTF), *DTB = (const float*)(P.ws + OFF_DTB);
    u16* ST = (u16*)(P.ws + OFF_ST);
    LAS float* dtl = (LAS float*)(lds + 108544);
    LAS float* csl = dtl + 2048;
    LAS float* segs = csl + 2048;
    {
        const int dh = tid & 15, seg = tid >> 4, dir = dh >> 3, hx = 8 * g + (dh & 7);
        const float bias = dir ? P.dtbb[hx] : P.dtbf[hx]; const float a = -__expf(dir ? P.alb[hx] : P.alf[hx]);
        const float* DT = (const float*)(P.ws + OFF_DT);
        float dt[4], cs[4];
#pragma unroll
        for (int i = 0; i < 4; ++i) { const float raw = DT[(size_t)(row0 + seg * 4 + i) * 32 + dir * 16 + hx] + bias; dt[i] = (raw > 20.f) ? raw : log1pf(__expf(raw)); }
        float run = 0.f;
        if (dir == 0) {
#pragma unroll
            for (int i = 0; i < 4; ++i) { run += dt[i] * a; cs[i] = run; }
        } else {
#pragma unroll
            for (int i = 3; i >= 0; --i) { run += dt[i] * a; cs[i] = run; }
        }
        segs[seg * 16 + dh] = run;
        LDS_BARRIER();
        float off = 0.f, tot = 0.f;
#pragma unroll
        for (int s2 = 0; s2 < 32; ++s2) { const float v = segs[s2 * 16 + dh]; tot += v; if (dir == 0 ? (s2 < seg) : (s2 > seg)) off += v; }
        float* DTO = (float*)(P.ws + (dir ? OFF_DTB : OFF_DTF)); float* CSO = (float*)(P.ws + (dir ? OFF_CSB : OFF_CSF));
#pragma unroll
        for (int i = 0; i < 4; ++i) { const int l = seg * 4 + i; const size_t o = (size_t)(row0 + l) * 16 + hx; const float c = cs[i] + off;
            DTO[o] = dt[i]; CSO[o] = c; dtl[dh * 128 + l] = dt[i]; csl[dh * 128 + l] = c; }
        if (seg == 0) ((float*)(P.ws + OFF_CDEC))[((b * 2 + dir) * 18 + (dir ? jb : jf)) * 16 + hx] = __expf(tot);
    }
    ConvLd<256> LX;
    { ConvLd<128> LBt; stage_conv_load<128>(LBt, XBC, row0, 1024 + 128 * g); stage_conv_load<256>(LX, XBC, row0, 64 * (8 * g));
      stage_conv_compute<128, true>(LBt, BT, 136, row0, seq0, seq1, 1024 + 128 * g, P.scw, P.scb); }
    LDS_BARRIER();
    const int hq = w >> 1, pb = w & 1;
#pragma unroll
    for (int pass = 0; pass < 2; ++pass) {
        const int h0 = 8 * g + 4 * pass, h = h0 + hq;
        stage_conv_compute<256, true>(LX, XT, 136, row0, seq0, seq1, 64 * h0, P.scw, P.scb);
#pragma unroll
        for (int e = 0; e < 2; ++e) { const int idx = tid + 512 * e, hh = idx >> 8, dir = (idx >> 7) & 1, l = idx & 127, dq = dir * 8 + 4 * pass + hh;
            wfb[(hh * 2 + dir) * 128 + l] = __expf(csl[dq * 128 + (dir ? 0 : 127)] - csl[dq * 128 + l]) * dtl[dq * 128 + l]; }
        __syncthreads();
        f32x16 acc[2][4];
#pragma unroll
        for (int d = 0; d < 2; ++d)
#pragma unroll
            for (int nb = 0; nb < 4; ++nb)
#pragma unroll
                for (int i = 0; i < 16; ++i) acc[d][nb][i] = 0.f;
#pragma unroll 2
        for (int ks = 0; ks < 8; ++ks) {
            const int lb = 16 * ks + 8 * hf;
            const bf16x8 xr = *(const LAS bf16x8*)(XT + (hq * 64 + 32 * pb + r) * 136 + lb);
            const f32x4 wf0 = *(const LAS f32x4*)(wfb + (hq * 2 + 0) * 128 + lb), wf1 = *(const LAS f32x4*)(wfb + (hq * 2 + 0) * 128 + lb + 4);
            const f32x4 wb0 = *(const LAS f32x4*)(wfb + (hq * 2 + 1) * 128 + lb), wb1 = *(const LAS f32x4*)(wfb + (hq * 2 + 1) * 128 + lb + 4);
            float xv[8];
#pragma unroll
            for (int j = 0; j < 8; ++j) xv[j] = bf2f((u16)xr[j]);
            u32x4 qf, qb;
            qf.x = cvt_pk_bf16(xv[0] * wf0[0], xv[1] * wf0[1]); qf.y = cvt_pk_bf16(xv[2] * wf0[2], xv[3] * wf0[3]); qf.z = cvt_pk_bf16(xv[4] * wf1[0], xv[5] * wf1[1]); qf.w = cvt_pk_bf16(xv[6] * wf1[2], xv[7] * wf1[3]);
            qb.x = cvt_pk_bf16(xv[0] * wb0[0], xv[1] * wb0[1]); qb.y = cvt_pk_bf16(xv[2] * wb0[2], xv[3] * wb0[3]); qb.z = cvt_pk_bf16(xv[4] * wb1[0], xv[5] * wb1[1]); qb.w = cvt_pk_bf16(xv[6] * wb1[2], xv[7] * wb1[3]);
            const bf16x8 xf = __builtin_bit_cast(bf16x8, qf), xb = __builtin_bit_cast(bf16x8, qb);
#pragma unroll
            for (int nb = 0; nb < 4; ++nb) { const bf16x8 bfr = *(const LAS bf16x8*)(BT + (32 * nb + r) * 136 + lb);
                acc[0][nb] = MFMA32(bfr, xf, acc[0][nb]); acc[1][nb] = MFMA32(bfr, xb, acc[1][nb]); }
        }
        if (pass == 0) stage_conv_load<256>(LX, XBC, row0, 64 * (8 * g + 4));
#pragma unroll
        for (int d = 0; d < 2; ++d) { const int j = d ? jb : jf;
            if (j <= 16) { u16* sp = ST + ((size_t)((b * 2 + d) * 17 + j) * 16 + h) * 8192 + ((pb * 4) * 64 + lane) * 16;
#pragma unroll
                for (int nb = 0; nb < 4; ++nb) { u32x4 q0, q1;
                    q0.x = cvt_pk_bf16(acc[d][nb][0], acc[d][nb][1]); q0.y = cvt_pk_bf16(acc[d][nb][2], acc[d][nb][3]); q0.z = cvt_pk_bf16(acc[d][nb][4], acc[d][nb][5]); q0.w = cvt_pk_bf16(acc[d][nb][6], acc[d][nb][7]);
                    q1.x = cvt_pk_bf16(acc[d][nb][8], acc[d][nb][9]); q1.y = cvt_pk_bf16(acc[d][nb][10], acc[d][nb][11]); q1.z = cvt_pk_bf16(acc[d][nb][12], acc[d][nb][13]); q1.w = cvt_pk_bf16(acc[d][nb][14], acc[d][nb][15]);
                    *(u32x4*)(sp + nb * 1024) = q0; *(u32x4*)(sp + nb * 1024 + 8) = q1; } } }
        LDS_BARRIER();
    }
}

__device__ __forceinline__ void phase_s2(const Params& P) {
    u16* ST = (u16*)(P.ws + OFF_ST); const float* CDEC = (const float*)(P.ws + OFF_CDEC);
    const int nth = gridDim.x * 512;
    for (int v = blockIdx.x * 512 + tid_fresh(); v < 32 * 2 * 16 * 1024; v += nth) {
        const int pn = (v & 1023) * 8, h = (v >> 10) & 15, bd = v >> 14;
        float hs[8];
#pragma unroll
        for (int j = 0; j < 8; ++j) hs[j] = 0.f;
        u16* base = ST + ((size_t)(bd * 17) * 16 + h) * 8192 + pn;
        u32x4 q[17]; float dec[17];
#pragma unroll
        for (int s = 0; s < 17; ++s) { q[s] = *(const u32x4*)(base + (size_t)s * 16 * 8192); dec[s] = CDEC[(bd * 18 + s) * 16 + h]; }
#pragma unroll
        for (int s = 0; s < 17; ++s) {
            const float d = dec[s];
            hs[0] = hs[0] * d + lo_f(q[s].x); hs[1] = hs[1] * d + hi_f(q[s].x); hs[2] = hs[2] * d + lo_f(q[s].y); hs[3] = hs[3] * d + hi_f(q[s].y);
            hs[4] = hs[4] * d + lo_f(q[s].z); hs[5] = hs[5] * d + hi_f(q[s].z); hs[6] = hs[6] * d + lo_f(q[s].w); hs[7] = hs[7] * d + hi_f(q[s].w);
            u32x4 o; o.x = cvt_pk_bf16(hs[0], hs[1]); o.y = cvt_pk_bf16(hs[2], hs[3]); o.z = cvt_pk_bf16(hs[4], hs[5]); o.w = cvt_pk_bf16(hs[6], hs[7]);
            *(u32x4*)(base + (size_t)s * 16 * 8192) = o;
        }
    }
}

__device__ __forceinline__ void s3_item(const Params& P, LAS unsigned char* lds, int item) {
    const int tid = tid_fresh(), w = tid >> 6, lane = tid & 63, r = lane & 31, hf = lane >> 5;
    const int g = item & 1, c = (item >> 1) & 15, b = item >> 5;
    const int seq0 = b * 2048, seq1 = seq0 + 2048, row0 = seq0 + 128 * c;
    LAS u16* Cs = (LAS u16*)lds;
    LAS u16* Gs = (LAS u16*)(lds + 34816);
    LAS u16* XT = (LAS u16*)(lds + 69632);
    LAS u16* Bs = XT;
    LAS float* ar = (LAS float*)(lds + 139264);
    LAS float* ssq = (LAS float*)(lds + 147456);
    const u16* XBC = (const u16*)(P.ws + OFF_XBC); const u16* ST = (const u16*)(P.ws + OFF_ST); u16* Yg = (u16*)(P.ws + OFF_Y);
    const float *CSF = (const float*)(P.ws + OFF_CSF), *CSB = (const float*)(P.ws + OFF_CSB), *DTF = (const float*)(P.ws + OFF_DTF), *DTB = (const float*)(P.ws + OFF_DTB);
    ConvLd<256> LX;
    { ConvLd<128> LC, LB; stage_conv_load<128>(LC, XBC, row0, 1280 + 128 * g); stage_conv_load<128>(LB, XBC, row0, 1024 + 128 * g);
      stage_conv_compute<128, false>(LC, Cs, 136, row0, seq0, seq1, 1280 + 128 * g, P.scw, P.scb);
      stage_conv_compute<128, false>(LB, Bs, 136, row0, seq0, seq1, 1024 + 128 * g, P.scw, P.scb); }
    if (tid < 128) ssq[tid] = 0.f;
    LDS_BARRIER();
    {
        const int wr2 = w >> 1, wc2 = w & 1;
        f32x16 g0, g1;
#pragma unroll
        for (int i = 0; i < 16; ++i) { g0[i] = 0.f; g1[i] = 0.f; }
#pragma unroll 2
        for (int ks = 0; ks < 8; ++ks) {
            const bf16x8 a = *(const LAS bf16x8*)(Cs + (32 * wr2 + r) * 136 + 16 * ks + 8 * hf);
            const bf16x8 b0 = *(const LAS bf16x8*)(Bs + (64 * wc2 + r) * 136 + 16 * ks + 8 * hf);
            const bf16x8 b1 = *(const LAS bf16x8*)(Bs + (64 * wc2 + 32 + r) * 136 + 16 * ks + 8 * hf);
            g0 = MFMA32(a, b0, g0); g1 = MFMA32(a, b1, g1);
        }
#pragma unroll
        for (int i = 0; i < 16; ++i) { const int l = 32 * wr2 + (i & 3) + 8 * (i >> 2) + 4 * hf;
            Gs[l * 136 + 64 * wc2 + r] = f2bf(g0[i]); Gs[l * 136 + 64 * wc2 + 32 + r] = f2bf(g1[i]); }
    }
    LDS_BARRIER();
    const int hq = __builtin_amdgcn_readfirstlane(w >> 1), rbh = __builtin_amdgcn_readfirstlane(w & 1);
#pragma unroll
    for (int pass = 0; pass < 2; ++pass) {
        const int h0 = 8 * g + 4 * pass, h = h0 + hq;
        if (pass == 0) stage_conv_load<256>(LX, XBC, row0, 64 * h0);
        float av[4];
#pragma unroll
        for (int e = 0; e < 4; ++e) { const int idx = tid + 512 * e, hh = idx >> 9, which = (idx >> 7) & 3, l = idx & 127;
            const float* srcp = (which == 0) ? CSF : (which == 1) ? CSB : (which == 2) ? DTF : DTB; av[e] = srcp[(size_t)(row0 + l) * 16 + h0 + hh]; }
        const u16* stf = ST + ((size_t)((b * 2 + 0) * 17 + (c + 1)) * 16 + h) * 8192 + lane * 16;
        const u16* stb = ST + ((size_t)((b * 2 + 1) * 17 + (16 - c)) * 16 + h) * 8192 + lane * 16;
        u32x4 hfr[2][2][2][2];
#pragma unroll
        for (int cb = 0; cb < 2; ++cb)
#pragma unroll
            for (int nl = 0; nl < 2; ++nl)
#pragma unroll
                for (int sx = 0; sx < 2; ++sx) { const int off = ((cb * 4 + nl) * 64) * 16 + 8 * sx; hfr[0][cb][nl][sx] = *(const u32x4*)(stf + off); hfr[1][cb][nl][sx] = *(const u32x4*)(stb + off); }
        stage_conv_compute<256, true>(LX, XT, 136, row0, seq0, seq1, 64 * h0, P.scw, P.scb);
#pragma unroll
        for (int e = 0; e < 4; ++e) { const int idx = tid + 512 * e, which = (idx >> 7) & 3; ar[idx] = av[e] * ((which < 2) ? 1.4426950408889634f : 1.0f); }
        LDS_BARRIER();
        LAS float* A = ar + hq * 512;
        f32x16 acc[2][2];
#pragma unroll
        for (int a = 0; a < 2; ++a)
#pragma unroll
            for (int cb = 0; cb < 2; ++cb)
#pragma unroll
                for (int i = 0; i < 16; ++i) acc[a][cb][i] = 0.f;
        const int l0 = 64 * rbh + r, l1 = l0 + 32;
        const float csf0 = A[l0], csb0 = A[128 + l0], dg0 = A[256 + l0] + A[384 + l0], csf1 = A[l1], csb1 = A[128 + l1], dg1 = A[256 + l1] + A[384 + l1];
        const float ef0 = __builtin_amdgcn_exp2f(csf0), eb0 = __builtin_amdgcn_exp2f(csb0), ef1 = __builtin_amdgcn_exp2f(csf1), eb1 = __builtin_amdgcn_exp2f(csb1), dsk = P.ssm_d[h];
#define S3_OFF(NBH) do { _Pragma("unroll") for (int nl = 0; nl < 2; ++nl) _Pragma("unroll") for (int sx = 0; sx < 2; ++sx) { const int no = 32 * (2 * (NBH) + nl) + 16 * sx + 4 * hf; \
            _Pragma("unroll") for (int rb2 = 0; rb2 < 2; ++rb2) { const int l = rb2 ? l1 : l0; const float ef = rb2 ? ef1 : ef0, eb = rb2 ? eb1 : eb0; \
                const u32x2 clo = *(const LAS u32x2*)(Cs + l * 136 + no), chi = *(const LAS u32x2*)(Cs + l * 136 + no + 8); \
                const float c0 = lo_f(clo.x), c1 = hi_f(clo.x), c2 = lo_f(clo.y), c3 = hi_f(clo.y), c4 = lo_f(chi.x), c5 = hi_f(chi.x), c6 = lo_f(chi.y), c7 = hi_f(chi.y); \
                u32x4 qf, qb; qf.x = cvt_pk_bf16(c0 * ef, c1 * ef); qf.y = cvt_pk_bf16(c2 * ef, c3 * ef); qf.z = cvt_pk_bf16(c4 * ef, c5 * ef); qf.w = cvt_pk_bf16(c6 * ef, c7 * ef); \
                qb.x = cvt_pk_bf16(c0 * eb, c1 * eb); qb.y = cvt_pk_bf16(c2 * eb, c3 * eb); qb.z = cvt_pk_bf16(c4 * eb, c5 * eb); qb.w = cvt_pk_bf16(c6 * eb, c7 * eb); \
                const bf16x8 af = __builtin_bit_cast(bf16x8, qf), ab = __builtin_bit_cast(bf16x8, qb); \
                _Pragma("unroll") for (int cb = 0; cb < 2; ++cb) { acc[rb2][cb] = MFMA32(af, __builtin_bit_cast(bf16x8, hfr[0][cb][nl][sx]), acc[rb2][cb]); \
                    acc[rb2][cb] = MFMA32(ab, __builtin_bit_cast(bf16x8, hfr[1][cb][nl][sx]), acc[rb2][cb]); } } } } while (0)
        S3_OFF(0);
#pragma unroll
        for (int cb = 0; cb < 2; ++cb)
#pragma unroll
            for (int nl = 0; nl < 2; ++nl)
#pragma unroll
                for (int sx = 0; sx < 2; ++sx) { const int off = ((cb * 4 + 2 + nl) * 64) * 16 + 8 * sx; hfr[0][cb][nl][sx] = *(const u32x4*)(stf + off); hfr[1][cb][nl][sx] = *(const u32x4*)(stb + off); }
#pragma unroll 1
        for (int ks = 0; ks < 8; ++ks) {
            const int sb = 16 * ks + 8 * hf;
            const bf16x8 x0 = *(const LAS bf16x8*)(XT + (hq * 64 + r) * 136 + sb), x1 = *(const LAS bf16x8*)(XT + (hq * 64 + 32 + r) * 136 + sb);
#pragma unroll
            for (int rb2 = 0; rb2 < 2; ++rb2) { const int l = rb2 ? l1 : l0; const float csf_l = rb2 ? csf1 : csf0, csb_l = rb2 ? csb1 : csb0;
                const int RB = 2 * rbh + rb2;
                const bf16x8 gv = *(const LAS bf16x8*)(Gs + l * 136 + sb); float o[8];
                if (ks < 2 * RB) {
                    const f32x4 c0 = *(const LAS f32x4*)(A + sb), c1 = *(const LAS f32x4*)(A + sb + 4), d0 = *(const LAS f32x4*)(A + 256 + sb), d1 = *(const LAS f32x4*)(A + 256 + sb + 4);
#pragma unroll
                    for (int j = 0; j < 4; ++j) { o[j] = bf2f((u16)gv[j]) * (__builtin_amdgcn_exp2f(csf_l - c0[j]) * d0[j]); o[4 + j] = bf2f((u16)gv[4 + j]) * (__builtin_amdgcn_exp2f(csf_l - c1[j]) * d1[j]); }
                } else if (ks > 2 * RB + 1) {
                    const f32x4 c0 = *(const LAS f32x4*)(A + 128 + sb), c1 = *(const LAS f32x4*)(A + 128 + sb + 4), d0 = *(const LAS f32x4*)(A + 384 + sb), d1 = *(const LAS f32x4*)(A + 384 + sb + 4);
#pragma unroll
                    for (int j = 0; j < 4; ++j) { o[j] = bf2f((u16)gv[j]) * (__builtin_amdgcn_exp2f(csb_l - c0[j]) * d0[j]); o[4 + j] = bf2f((u16)gv[4 + j]) * (__builtin_amdgcn_exp2f(csb_l - c1[j]) * d1[j]); }
                } else {
                    float cfs[8], cbs[8], dfs[8], dbs[8];
#pragma unroll
                    for (int q = 0; q < 2; ++q) { const f32x4 t0 = *(const LAS f32x4*)(A + sb + 4 * q), t1 = *(const LAS f32x4*)(A + 128 + sb + 4 * q), t2 = *(const LAS f32x4*)(A + 256 + sb + 4 * q), t3 = *(const LAS f32x4*)(A + 384 + sb + 4 * q);
#pragma unroll
                        for (int j = 0; j < 4; ++j) { cfs[4 * q + j] = t0[j]; cbs[4 * q + j] = t1[j]; dfs[4 * q + j] = t2[j]; dbs[4 * q + j] = t3[j]; } }
#pragma unroll
                    for (int j = 0; j < 8; ++j) { const int ss = sb + j; const bool le = ss <= l, eq = ss == l;
                        const float arg = le ? (csf_l - cfs[j]) : (csb_l - cbs[j]), sc = le ? dfs[j] : dbs[j];
                        const float f = __builtin_amdgcn_exp2f(arg) * sc + (eq ? dbs[j] : 0.f);
                        o[j] = bf2f((u16)gv[j]) * f + (eq ? dsk : 0.f); }
                }
                u32x4 q; q.x = cvt_pk_bf16(o[0], o[1]); q.y = cvt_pk_bf16(o[2], o[3]); q.z = cvt_pk_bf16(o[4], o[5]); q.w = cvt_pk_bf16(o[6], o[7]);
                const bf16x8 am = __builtin_bit_cast(bf16x8, q);
                acc[rb2][0] = MFMA32(am, x0, acc[rb2][0]); acc[rb2][1] = MFMA32(am, x1, acc[rb2][1]); }
        }
        S3_OFF(1);
#undef S3_OFF
        if (pass == 0) stage_conv_load<256>(LX, XBC, row0, 64 * (8 * g + 4));
        u32x4 zv[8];
        { const int t5 = tid_fresh(); const u16* zb = Yg + (size_t)row0 * 2048 + 64 * h0 + (t5 & 31) * 8;
#pragma unroll
          for (int e = 0; e < 8; ++e) zv[e] = *(const u32x4*)(zb + (size_t)((t5 >> 5) + 16 * e) * 2048); }
        LDS_BARRIER();
#pragma unroll
        for (int rb2 = 0; rb2 < 2; ++rb2)
#pragma unroll
            for (int cb = 0; cb < 2; ++cb)
#pragma unroll
                for (int i = 0; i < 16; i += 2) { const u32 pk = cvt_pk_bf16(acc[rb2][cb][i], acc[rb2][cb][i + 1]);
                    const int ro = (64 * rbh + 32 * rb2 + 8 * (i >> 2) + 4 * hf + (i & 3)) * 264 + hq * 64 + 32 * cb + r;
                    XT[ro] = (u16)(pk & 0xffffu); XT[ro + 264] = (u16)(pk >> 16); }
        LDS_BARRIER();
        {
            const int t2 = tid_fresh();
            u16* yb = Yg + (size_t)row0 * 2048 + 64 * h0 + (t2 & 31) * 8;
#pragma unroll
            for (int e = 0; e < 8; ++e) { const int l = (t2 >> 5) + 16 * e; const u32x4 yv = *(const LAS u32x4*)(XT + l * 264 + (t2 & 31) * 8); const u32x4 z = zv[e];
                float v[8] = {lo_f(yv.x) * lo_f(z.x), hi_f(yv.x) * hi_f(z.x), lo_f(yv.y) * lo_f(z.y), hi_f(yv.y) * hi_f(z.y),
                              lo_f(yv.z) * lo_f(z.z), hi_f(yv.z) * hi_f(z.z), lo_f(yv.w) * lo_f(z.w), hi_f(yv.w) * hi_f(z.w)};
                float sv = 0.f;
#pragma unroll
                for (int j = 0; j < 8; ++j) sv += v[j] * v[j];
#pragma unroll
                for (int o = 16; o >= 1; o >>= 1) sv += __shfl_xor(sv, o);
                if ((t2 & 31) == 0) atomicAdd((float*)(ssq + l), sv);
                u32x4 q; q.x = cvt_pk_bf16(v[0], v[1]); q.y = cvt_pk_bf16(v[2], v[3]); q.z = cvt_pk_bf16(v[4], v[5]); q.w = cvt_pk_bf16(v[6], v[7]);
                *(u32x4*)(yb + (size_t)l * 2048) = q; }
        }
        if (pass == 1) { __syncthreads(); } else { LDS_BARRIER(); }
    }
    {
        const int t4 = tid_fresh();
        const int c8 = (t4 & 63) * 8;
        const f32x4 w0 = *(const f32x4*)(P.ssm_nw + 512 * g + c8), w1 = *(const f32x4*)(P.ssm_nw + 512 * g + c8 + 4);
        u16* ybase = Yg + (size_t)(row0 + (t4 >> 6)) * 2048 + 512 * g + c8;
#pragma unroll
        for (int hb = 0; hb < 1; ++hb) {
            u32x4 qv[16];
#pragma unroll
            for (int i = 0; i < 16; ++i) qv[i] = *(const u32x4*)(ybase + (size_t)i * 8 * 2048);
#pragma unroll
            for (int i = 0; i < 16; ++i) { const int l = (t4 >> 6) + 8 * i;
                const float rstd = rsqrtf(ssq[l] * (1.0f / 512.0f) + EPSF); const u32x4 q = qv[i];
                u32x4 o; o.x = cvt_pk_bf16(lo_f(q.x) * rstd * w0[0], hi_f(q.x) * rstd * w0[1]); o.y = cvt_pk_bf16(lo_f(q.y) * rstd * w0[2], hi_f(q.y) * rstd * w0[3]);
                o.z = cvt_pk_bf16(lo_f(q.z) * rstd * w1[0], hi_f(q.z) * rstd * w1[1]); o.w = cvt_pk_bf16(lo_f(q.w) * rstd * w1[2], hi_f(q.w) * rstd * w1[3]);
                *(u32x4*)(ybase + (size_t)(hb * 8 + i) * 8 * 2048) = o; }
        }
    }
    LDS_BARRIER();
}

__device__ __forceinline__ void phase_lnb(const Params& P) {
    constexpr int NR = 4;
    const int lane = tid_fresh() & 63, gw = blockIdx.x * 8 + (tid_fresh() >> 6), nwv = gridDim.x * 8;
    u16* Yg = (u16*)(P.ws + OFF_Y);
    f32x4 lw[4], lb[4];
#pragma unroll
    for (int i = 0; i < 4; ++i) { const int col = (i >> 1) * 512 + lane * 8 + (i & 1) * 4; lw[i] = *(const f32x4*)(P.lnw + col); lb[i] = *(const f32x4*)(P.lnb + col); }
    for (int row0 = gw * NR; row0 < TX; row0 += nwv * NR) {
        u32x4 raw[NR][2];
#pragma unroll
        for (int q = 0; q < NR; ++q) { const u16* p = Yg + (size_t)(row0 + q) * 2048 + 1024 + lane * 8; raw[q][0] = *(const u32x4*)p; raw[q][1] = *(const u32x4*)(p + 512); }
#pragma unroll
        for (int q = 0; q < NR; ++q) {
            f32x4 v[4];
            v[0] = (f32x4){lo_f(raw[q][0].x), hi_f(raw[q][0].x), lo_f(raw[q][0].y), hi_f(raw[q][0].y)}; v[1] = (f32x4){lo_f(raw[q][0].z), hi_f(raw[q][0].z), lo_f(raw[q][0].w), hi_f(raw[q][0].w)};
            v[2] = (f32x4){lo_f(raw[q][1].x), hi_f(raw[q][1].x), lo_f(raw[q][1].y), hi_f(raw[q][1].y)}; v[3] = (f32x4){lo_f(raw[q][1].z), hi_f(raw[q][1].z), lo_f(raw[q][1].w), hi_f(raw[q][1].w)};
            float s = 0.f;
#pragma unroll
            for (int i = 0; i < 4; ++i) s += (v[i][0] + v[i][1]) + (v[i][2] + v[i][3]);
            const float mu = wave_sum(s) * (1.0f / 1024.0f);
            float qq = 0.f;
#pragma unroll
            for (int i = 0; i < 4; ++i) { v[i] = v[i] - mu; qq += v[i][0] * v[i][0] + v[i][1] * v[i][1] + v[i][2] * v[i][2] + v[i][3] * v[i][3]; }
            const float rstd = rsqrtf(wave_sum(qq) * (1.0f / 1024.0f) + EPSF);
            u32x4 o[2];
#pragma unroll
            for (int i = 0; i < 4; ++i) { const f32x4 t = v[i] * rstd * lw[i] + lb[i];
                const u32 a = cvt_pk_bf16(silu_f(t[0]), silu_f(t[1])), b = cvt_pk_bf16(silu_f(t[2]), silu_f(t[3]));
                if ((i & 1) == 0) { o[i >> 1].x = a; o[i >> 1].y = b; } else { o[i >> 1].z = a; o[i >> 1].w = b; } }
            u16* p = Yg + (size_t)(row0 + q) * 2048 + 1024 + lane * 8;
            *(u32x4*)p = o[0]; *(u32x4*)(p + 512) = o[1];
        }
    }
}

template <int PH> __device__ __forceinline__ void run_phase(const Params& P, LAS unsigned char* lds) {
    unsigned char* ws = P.ws;
    const float* MOD = (const float*)(ws + OFF_MOD);
    if constexpr (PH == 0) phase_prep(P, lds);
    if constexpr (PH == 1) phase_norm<0>(P, P.x, P.ctx, TT, P.norm_ffn1, 0, 1, (u16*)(ws + OFF_H), nullptr);
    if constexpr (PH == 2) { Gemm gm{(const bf16_t*)(ws + OFF_H), (const bf16_t*)(ws + OFF_WGU1), TT, NGU, 1024}; StaticOrder S; S.init(TT, NGU, (int)gridDim.x, (int)blockIdx.x);
        EpiSwiGLU E{(bf16_t*)(ws + OFF_ACT)}; gemm_phase<EpiSwiGLU, StaticOrder, false>(lds, gm, S, E, nullptr); }
    if constexpr (PH == 3) { Gemm gm{(const bf16_t*)(ws + OFF_ACT), (const bf16_t*)(ws + OFF_WD1), TT, 1024, DFF}; StaticOrder S; S.init(TT, 1024, (int)gridDim.x, (int)blockIdx.x);
        EpiResidT<0, 1> E{P.x, P.out, P.ctx, ws + OFF_XC1, MOD + 2 * 1024, 0.5f}; gemm_phase<EpiResidT<0, 1>, StaticOrder, false>(lds, gm, S, E, nullptr); }
    if constexpr (PH == 4) phase_norm_b<0>(P, (const u16*)P.out, (const u16*)(ws + OFF_XC1), TT, P.norm_mix, 3, 4, (u16*)(ws + OFF_H), nullptr);
    if constexpr (PH == 5) { Gemm gm{(const bf16_t*)(ws + OFF_H), (const bf16_t*)(ws + OFF_WIN), TX, NIN, 1024}; InOrder S; S.init(TX, NIN, (int)gridDim.x, (int)blockIdx.x);
        EpiInProj E{(bf16_t*)(ws + OFF_XBC), (float*)(ws + OFF_DT), (bf16_t*)(ws + OFF_Y), (bf16_t*)(ws + OFF_U)}; gemm_phase<EpiInProj, InOrder, false>(lds, gm, S, E, nullptr); }
    if constexpr (PH == 6) phase_p6(P, lds);
    if constexpr (PH == 7) { for (int it = blockIdx.x; it < 1152; it += gridDim.x) s1_item(P, lds, it); }
    if constexpr (PH == 8) {
        const int mine = (int)(blockIdx.x % 16u); int k = 0; bool done = false;
        u32x4 raw[4], rawn[4];
        if ((int)blockIdx.x < 4096) uconv_load(P, blockIdx.x, raw);
        for (int it = blockIdx.x; it < 4096; it += gridDim.x, ++k) { if (k == mine) { phase_s2(P); done = true; }
            uconv_item(P, lds, it, raw, it + (int)gridDim.x, rawn);
#pragma unroll
            for (int i = 0; i < 4; ++i) raw[i] = rawn[i]; }
        if (!done) phase_s2(P);
    }
    if constexpr (PH == 9) { for (int it = blockIdx.x; it < 1024; it += gridDim.x) s3_item(P, lds, it); phase_lnb(P); }
    if constexpr (PH == 10) { Gemm gm{(const bf16_t*)(ws + OFF_Y), (const bf16_t*)(ws + OFF_WOUT), TX, 1024, 2048}; StaticOrder S; S.init(TX, 1024, (int)gridDim.x, (int)blockIdx.x);
        EpiResidT<1, 1> E{P.out, ws + OFF_XBC, P.out, ws + OFF_XBC, MOD + 5 * 1024, 1.0f}; gemm_phase<EpiResidT<1, 1>, StaticOrder, false>(lds, gm, S, E, nullptr); }
    if constexpr (PH == 11) phase_norm_b<0>(P, (const u16*)(ws + OFF_XBC), (const u16*)(ws + OFF_XBC), TX, P.norm_ffn2, 6, 7, (u16*)(ws + OFF_H), nullptr);
    if constexpr (PH == 12) { Gemm gm{(const bf16_t*)(ws + OFF_H), (const bf16_t*)(ws + OFF_WGU2), TX, NGU, 1024}; StaticOrder S; S.init(TX, NGU, (int)gridDim.x, (int)blockIdx.x);
        EpiSwiGLU E{(bf16_t*)(ws + OFF_ACT)}; gemm_phase<EpiSwiGLU, StaticOrder, false>(lds, gm, S, E, nullptr); }
    if constexpr (PH == 13) { Gemm gm{(const bf16_t*)(ws + OFF_ACT), (const bf16_t*)(ws + OFF_WD2), TX, 1024, DFF}; StaticOrder S; S.init(TX, 1024, (int)gridDim.x, (int)blockIdx.x);
        EpiResidT<1, 1> E{ws + OFF_XBC, ws + OFF_U, ws + OFF_XBC, ws + OFF_U, MOD + 8 * 1024, 0.5f}; gemm_phase<EpiResidT<1, 1>, StaticOrder, false>(lds, gm, S, E, nullptr); }
    if constexpr (PH == 14) phase_norm_b<1>(P, (const u16*)(ws + OFF_U), (const u16*)(ws + OFF_U), TX, P.fnorm, 0, 0, nullptr, P.out);
}

template <int PH> __global__ void __launch_bounds__(512, 2) k_one(Params P) {
    extern __shared__ __attribute__((aligned(16))) unsigned char shm[];
    run_phase<PH>(P, (LAS unsigned char*)shm);
}

__device__ __forceinline__ void grid_bar(unsigned* ctr, unsigned target) {
    __syncthreads();
    if (tid_fresh() == 0) {
        __builtin_amdgcn_fence(__ATOMIC_RELEASE, "agent");
        __hip_atomic_fetch_add(ctr, 1u, __ATOMIC_RELAXED, __HIP_MEMORY_SCOPE_AGENT);
        unsigned v;
        do { __builtin_amdgcn_s_sleep(1); v = __hip_atomic_load(ctr, __ATOMIC_RELAXED, __HIP_MEMORY_SCOPE_AGENT); asm volatile("" : "+v"(v)); } while (v < target);
        __builtin_amdgcn_fence(__ATOMIC_ACQUIRE, "agent");
    }
    __syncthreads();
}
constexpr bool phase_empty(int ph) { return ph == 6; }
template <int PH, int NB> __device__ __forceinline__ void run_all(const Params& P, LAS unsigned char* lds, cg::grid_group& grid) {
    unsigned* ctr = (unsigned*)(P.ws + OFF_BAR);
    if constexpr (PH == 0) { if (blockIdx.x == 0 && threadIdx.x == 0) __hip_atomic_store(ctr, 0u, __ATOMIC_RELAXED, __HIP_MEMORY_SCOPE_AGENT); }
    if constexpr (phase_empty(PH)) { if constexpr (PH + 1 < NPHASE) run_all<PH + 1, NB>(P, lds, grid); }
    else {
        run_phase<PH>(P, lds);
        constexpr int NXT = (PH + 1 < NPHASE && phase_empty(PH + 1)) ? PH + 2 : PH + 1;
        if constexpr (NXT < NPHASE) {
            if constexpr (PH == 0) grid.sync(); else grid_bar(ctr, (unsigned)NB * gridDim.x);
            run_all<NXT, (PH == 0 ? NB : NB + 1)>(P, lds, grid);
        }
    }
}
__global__ void __launch_bounds__(512, 2) mega(Params P) {
    extern __shared__ __attribute__((aligned(16))) unsigned char shm[];
    cg::grid_group grid = cg::this_grid();
    run_all<0, 1>(P, (LAS unsigned char*)shm, grid);
}

template <int PH> static void launch_each(int grid, hipStream_t stream, const Params& p) {
    static bool attr = false; if (!attr) { (void)hipFuncSetAttribute((const void*)k_one<PH>, hipFuncAttributeMaxDynamicSharedMemorySize, LDS_BYTES); attr = true; }
    hipLaunchKernelGGL(k_one<PH>, dim3(grid), dim3(512), LDS_BYTES, stream, p);
    if constexpr (PH + 1 < NPHASE) launch_each<PH + 1>(grid, stream, p);
}

#ifndef MK_MULTI
#define MK_MULTI 0
#endif
extern "C" void kernel_launch(void* const* d_in, const int* in_sizes, int n_in, void* d_out, int out_size, void* d_ws, size_t ws_size, hipStream_t stream) {
    static int grid = 0;
    if (grid == 0) {
        if (n_in != 30 || ws_size < WS_TOTAL) { fprintf(stderr, "kernel_launch: expected 30 inputs and >= %zu bytes of workspace (got %d, %zu)\n", (size_t)WS_TOTAL, n_in, ws_size); grid = -1; return; }
        int dev = 0, cus = 0, per_cu = 0;
        (void)hipGetDevice(&dev); (void)hipDeviceGetAttribute(&cus, hipDeviceAttributeMultiprocessorCount, dev);
        if (hipFuncSetAttribute((const void*)mega, hipFuncAttributeMaxDynamicSharedMemorySize, LDS_BYTES) != hipSuccess) { fprintf(stderr, "kernel_launch: hipFuncSetAttribute failed\n"); }
        if (hipOccupancyMaxActiveBlocksPerMultiprocessor(&per_cu, (const void*)mega, 512, LDS_BYTES) != hipSuccess || per_cu < 1) { fprintf(stderr, "kernel_launch: occupancy query says %d\n", per_cu); per_cu = 1; }
        (void)hipGetLastError();
        grid = cus * per_cu;
    }
    if (grid < 0) return;
    Params p{};
    const float** pp = (const float**)&p;
    for (int i = 0; i < 30; ++i) pp[i] = (const float*)d_in[i];
    p.out = (float*)d_out; p.ws = (unsigned char*)d_ws;
#if MK_MULTI
    launch_each<0>(grid, stream, p);
#else
    void* args[] = {&p};
    hipError_t e = hipLaunchCooperativeKernel((const void*)mega, dim3(grid), dim3(512), args, LDS_BYTES, stream);
    if (e != hipSuccess) fprintf(stderr, "kernel_launch: cooperative launch failed: %s (grid %d)\n", hipGetErrorString(e), grid);
#endif
}
```
